# Optimizing an MI355X kernel written in HIP

```python
import math
import jax, jax.numpy as jnp
from jax import lax
import numpy as np

D_MODEL = 1024
BATCH = 2
SEQ = 16384
DEPTH = 2
DEC_BATCH = 16
DEC_SEQ = 2048
PAST_LEN = 128

HEAD_DIM = 64
N_EVEN = (DEPTH + 1) // 2
N_ODD = DEPTH // 2
DA_HEADS = 4
DA_VDIM = 2 * HEAD_DIM
DA_QK = DA_HEADS * 2 * HEAD_DIM
DA_V = DA_HEADS * DA_VDIM
HY_CH = D_MODEL // 2
HY_ORDER = 2
HY_BANDS = 8
HY_EMB = 1 + 2 * HY_BANDS
HY_HIDDEN = 64
HY_FAST_DECAY = 0.3
HY_SLOW_DECAY = 1.5
HY_TARGET = 1e-2
EVEN_IN = 2 * DA_QK + DA_V + 3 * HY_CH
EVEN_OUT = DA_V + HY_CH
NA_HEADS = 8
GRID_W = 64
NA_ROWS_MAX = 8
NA_COLS = 16
NA_W = NA_HEADS * HEAD_DIM
WG_HEADS = 8
WG_KV_HEADS = 2
WG_WINDOW = 128
WG_BLOCK = 128
WG_Q = WG_HEADS * HEAD_DIM
WG_KV = WG_KV_HEADS * HEAD_DIM
ODD_IN = 3 * NA_W + WG_Q + 2 * WG_KV
ODD_OUT = NA_W + WG_Q
T5_BUCKETS = 32
T5_MAX_DIST = 128
T5_HEADS = 8
N_MEM = 256
MEM_HEADS = 4
MEM_W = MEM_HEADS * HEAD_DIM
D_FF = 4 * D_MODEL
Q_BLOCK = 128
EPS = 1e-6
NEG_INF = -1e30

kernel_name = "hybrid_diffattn_hyena_natten_swa_encoder"


def rms_f32(x, g):
    xf = x.astype(jnp.float32)
    return xf * lax.rsqrt(jnp.mean(xf * xf, axis=-1, keepdims=True) + EPS) * g.astype(jnp.float32)


def rmsnorm(x, g):
    return rms_f32(x, g).astype(x.dtype)


def t5_bucket(rel):
    half = T5_BUCKETS // 2
    exact = half // 2
    n = jnp.abs(rel)
    nf = jnp.maximum(n, 1).astype(jnp.float32)
    large = exact + (jnp.log(nf / exact) / math.log(T5_MAX_DIST / exact) * (half - exact)).astype(jnp.int32)
    large = jnp.minimum(large, half - 1)
    return jnp.where(rel > 0, half, 0) + jnp.where(n < exact, n, large)


def lambda_init(layer):
    return 0.8 - 0.6 * math.exp(-0.3 * layer)


def diff_attention(q, k, v, lam, q_gain, k_gain, sub_gain, t5_table, lam_init):
    B, L = q.shape[:2]
    nb = L // Q_BLOCK
    q = rms_f32(q, q_gain) * (HEAD_DIM ** -0.5)
    k = rms_f32(k, k_gain)
    v = v.astype(jnp.float32)
    lf = lam.astype(jnp.float32)
    lam_val = jnp.exp(jnp.sum(lf[0] * lf[1])) - jnp.exp(jnp.sum(lf[2] * lf[3])) + lam_init
    qb = jnp.moveaxis(q.reshape(B, nb, Q_BLOCK, DA_HEADS, 2, HEAD_DIM), 1, 0)
    kpos = jnp.arange(L, dtype=jnp.int32)
    table = t5_table.astype(jnp.float32)

    def block(args):
        i, qi = args
        qpos = i * Q_BLOCK + jnp.arange(Q_BLOCK, dtype=jnp.int32)
        bias = table[t5_bucket(kpos[None, :] - qpos[:, None])]
        bias = jnp.transpose(bias, (2, 0, 1)).reshape(DA_HEADS, 2, Q_BLOCK, L)
        s = jnp.einsum('bqhmd,bkhmd->bhmqk', qi, k) + bias[None]
        p = jax.nn.softmax(s, axis=-1)
        a = p[:, :, 0] - lam_val * p[:, :, 1]
        return jnp.einsum('bhqk,bkhd->bqhd', a, v)

    o = lax.map(block, (jnp.arange(nb, dtype=jnp.int32), qb))
    o = jnp.moveaxis(o, 0, 1).reshape(B, L, DA_HEADS, DA_VDIM)
    o = rms_f32(o, sub_gain) * (1.0 - lam_init)
    return o.reshape(B, L, DA_V)


def hyena_filters(L, w1, b1, freq, w2, b2, w3):
    t_idx = jnp.arange(L, dtype=jnp.float32)
    t01 = t_idx / max(L - 1, 1)
    w = 2.0 * math.pi * t_idx / L
    f = jnp.linspace(1e-4, HY_BANDS - 1, HY_BANDS, dtype=jnp.float32)
    ang = w[:, None] * f[None, :]
    z = jnp.concatenate([t01[:, None], jnp.cos(ang), -jnp.sin(ang)], axis=-1)
    fr = freq.astype(jnp.float32)
    h = jnp.sin(fr[0] * (z @ w1.astype(jnp.float32) + b1.astype(jnp.float32)))
    h = jnp.sin(fr[1] * (h @ w2.astype(jnp.float32) + b2.astype(jnp.float32)))
    h = (h @ w3.astype(jnp.float32)).reshape(L, HY_ORDER, 2, HY_CH)
    min_decay = math.log(HY_TARGET) / HY_SLOW_DECAY
    max_decay = math.log(HY_TARGET) / HY_FAST_DECAY
    deltas = jnp.abs(jnp.linspace(min_decay, max_decay, HY_CH, dtype=jnp.float32))
    h = h * jnp.exp(-t01[:, None] * deltas[None, :])[:, None, None, :]
    fwd, bwd = h[:, :, 0], h[:, :, 1]
    k2 = jnp.concatenate([fwd, jnp.zeros((1, HY_ORDER, HY_CH), jnp.float32), bwd[1:][::-1]], axis=0)
    k2 = k2 / jnp.sum(jnp.abs(k2), axis=0, keepdims=True)
    return jnp.fft.rfft(k2, n=2 * L, axis=0)


def hyena_mixer(u, conv_w, conv_b, skip, kf):
    L = u.shape[1]
    up = jnp.pad(u, ((0, 0), (1, 1), (0, 0)))
    uc = up[:, :-2] * conv_w[0] + up[:, 1:-1] * conv_w[1] + up[:, 2:] * conv_w[2] + conv_b
    v, x1, x2 = jnp.split(uc.astype(jnp.float32), 3, axis=-1)
    sk = skip.astype(jnp.float32)
    z = v
    for o, gate in enumerate((x1, x2)):
        zc = jnp.fft.irfft(jnp.fft.rfft(z, n=2 * L, axis=1) * kf[:, o][None], n=2 * L, axis=1)[:, :L]
        z = gate * (zc + sk[o] * z)
    return z


def neighbourhood_attention(q, k, v, q_gain, k_gain, rpb):
    B, L = q.shape[:2]
    rows = L // GRID_W
    kr = min(NA_ROWS_MAX, rows)
    q = rms_f32(q, q_gain) * (HEAD_DIM ** -0.5)
    k = rms_f32(k, k_gain).reshape(B, rows, GRID_W, NA_HEADS, HEAD_DIM)
    v = v.astype(jnp.float32).reshape(B, rows, GRID_W, NA_HEADS, HEAD_DIM)
    qr = jnp.moveaxis(q.reshape(B, rows, GRID_W, NA_HEADS, HEAD_DIM), 1, 0)
    cols = jnp.arange(GRID_W, dtype=jnp.int32)
    c_start = jnp.clip(cols - NA_COLS // 2, 0, GRID_W - NA_COLS)
    idx_c = c_start[:, None] + jnp.arange(NA_COLS, dtype=jnp.int32)[None, :]
    dc = idx_c - cols[:, None] + (NA_COLS - 1)
    rpb_f = rpb.astype(jnp.float32)

    def row(args):
        r, qi = args
        r_start = jnp.clip(r - kr // 2, 0, rows - kr)
        kg = lax.dynamic_slice_in_dim(k, r_start, kr, axis=1)[:, :, idx_c]
        vg = lax.dynamic_slice_in_dim(v, r_start, kr, axis=1)[:, :, idx_c]
        dr = r_start + jnp.arange(kr, dtype=jnp.int32) - r + (NA_ROWS_MAX - 1)
        bias = rpb_f[:, dr[None, :, None], dc[:, None, :]]
        s = jnp.einsum('bchd,bicjhd->bhcij', qi, kg) + bias[None]
        p = jax.nn.softmax(s.reshape(B, NA_HEADS, GRID_W, kr * NA_COLS), axis=-1).reshape(s.shape)
        return jnp.einsum('bhcij,bicjhd->bchd', p, vg)

    o = lax.map(row, (jnp.arange(rows, dtype=jnp.int32), qr))
    return jnp.moveaxis(o, 0, 1).reshape(B, L, NA_W)


def window_gqa(q, k, v, q_gain, k_gain, sink, t5_table):
    B, L = q.shape[:2]
    nb = L // WG_BLOCK
    grp = WG_HEADS // WG_KV_HEADS
    q = (rms_f32(q, q_gain) * (HEAD_DIM ** -0.5)).reshape(B, nb, WG_BLOCK, WG_KV_HEADS, grp, HEAD_DIM)
    k = rms_f32(k, k_gain)
    v = v.astype(jnp.float32)

    def band(t):
        tp = jnp.pad(t, ((0, 0), (WG_BLOCK, WG_BLOCK), (0, 0), (0, 0)))
        tp = tp.reshape(B, nb + 2, WG_BLOCK, WG_KV_HEADS, HEAD_DIM)
        return jnp.concatenate([tp[:, :-2], tp[:, 1:-1], tp[:, 2:]], axis=2)

    kb, vb = band(k), band(v)
    qi = jnp.arange(WG_BLOCK, dtype=jnp.int32)
    ki = jnp.arange(3 * WG_BLOCK, dtype=jnp.int32)
    rel = ki[None, :] - WG_BLOCK - qi[:, None]
    bias = t5_table.astype(jnp.float32)[t5_bucket(rel)]
    bias = jnp.transpose(bias, (2, 0, 1)).reshape(WG_KV_HEADS, grp, WG_BLOCK, 3 * WG_BLOCK)
    kpos = jnp.arange(nb, dtype=jnp.int32)[:, None] * WG_BLOCK - WG_BLOCK + ki[None, :]
    valid = (jnp.abs(rel) <= WG_WINDOW)[None] & ((kpos >= 0) & (kpos < L))[:, None, :]
    s = jnp.einsum('bnqgrd,bnkgd->bngrqk', q, kb) + bias[None, None]
    s = jnp.where(valid[None, :, None, None], s, NEG_INF)
    sink_l = jnp.broadcast_to(sink.astype(jnp.float32).reshape(WG_KV_HEADS, grp, 1, 1), s.shape[:-1] + (1,))
    p = jax.nn.softmax(jnp.concatenate([s, sink_l], axis=-1), axis=-1)[..., :-1]
    o = jnp.einsum('bngrqk,bnkgd->bnqgrd', p, vb)
    return o.reshape(B, L, WG_Q)


def memory_attention(x, mem, norm_g, mem_norm_g, wq, wkv, wo, qg, kg):
    B, L, _ = x.shape
    M = mem.shape[1]
    h = rmsnorm(x, norm_g)
    m = rmsnorm(mem, mem_norm_g)
    q = rms_f32((h @ wq).reshape(B, L, MEM_HEADS, HEAD_DIM), qg) * (HEAD_DIM ** -0.5)
    kv = (m @ wkv).reshape(B, M, 2, MEM_HEADS, HEAD_DIM)
    k = rms_f32(kv[:, :, 0], kg)
    v = kv[:, :, 1].astype(jnp.float32)
    p = jax.nn.softmax(jnp.einsum('blhd,bmhd->bhlm', q, k), axis=-1)
    o = jnp.einsum('bhlm,bmhd->blhd', p, v).reshape(B, L, MEM_W)
    return o.astype(x.dtype) @ wo


def sq_relu_mlp(x, g, w1, w2):
    h = rmsnorm(x, g) @ w1
    return jnp.square(jax.nn.relu(h)) @ w2


def trunk(x, mem, t5_table, norm_mix, norm_mem, norm_memkv, norm_mlp,
          w_in_even, da_q_gain, da_k_gain, da_lambda, da_sub_gain,
          hy_conv_w, hy_conv_b, hy_w1, hy_b1, hy_freq, hy_w2, hy_b2, hy_w3, hy_skip, w_out_even,
          w_in_odd, na_q_gain, na_k_gain, na_rpb, wg_q_gain, wg_k_gain, wg_sink, w_out_odd,
          mem_wq, mem_wkv, mem_wo, mem_q_gain, mem_k_gain, mlp_w1, mlp_w2):
    B, L, _ = x.shape
    for layer in range(DEPTH):
        h = rmsnorm(x, norm_mix[layer])
        if layer % 2 == 0:
            j = layer // 2
            proj = h @ w_in_even[j]
            qa, ka, va, ub = jnp.split(proj, [DA_QK, 2 * DA_QK, 2 * DA_QK + DA_V], axis=-1)
            oa = diff_attention(qa.reshape(B, L, DA_HEADS, 2, HEAD_DIM),
                                ka.reshape(B, L, DA_HEADS, 2, HEAD_DIM),
                                va.reshape(B, L, DA_HEADS, DA_VDIM),
                                da_lambda[j], da_q_gain[j], da_k_gain[j], da_sub_gain[j],
                                t5_table, lambda_init(layer))
            kf = hyena_filters(L, hy_w1[j], hy_b1[j], hy_freq[j], hy_w2[j], hy_b2[j], hy_w3[j])
            ob = hyena_mixer(ub, hy_conv_w[j], hy_conv_b[j], hy_skip[j], kf)
            mix = jnp.concatenate([oa, ob], axis=-1).astype(x.dtype) @ w_out_even[j]
        else:
            j = layer // 2
            proj = h @ w_in_odd[j]
            qc, kc, vc, qd, kd, vd = jnp.split(
                proj, [NA_W, 2 * NA_W, 3 * NA_W, 3 * NA_W + WG_Q, 3 * NA_W + WG_Q + WG_KV], axis=-1)
            oc = neighbourhood_attention(qc.reshape(B, L, NA_HEADS, HEAD_DIM),
                                         kc.reshape(B, L, NA_HEADS, HEAD_DIM),
                                         vc.reshape(B, L, NA_HEADS, HEAD_DIM),
                                         na_q_gain[j], na_k_gain[j], na_rpb[j])
            od = window_gqa(qd.reshape(B, L, WG_HEADS, HEAD_DIM),
                            kd.reshape(B, L, WG_KV_HEADS, HEAD_DIM),
                            vd.reshape(B, L, WG_KV_HEADS, HEAD_DIM),
                            wg_q_gain[j], wg_k_gain[j], wg_sink[j], t5_table)
            mix = jnp.concatenate([oc, od], axis=-1).astype(x.dtype) @ w_out_odd[j]
        x = x + mix.astype(x.dtype)
        x = x + memory_attention(x, mem, norm_mem[layer], norm_memkv[layer], mem_wq[layer],
                                 mem_wkv[layer], mem_wo[layer], mem_q_gain[layer],
                                 mem_k_gain[layer]).astype(x.dtype)
        x = x + sq_relu_mlp(x, norm_mlp[layer], mlp_w1[layer], mlp_w2[layer]).astype(x.dtype)
    return x


def setup_inputs(seed: int = 0) -> dict:
    key = jax.random.key(seed)
    ks = iter(jax.random.split(key, 40))

    def nrm(shape, scale):
        return jax.random.normal(next(ks), shape, jnp.float32) * scale

    def gain(shape):
        return 1.0 + nrm(shape, 0.05)

    return {
        "x_prompt": nrm((BATCH, SEQ, D_MODEL), 1.0),
        "x_sample": nrm((DEC_BATCH, DEC_SEQ, D_MODEL), 1.0),
        "mem_prompt": nrm((BATCH, N_MEM, D_MODEL), 1.0),
        "mem_sample": nrm((DEC_BATCH, N_MEM, D_MODEL), 1.0),
        "t5_table": nrm((T5_BUCKETS, T5_HEADS), 0.2),
        "norm_mix": gain((DEPTH, D_MODEL)),
        "norm_mem": gain((DEPTH, D_MODEL)),
        "norm_memkv": gain((DEPTH, D_MODEL)),
        "norm_mlp": gain((DEPTH, D_MODEL)),
        "w_in_even": nrm((N_EVEN, D_MODEL, EVEN_IN), D_MODEL ** -0.5),
        "da_q_gain": gain((N_EVEN, HEAD_DIM)),
        "da_k_gain": gain((N_EVEN, HEAD_DIM)),
        "da_lambda": nrm((N_EVEN, 4, HEAD_DIM), 0.1),
        "da_sub_gain": gain((N_EVEN, DA_VDIM)),
        "hy_conv_w": nrm((N_EVEN, 3, 3 * HY_CH), 3 ** -0.5),
        "hy_conv_b": nrm((N_EVEN, 3 * HY_CH), 0.02),
        "hy_w1": nrm((N_EVEN, HY_EMB, HY_HIDDEN), HY_EMB ** -0.5),
        "hy_b1": nrm((N_EVEN, HY_HIDDEN), 0.02),
        "hy_freq": gain((N_EVEN, 2, HY_HIDDEN)),
        "hy_w2": nrm((N_EVEN, HY_HIDDEN, HY_HIDDEN), HY_HIDDEN ** -0.5),
        "hy_b2": nrm((N_EVEN, HY_HIDDEN), 0.02),
        "hy_w3": nrm((N_EVEN, HY_HIDDEN, HY_ORDER * 2 * HY_CH), HY_HIDDEN ** -0.5),
        "hy_skip": nrm((N_EVEN, HY_ORDER, HY_CH), 1.0),
        "w_out_even": nrm((N_EVEN, EVEN_OUT, D_MODEL), EVEN_OUT ** -0.5),
        "w_in_odd": nrm((N_ODD, D_MODEL, ODD_IN), D_MODEL ** -0.5),
        "na_q_gain": gain((N_ODD, HEAD_DIM)),
        "na_k_gain": gain((N_ODD, HEAD_DIM)),
        "na_rpb": nrm((N_ODD, NA_HEADS, 2 * NA_ROWS_MAX - 1, 2 * NA_COLS - 1), 0.2),
        "wg_q_gain": gain((N_ODD, HEAD_DIM)),
        "wg_k_gain": gain((N_ODD, HEAD_DIM)),
        "wg_sink": nrm((N_ODD, WG_HEADS), 0.5),
        "w_out_odd": nrm((N_ODD, ODD_OUT, D_MODEL), ODD_OUT ** -0.5),
        "mem_wq": nrm((DEPTH, D_MODEL, MEM_W), D_MODEL ** -0.5),
        "mem_wkv": nrm((DEPTH, D_MODEL, 2 * MEM_W), D_MODEL ** -0.5),
        "mem_wo": nrm((DEPTH, MEM_W, D_MODEL), MEM_W ** -0.5),
        "mem_q_gain": gain((DEPTH, HEAD_DIM)),
        "mem_k_gain": gain((DEPTH, HEAD_DIM)),
        "mlp_w1": nrm((DEPTH, D_MODEL, D_FF), D_MODEL ** -0.5),
        "mlp_w2": nrm((DEPTH, D_FF, D_MODEL), D_FF ** -0.5),
    }


def reference(x_prompt, x_sample, mem_prompt, mem_sample, t5_table, norm_mix, norm_mem, norm_memkv,
              norm_mlp, w_in_even, da_q_gain, da_k_gain, da_lambda, da_sub_gain, hy_conv_w, hy_conv_b,
              hy_w1, hy_b1, hy_freq, hy_w2, hy_b2, hy_w3, hy_skip, w_out_even, w_in_odd, na_q_gain,
              na_k_gain, na_rpb, wg_q_gain, wg_k_gain, wg_sink, w_out_odd, mem_wq, mem_wkv, mem_wo,
              mem_q_gain, mem_k_gain, mlp_w1, mlp_w2):
    weights = (t5_table, norm_mix, norm_mem, norm_memkv, norm_mlp,
               w_in_even, da_q_gain, da_k_gain, da_lambda, da_sub_gain,
               hy_conv_w, hy_conv_b, hy_w1, hy_b1, hy_freq, hy_w2, hy_b2, hy_w3, hy_skip, w_out_even,
               w_in_odd, na_q_gain, na_k_gain, na_rpb, wg_q_gain, wg_k_gain, wg_sink, w_out_odd,
               mem_wq, mem_wkv, mem_wo, mem_q_gain, mem_k_gain, mlp_w1, mlp_w2)
    y_prompt = trunk(x_prompt, mem_prompt, *weights)
    y_sample = trunk(x_sample, mem_sample, *weights)
    return (y_prompt, y_sample)
```

```cpp
#include <hip/hip_runtime.h>
#include <hip/hip_cooperative_groups.h>
#include <cstdio>
namespace cg = cooperative_groups;

#define DI __device__ __forceinline__
typedef unsigned short bf16_t;
using bf16x8 = __attribute__((ext_vector_type(8))) short;
using s16x4 = __attribute__((ext_vector_type(4))) short;
using f32x4 = __attribute__((ext_vector_type(4))) float;
#define MFMA16(a, b, c) __builtin_amdgcn_mfma_f32_16x16x32_bf16((a), (b), (c), 0, 0, 0)

constexpr int NTHR = 512;
constexpr int T_ALL = 65536;
constexpr int T_P = 32768;
constexpr int LP = 16384, LS = 2048;
constexpr int DM = 1024;
constexpr float EPS = 1e-6f;
constexpr float LOG2E = 1.4426950408889634f;
constexpr float QSCALE = 0.125f * 1.4426950408889634f;
constexpr int SMEM_BYTES = 144 * 1024;
constexpr size_t MiB = (size_t)1 << 20;

constexpr size_t WS_XB = 0;
constexpr size_t WS_W = 128 * MiB;
constexpr size_t W_INE = 0;
constexpr size_t W_OUTE = W_INE + (size_t)3072 * 1024;
constexpr size_t W_INO = W_OUTE + (size_t)1024 * 1024;
constexpr size_t W_OUTO = W_INO + (size_t)2304 * 1024;
constexpr size_t W_Q = W_OUTO + (size_t)1024 * 1024;
constexpr size_t W_KV = W_Q + (size_t)2 * 256 * 1024;
constexpr size_t W_O = W_KV + (size_t)2 * 512 * 1024;
constexpr size_t W_1 = W_O + (size_t)2 * 1024 * 256;
constexpr size_t W_2 = W_1 + (size_t)2 * 4096 * 1024;
constexpr size_t W_END = W_2 + (size_t)2 * 4096 * 1024;
static_assert(W_END * 2 <= 51 * MiB, "weights");
constexpr size_t WS_MISC = 179 * MiB;
constexpr size_t MS_RS = 0;
constexpr size_t MS_RSM = MS_RS + (size_t)6 * T_ALL * 4;
constexpr size_t MS_MK = MS_RSM + 32768;
constexpr size_t MS_MVT = MS_MK + (size_t)2 * 18 * 256 * 256 * 2;
constexpr size_t MS_H2P = MS_MVT + (size_t)2 * 18 * 256 * 256 * 2;
constexpr size_t MS_H2S = MS_H2P + (size_t)LP * 64 * 4;
constexpr size_t MS_LUT = MS_H2S + (size_t)LS * 64 * 4;
constexpr size_t MS_LAM = MS_LUT + 16384;
constexpr size_t MS_END = MS_LAM + 256;
static_assert(MS_END <= 16 * MiB, "misc");
constexpr size_t WS_R0 = 195 * MiB;
constexpr size_t WS_R1 = 259 * MiB;
constexpr size_t WS_R2 = 323 * MiB;
constexpr size_t WS_R3 = 387 * MiB;
constexpr size_t WS_KD = 451 * MiB;
constexpr size_t WS_VDT = 467 * MiB;
constexpr size_t WS_QM = 451 * MiB;
constexpr size_t WS_H_L0 = 323 * MiB;
constexpr size_t WS_H_L1 = 259 * MiB;
constexpr size_t WS_NEED = 512 * MiB;
constexpr size_t HY_SCR_PER_BLOCK = 512 * 1024;

struct Params {
  const float* in[39];
  float* out;
  char* ws;
};

DI unsigned short f2bf(float x) { unsigned u = __float_as_uint(x); u += 0x7fffu + ((u >> 16) & 1u); return (unsigned short)(u >> 16); }
DI unsigned pack2(float a, float b) { return (unsigned)f2bf(a) | ((unsigned)f2bf(b) << 16); }
DI float bf2f(unsigned short h) { return __uint_as_float(((unsigned)h) << 16); }
DI float ex2(float x) { return __builtin_amdgcn_exp2f(x); }
DI float sin_rev(float r) { return __builtin_amdgcn_sinf(r); }
DI float cos_rev(float r) { return __builtin_amdgcn_cosf(r); }
DI int opaque(int x) { asm volatile("" : "+v"(x)); return x; }
DI void block_sync_global() { __threadfence(); __syncthreads(); __threadfence(); }

DI size_t chm_index(int CH, int row, int ch) {
  if (row < T_P) { int b = row >> 14, t = row & (LP - 1); return ((size_t)(b * CH + ch) << 14) + t; }
  int r = row - T_P; int b = r >> 11, t = r & (LS - 1);
  return (size_t)T_P * CH + ((size_t)(b * CH + ch) << 11) + t;
}

struct GemmArgs {
  const bf16_t* A0; const bf16_t* A1; int ksplit; int lda;
  const bf16_t* Wt; int ldw; int K;
};
enum { SEG_NORM = 0, SEG_CHM = 1, SEG_CHMEM = 2, SEG_RESID = 3, SEG_MLP1 = 4 };
struct Seg {
  int type;
  bf16_t* dst; int ld; int col;
  const float* gain; float scale;
  int CH;
  const float* rs;
  const float* xin0; const float* xin1; float* xout; bf16_t* xb; float* rs_out;
};
constexpr int G_STAGE = (256 + 128) * 144;

DI void gemm_tile(char* smem, const GemmArgs& ga, int m0, int n0, const Seg& sg) {
  const int tid = opaque((int)threadIdx.x), lane = tid & 63, wave = tid >> 6;
  const int l16 = lane & 15, g = lane >> 4;
  const int wm = wave >> 1, wn = wave & 1;
  f32x4 acc[4][4];
#pragma unroll
  for (int i = 0; i < 4; ++i)
#pragma unroll
    for (int j = 0; j < 4; ++j) acc[i][j] = (f32x4){0.f, 0.f, 0.f, 0.f};
  const int lrow = tid >> 3, lkc = tid & 7;
  uint4 ra[4], rb[2];
  const int KT = ga.K >> 6;
  {
    const bf16_t* Ab = (0 < ga.ksplit) ? ga.A0 : ga.A1;
#pragma unroll
    for (int i = 0; i < 4; ++i) ra[i] = *(const uint4*)(Ab + (size_t)(m0 + lrow + 64 * i) * ga.lda + 8 * lkc);
#pragma unroll
    for (int i = 0; i < 2; ++i) rb[i] = *(const uint4*)(ga.Wt + (size_t)(n0 + lrow + 64 * i) * ga.ldw + 8 * lkc);
  }
  {
    char* As = smem; char* Bs = As + 256 * 144;
#pragma unroll
    for (int i = 0; i < 4; ++i) *(uint4*)(As + (lrow + 64 * i) * 144 + lkc * 16) = ra[i];
#pragma unroll
    for (int i = 0; i < 2; ++i) *(uint4*)(Bs + (lrow + 64 * i) * 144 + lkc * 16) = rb[i];
  }
  __syncthreads();
  for (int kt = 0; kt < KT; ++kt) {
    const int buf = kt & 1;
    if (kt + 1 < KT) {
      const int k0 = (kt + 1) << 6;
      const bf16_t* Ab = (k0 < ga.ksplit) ? ga.A0 + k0 : ga.A1 + (k0 - ga.ksplit);
#pragma unroll
      for (int i = 0; i < 4; ++i) ra[i] = *(const uint4*)(Ab + (size_t)(m0 + lrow + 64 * i) * ga.lda + 8 * lkc);
#pragma unroll
      for (int i = 0; i < 2; ++i) rb[i] = *(const uint4*)(ga.Wt + (size_t)(n0 + lrow + 64 * i) * ga.ldw + k0 + 8 * lkc);
    }
    const char* As = smem + buf * G_STAGE; const char* Bs = As + 256 * 144;
#pragma unroll
    for (int ks = 0; ks < 2; ++ks) {
      bf16x8 af[4], bfr[4];
#pragma unroll
      for (int mb = 0; mb < 4; ++mb) af[mb] = *(const bf16x8*)(As + (64 * wm + 16 * mb + l16) * 144 + (32 * ks + 8 * g) * 2);
#pragma unroll
      for (int nb = 0; nb < 4; ++nb) bfr[nb] = *(const bf16x8*)(Bs + (64 * wn + 16 * nb + l16) * 144 + (32 * ks + 8 * g) * 2);
#pragma unroll
      for (int mb = 0; mb < 4; ++mb)
#pragma unroll
        for (int nb = 0; nb < 4; ++nb) acc[mb][nb] = MFMA16(af[mb], bfr[nb], acc[mb][nb]);
    }
    if (kt + 1 < KT) {
      char* As2 = smem + (buf ^ 1) * G_STAGE; char* Bs2 = As2 + 256 * 144;
#pragma unroll
      for (int i = 0; i < 4; ++i) *(uint4*)(As2 + (lrow + 64 * i) * 144 + lkc * 16) = ra[i];
#pragma unroll
      for (int i = 0; i < 2; ++i) *(uint4*)(Bs2 + (lrow + 64 * i) * 144 + lkc * 16) = rb[i];
    }
    __syncthreads();
  }
  const int rbase = m0 + 64 * wm + 4 * g;
  const int lcb = 64 * wn + l16;
  if (sg.rs) {
#pragma unroll
    for (int mb = 0; mb < 4; ++mb)
#pragma unroll
      for (int r = 0; r < 4; ++r) {
        float s = rsqrtf(sg.rs[rbase + 16 * mb + r] * (1.0f / 1024.0f) + EPS);
#pragma unroll
        for (int nb = 0; nb < 4; ++nb) acc[mb][nb][r] *= s;
      }
  }
  if (sg.type == SEG_NORM) {
    float gn[4];
#pragma unroll
    for (int nb = 0; nb < 4; ++nb) gn[nb] = sg.gain[16 * nb + l16] * sg.scale;
#pragma unroll
    for (int mb = 0; mb < 4; ++mb)
#pragma unroll
      for (int r = 0; r < 4; ++r) {
        float ss = 0.f;
#pragma unroll
        for (int nb = 0; nb < 4; ++nb) ss += acc[mb][nb][r] * acc[mb][nb][r];
        ss += __shfl_xor(ss, 1); ss += __shfl_xor(ss, 2); ss += __shfl_xor(ss, 4); ss += __shfl_xor(ss, 8);
        float sc = rsqrtf(ss * (1.0f / 64.0f) + EPS);
        bf16_t* d = sg.dst + (size_t)(rbase + 16 * mb + r) * sg.ld + sg.col + lcb;
#pragma unroll
        for (int nb = 0; nb < 4; ++nb) d[16 * nb] = f2bf(acc[mb][nb][r] * sc * gn[nb]);
      }
  } else if (sg.type == SEG_CHM || sg.type == SEG_CHMEM) {
#pragma unroll
    for (int mb = 0; mb < 4; ++mb)
#pragma unroll
      for (int nb = 0; nb < 4; ++nb) {
        int row = rbase + 16 * mb; int ch = sg.col + lcb + 16 * nb;
        size_t off;
        if (sg.type == SEG_CHM) off = chm_index(sg.CH, row, ch);
        else off = ((size_t)((row >> 8) * 256 + ch) << 8) + (row & 255);
        uint2 v; v.x = pack2(acc[mb][nb][0], acc[mb][nb][1]); v.y = pack2(acc[mb][nb][2], acc[mb][nb][3]);
        *(uint2*)(sg.dst + off) = v;
      }
  } else {
    float* Cs = (float*)smem;
#pragma unroll
    for (int mb = 0; mb < 4; ++mb)
#pragma unroll
      for (int nb = 0; nb < 4; ++nb)
#pragma unroll
        for (int r = 0; r < 4; ++r) Cs[(64 * wm + 16 * mb + 4 * g + r) * 132 + 64 * wn + 16 * nb + l16] = acc[mb][nb][r];
    __syncthreads();
    const int rr = tid >> 5, c4 = (tid & 31) * 4;
#pragma unroll 2
    for (int it = 0; it < 16; ++it) {
      const int lr = it * 16 + rr; const int row = m0 + lr;
      f32x4 v = *(const f32x4*)(Cs + lr * 132 + c4);
      if (sg.type == SEG_MLP1) {
        v[0] = fmaxf(v[0], 0.f); v[1] = fmaxf(v[1], 0.f); v[2] = fmaxf(v[2], 0.f); v[3] = fmaxf(v[3], 0.f);
        uint2 u; u.x = pack2(v[0] * v[0], v[1] * v[1]); u.y = pack2(v[2] * v[2], v[3] * v[3]);
        *(uint2*)(sg.dst + (size_t)row * sg.ld + sg.col + c4) = u;
      } else {
        const float* xo;
        if (sg.xin0) xo = (row < T_P) ? sg.xin0 + (size_t)row * DM : sg.xin1 + (size_t)(row - T_P) * DM;
        else xo = sg.xout + (size_t)row * DM;
        const f32x4 x = *(const f32x4*)(xo + sg.col + c4);
        v += x;
        *(f32x4*)(sg.xout + (size_t)row * DM + sg.col + c4) = v;
        if (sg.xb) { uint2 u; u.x = pack2(v[0], v[1]); u.y = pack2(v[2], v[3]); *(uint2*)(sg.xb + (size_t)row * DM + sg.col + c4) = u; }
        if (sg.rs_out) {
          float ss = v[0] * v[0] + v[1] * v[1] + v[2] * v[2] + v[3] * v[3];
          ss += __shfl_xor(ss, 1); ss += __shfl_xor(ss, 2); ss += __shfl_xor(ss, 4); ss += __shfl_xor(ss, 8); ss += __shfl_xor(ss, 16);
          if ((tid & 31) == 0) atomicAdd(sg.rs_out + row, ss);
        }
      }
    }
    __syncthreads();
  }
}

enum { AM_MEM = 0, AM_DIFF = 1, AM_WG = 2, AM_NA = 3 };
constexpr int ATT_LUT_OFS = 2 * (64 + 128) * 144;

template <int VD, int MODE>
DI void attn_core(char* smem, const bf16_t* Q, int ldq, const bf16_t* K, int ldk, const bf16_t* Vt, int ldv,
                  int qpos0, int kbeg, int kend, int nrows, float sink_l2, float (&O)[2][VD / 16][4]) {
  constexpr int NDB = VD / 16;
  constexpr int STAGE = (64 + VD) * 144;
  const int tid = opaque((int)threadIdx.x), lane = tid & 63, wave = tid >> 6;
  const int l16 = lane & 15, g = lane >> 4;
  const float* lut = (const float*)(smem + ATT_LUT_OFS);
  bf16x8 qf[2][2];
#pragma unroll
  for (int qb = 0; qb < 2; ++qb)
#pragma unroll
    for (int kk = 0; kk < 2; ++kk) qf[qb][kk] = *(const bf16x8*)(Q + (size_t)(32 * wave + 16 * qb + l16) * ldq + 32 * kk + 8 * g);
  float m[2] = {-1e30f, -1e30f}, l[2] = {0.f, 0.f};
#pragma unroll
  for (int qb = 0; qb < 2; ++qb)
#pragma unroll
    for (int db = 0; db < NDB; ++db)
#pragma unroll
      for (int r = 0; r < 4; ++r) O[qb][db][r] = 0.f;
  const int wq0 = qpos0 + 32 * wave;
  const int lrow = tid >> 3, lc = tid & 7;
  uint4 rk, rv0, rv1;
  rv1 = make_uint4(0, 0, 0, 0);
#define ATT_GLOAD(k0_) do { \
    rk = *(const uint4*)(K + (size_t)((k0_) + lrow) * ldk + 8 * lc); \
    rv0 = *(const uint4*)(Vt + (size_t)(lrow) * ldv + (k0_) + 8 * lc); \
    if (VD == 128) rv1 = *(const uint4*)(Vt + (size_t)(lrow + 64) * ldv + (k0_) + 8 * lc); } while (0)
#define ATT_SWRITE(buf_) do { \
    char* Ks_ = smem + (buf_) * STAGE; char* Vs_ = Ks_ + 64 * 144; \
    *(uint4*)(Ks_ + lrow * 144 + lc * 16) = rk; \
    *(uint4*)(Vs_ + lrow * 144 + lc * 16) = rv0; \
    if (VD == 128) *(uint4*)(Vs_ + (lrow + 64) * 144 + lc * 16) = rv1; } while (0)
  ATT_GLOAD(kbeg); ATT_SWRITE(0);
  __syncthreads();
  int it = 0;
  for (int k0 = kbeg; k0 < kend; k0 += 64, ++it) {
    const int buf = it & 1;
    const bool more = (k0 + 64 < kend);
    if (more) ATT_GLOAD(k0 + 64);
    const char* Ks = smem + buf * STAGE; const char* Vs = Ks + 64 * 144;
    bool active = true;
    if (MODE == AM_WG) active = !(k0 + 63 < wq0 - 128 || k0 > wq0 + 31 + 128);
    int na_rs = 0; const int qr = wq0 >> 6, kr = k0 >> 6;
    if (MODE == AM_NA) { na_rs = min(max(qr - 4, 0), nrows - 8); active = (kr >= na_rs && kr < na_rs + 8); }
    if (active) {
      f32x4 S[2][4];
#pragma unroll
      for (int kb = 0; kb < 4; ++kb) {
        bf16x8 kf0 = *(const bf16x8*)(Ks + (16 * kb + l16) * 144 + (8 * g) * 2);
        bf16x8 kf1 = *(const bf16x8*)(Ks + (16 * kb + l16) * 144 + (32 + 8 * g) * 2);
#pragma unroll
        for (int qb = 0; qb < 2; ++qb) {
          f32x4 z = (f32x4){0.f, 0.f, 0.f, 0.f};
          z = MFMA16(kf0, qf[qb][0], z);
          S[qb][kb] = MFMA16(kf1, qf[qb][1], z);
        }
      }
#pragma unroll
      for (int qb = 0; qb < 2; ++qb) {
        const int q = wq0 + 16 * qb + l16;
        if (MODE == AM_DIFF || MODE == AM_WG) {
          if (MODE == AM_DIFF && k0 + 63 - wq0 <= -128) {
            const float c = lut[0];
#pragma unroll
            for (int kb = 0; kb < 4; ++kb)
#pragma unroll
              for (int r = 0; r < 4; ++r) S[qb][kb][r] += c;
          } else if (MODE == AM_DIFF && k0 - (wq0 + 31) >= 128) {
            const float c = lut[256];
#pragma unroll
            for (int kb = 0; kb < 4; ++kb)
#pragma unroll
              for (int r = 0; r < 4; ++r) S[qb][kb][r] += c;
          } else {
#pragma unroll
            for (int kb = 0; kb < 4; ++kb)
#pragma unroll
              for (int r = 0; r < 4; ++r) {
                const int rel = k0 + 16 * kb + 4 * g + r - q;
                const int rc = min(max(rel, -128), 128);
                float s = S[qb][kb][r] + lut[rc + 128];
                if (MODE == AM_WG && (rel > 128 || rel < -128)) s = -1e30f;
                S[qb][kb][r] = s;
              }
          }
        } else if (MODE == AM_NA) {
          const int qc = q & 63;
          const int cs = min(max(qc - 8, 0), 48);
          const int dr = kr - qr + 7;
#pragma unroll
          for (int kb = 0; kb < 4; ++kb)
#pragma unroll
            for (int r = 0; r < 4; ++r) {
              const int kc = 16 * kb + 4 * g + r;
              const bool ok = (kc >= cs) && (kc < cs + 16);
              const int dc = min(max(kc - qc + 15, 0), 30);
              float s = S[qb][kb][r] + lut[dr * 31 + dc];
              S[qb][kb][r] = ok ? s : -1e30f;
            }
        }
      }
#pragma unroll
      for (int qb = 0; qb < 2; ++qb) {
        float mx = -1e30f;
#pragma unroll
        for (int kb = 0; kb < 4; ++kb)
#pragma unroll
          for (int r = 0; r < 4; ++r) mx = fmaxf(mx, S[qb][kb][r]);
        mx = fmaxf(mx, __shfl_xor(mx, 16)); mx = fmaxf(mx, __shfl_xor(mx, 32));
        const float mn = fmaxf(m[qb], mx);
        const float alpha = ex2(m[qb] - mn);
        m[qb] = mn;
        float ps = 0.f;
#pragma unroll
        for (int kb = 0; kb < 4; ++kb)
#pragma unroll
          for (int r = 0; r < 4; ++r) { float p = ex2(S[qb][kb][r] - mn); S[qb][kb][r] = p; ps += p; }
        l[qb] = l[qb] * alpha + ps;
#pragma unroll
        for (int db = 0; db < NDB; ++db)
#pragma unroll
          for (int r = 0; r < 4; ++r) O[qb][db][r] *= alpha;
      }
#pragma unroll
      for (int ks = 0; ks < 2; ++ks) {
        bf16x8 pf[2];
#pragma unroll
        for (int qb = 0; qb < 2; ++qb) {
          uint4 u;
          u.x = pack2(S[qb][2 * ks][0], S[qb][2 * ks][1]); u.y = pack2(S[qb][2 * ks][2], S[qb][2 * ks][3]);
          u.z = pack2(S[qb][2 * ks + 1][0], S[qb][2 * ks + 1][1]); u.w = pack2(S[qb][2 * ks + 1][2], S[qb][2 * ks + 1][3]);
          pf[qb] = __builtin_bit_cast(bf16x8, u);
        }
#pragma unroll
        for (int db = 0; db < NDB; ++db) {
          const char* vrow = Vs + (16 * db + l16) * 144 + (32 * ks + 4 * g) * 2;
          uint2 v0 = *(const uint2*)(vrow);
          uint2 v1 = *(const uint2*)(vrow + 32);
          uint4 u; u.x = v0.x; u.y = v0.y; u.z = v1.x; u.w = v1.y;
          bf16x8 vf = __builtin_bit_cast(bf16x8, u);
#pragma unroll
          for (int qb = 0; qb < 2; ++qb) {
            f32x4 o = (f32x4){O[qb][db][0], O[qb][db][1], O[qb][db][2], O[qb][db][3]};
            o = MFMA16(vf, pf[qb], o);
            O[qb][db][0] = o[0]; O[qb][db][1] = o[1]; O[qb][db][2] = o[2]; O[qb][db][3] = o[3];
          }
        }
      }
    }
    if (more) ATT_SWRITE(buf ^ 1);
    __syncthreads();
  }
#pragma unroll
  for (int qb = 0; qb < 2; ++qb) {
    float lt = l[qb];
    lt += __shfl_xor(lt, 16); lt += __shfl_xor(lt, 32);
    if (MODE == AM_WG) lt += ex2(sink_l2 - m[qb]);
    const float inv = 1.0f / lt;
#pragma unroll
    for (int db = 0; db < NDB; ++db)
#pragma unroll
      for (int r = 0; r < 4; ++r) O[qb][db][r] *= inv;
  }
}

template <int NDB>
DI void attn_store(bf16_t* dst, int ld, const float (&O)[2][NDB][4]) {
  const int lane = threadIdx.x & 63, wave = threadIdx.x >> 6, l16 = lane & 15, g = lane >> 4;
#pragma unroll
  for (int qb = 0; qb < 2; ++qb)
#pragma unroll
    for (int db = 0; db < NDB; ++db) {
      uint2 v; v.x = pack2(O[qb][db][0], O[qb][db][1]); v.y = pack2(O[qb][db][2], O[qb][db][3]);
      *(uint2*)(dst + (size_t)(32 * wave + 16 * qb + l16) * ld + 16 * db + 4 * g) = v;
    }
}

DI void seq_of_row(int row0, int& L, int& seq_row0, int& b_glob) {
  if (row0 < T_P) { L = LP; int b = row0 >> 14; seq_row0 = b << 14; b_glob = b; }
  else { L = LS; int b = (row0 - T_P) >> 11; seq_row0 = T_P + (b << 11); b_glob = 2 + b; }
}

DI void diff_item(char* smem, const Params& p, int item) {
  bf16_t* QA = (bf16_t*)(p.ws + WS_R0);
  const bf16_t* KA = (const bf16_t*)((const char*)p.out + 192 * MiB);
  const bf16_t* VAt = (const bf16_t*)(p.ws + WS_R2);
  const float* misc_lut = (const float*)(p.ws + WS_MISC + MS_LUT);
  const float lam = *(const float*)(p.ws + WS_MISC + MS_LAM);
  int h, row0;
  if (item < 512) { h = item & 3; row0 = (item >> 2) * 256; }
  else { int i2 = item - 512; h = i2 & 3; row0 = T_P + (i2 >> 2) * 256; }
  int L, srow0, bg; seq_of_row(row0, L, srow0, bg);
  const int qpos0 = row0 - srow0;
  const bf16_t* Vt = VAt + chm_index(512, srow0, h * 128);
  float O[2][8][4];
  unsigned* o0s = (unsigned*)(smem + 57344) + threadIdx.x;
  const int tid = threadIdx.x;
#pragma unroll 1
  for (int mp = 0; mp < 2; ++mp) {
    __syncthreads();
    for (int i = tid; i < 257; i += NTHR) ((float*)(smem + ATT_LUT_OFS))[i] = misc_lut[(h * 2 + mp) * 257 + i];
    __syncthreads();
    attn_core<128, AM_DIFF>(smem, QA + (size_t)row0 * 512 + h * 128 + mp * 64, 512, KA + (size_t)srow0 * 512 + h * 128 + mp * 64, 512,
                            Vt, L, qpos0, 0, L, 0, 0.f, O);
    if (mp == 0) {
#pragma unroll
      for (int qb = 0; qb < 2; ++qb)
#pragma unroll
        for (int db = 0; db < 8; ++db) { o0s[((qb * 8 + db) * 2) * NTHR] = pack2(O[qb][db][0], O[qb][db][1]); o0s[((qb * 8 + db) * 2 + 1) * NTHR] = pack2(O[qb][db][2], O[qb][db][3]); }
    }
  }
  const int lane = tid & 63, l16 = lane & 15, g = lane >> 4;
  const float* sg = p.in[13];
#pragma unroll
  for (int qb = 0; qb < 2; ++qb) {
    float ss = 0.f;
#pragma unroll
    for (int db = 0; db < 8; ++db) {
      const unsigned w0 = o0s[((qb * 8 + db) * 2) * NTHR], w1 = o0s[((qb * 8 + db) * 2 + 1) * NTHR];
      float a0 = bf2f((unsigned short)(w0 & 0xffff)), a1 = bf2f((unsigned short)(w0 >> 16));
      float a2 = bf2f((unsigned short)(w1 & 0xffff)), a3 = bf2f((unsigned short)(w1 >> 16));
      O[qb][db][0] = a0 - lam * O[qb][db][0]; O[qb][db][1] = a1 - lam * O[qb][db][1];
      O[qb][db][2] = a2 - lam * O[qb][db][2]; O[qb][db][3] = a3 - lam * O[qb][db][3];
#pragma unroll
      for (int r = 0; r < 4; ++r) ss += O[qb][db][r] * O[qb][db][r];
    }
    ss += __shfl_xor(ss, 16); ss += __shfl_xor(ss, 32);
    const float sc = rsqrtf(ss * (1.0f / 128.0f) + EPS) * 0.8f;
#pragma unroll
    for (int db = 0; db < 8; ++db)
#pragma unroll
      for (int r = 0; r < 4; ++r) O[qb][db][r] *= sc * sg[16 * db + 4 * g + r];
  }
  attn_store<8>(QA + (size_t)row0 * 512 + h * 128, 512, O);
}

DI void wg_item(char* smem, const Params& p, int item) {
  bf16_t* QD = (bf16_t*)(p.ws + WS_R3);
  const bf16_t* KD = (const bf16_t*)(p.ws + WS_KD);
  const bf16_t* VDt = (const bf16_t*)(p.ws + WS_VDT);
  const float* misc_lut = (const float*)(p.ws + WS_MISC + MS_LUT);
  const int hq = item & 7; const int row0 = (item >> 3) * 256;
  int L, srow0, bg; seq_of_row(row0, L, srow0, bg);
  const int qpos0 = row0 - srow0;
  const int kvh = hq >> 2;
  __syncthreads();
  for (int i = threadIdx.x; i < 257; i += NTHR) ((float*)(smem + ATT_LUT_OFS))[i] = misc_lut[hq * 257 + i];
  __syncthreads();
  float O[2][4][4];
  const int kbeg = max(0, qpos0 - 128), kend = min(L, qpos0 + 256 + 128);
  attn_core<64, AM_WG>(smem, QD + (size_t)row0 * 512 + hq * 64, 512, KD + (size_t)srow0 * 128 + kvh * 64, 128,
                       VDt + chm_index(128, srow0, kvh * 64), L, qpos0, kbeg, kend, 0, p.in[30][hq] * LOG2E, O);
  attn_store<4>(QD + (size_t)row0 * 512 + hq * 64, 512, O);
}

DI void na_item(char* smem, const Params& p, int item) {
  bf16_t* QC = (bf16_t*)(p.ws + WS_R0);
  const bf16_t* KC = (const bf16_t*)(p.ws + WS_R1);
  const bf16_t* VCt = (const bf16_t*)(p.ws + WS_R2);
  const int h = item & 7; const int row0 = (item >> 3) * 256;
  int L, srow0, bg; seq_of_row(row0, L, srow0, bg);
  const int qpos0 = row0 - srow0;
  const int nrows = L >> 6;
  __syncthreads();
  for (int i = threadIdx.x; i < 465; i += NTHR) ((float*)(smem + ATT_LUT_OFS))[i] = p.in[27][h * 465 + i] * LOG2E;
  __syncthreads();
  const int qr0 = qpos0 >> 6;
  const int rs0 = min(max(qr0 - 4, 0), nrows - 8), rs3 = min(max(qr0 + 3 - 4, 0), nrows - 8);
  float O[2][4][4];
  attn_core<64, AM_NA>(smem, QC + (size_t)row0 * 512 + h * 64, 512, KC + (size_t)srow0 * 512 + h * 64, 512,
                       VCt + chm_index(512, srow0, h * 64), L, qpos0, rs0 * 64, (rs3 + 8) * 64, nrows, 0.f, O);
  attn_store<4>(QC + (size_t)row0 * 512 + h * 64, 512, O);
}

DI void mem_attn_tile(char* smem, const Params& p, int layer, int row0) {
  bf16_t* QM = (bf16_t*)(p.ws + WS_QM);
  const bf16_t* MK = (const bf16_t*)(p.ws + WS_MISC + MS_MK) + (size_t)layer * 18 * 256 * 256;
  const bf16_t* MVt = (const bf16_t*)(p.ws + WS_MISC + MS_MVT) + (size_t)layer * 18 * 256 * 256;
  int L, srow0, bg; seq_of_row(row0, L, srow0, bg);
#pragma unroll 1
  for (int h = 0; h < 4; ++h) {
    float O[2][4][4];
    attn_core<64, AM_MEM>(smem, QM + (size_t)row0 * 256 + h * 64, 256, MK + (size_t)bg * 256 * 256 + h * 64, 256,
                          MVt + ((size_t)(bg * 256 + h * 64) << 8), 256, 0, 0, 256, 0, 0.f, O);
    attn_store<4>(QM + (size_t)row0 * 256 + h * 64, 256, O);
  }
}

DI int PADI(int i) { return i + (i >> 5); }
DI float2 cmul(float2 a, float2 b) { return make_float2(a.x * b.x - a.y * b.y, a.x * b.y + a.y * b.x); }
DI float2 cmulc(float2 a, float2 b) { return make_float2(a.x * b.x + a.y * b.y, a.y * b.x - a.x * b.y); }
DI constexpr float C16(int m) { return m == 0 ? 1.f : m == 1 ? 0.92387953251128674f : m == 2 ? 0.70710678118654752f : m == 3 ? 0.38268343236508977f : m == 4 ? 0.f : m == 5 ? -0.38268343236508977f : m == 6 ? -0.70710678118654752f : -0.92387953251128674f; }
DI constexpr float S16(int m) { return m == 0 ? 0.f : m == 1 ? 0.38268343236508977f : m == 2 ? 0.70710678118654752f : m == 3 ? 0.92387953251128674f : m == 4 ? 1.f : m == 5 ? 0.92387953251128674f : m == 6 ? 0.70710678118654752f : 0.38268343236508977f; }

template <int LOGR, int LOGS, bool INV>
DI void fft_pass(float2* buf, int total) {
  constexpr int R = 1 << LOGR;
  constexpr int S = 1 << LOGS;
  const int tid0 = opaque((int)threadIdx.x);
#pragma unroll 1
  for (int u = tid0; u < (total >> LOGR); u += NTHR) {
    const int j = u & (S - 1);
    const int base = ((u >> LOGS) << (LOGS + LOGR)) + j;
    float2* bp = buf + PADI(base);
    float2 x[R];
#pragma unroll
    for (int k = 0; k < R; ++k) x[k] = bp[k * S + ((k * S) >> 5)];
    float2 pw[LOGR];
    {
      const float rev = -(float)j * (1.0f / (float)(R * S));
      pw[0] = make_float2(cos_rev(rev), sin_rev(rev));
#pragma unroll
      for (int i = 1; i < LOGR; ++i) pw[i] = cmul(pw[i - 1], pw[i - 1]);
    }
    if (!INV) {
#pragma unroll
      for (int i = 0; i < LOGR; ++i) {
        const int h = R >> (i + 1);
#pragma unroll
        for (int k = 0; k < R; ++k) {
          if ((k & h) == 0) {
            const int mm = (k & (h - 1)) * 8 / h;
            float2 a = x[k], b = x[k + h];
            x[k] = make_float2(a.x + b.x, a.y + b.y);
            float2 d = make_float2(a.x - b.x, a.y - b.y);
            if (mm != 0) d = cmul(d, make_float2(C16(mm), -S16(mm)));
            x[k + h] = cmul(d, pw[i]);
          }
        }
      }
    } else {
#pragma unroll
      for (int i = LOGR - 1; i >= 0; --i) {
        const int h = R >> (i + 1);
#pragma unroll
        for (int k = 0; k < R; ++k) {
          if ((k & h) == 0) {
            const int mm = (k & (h - 1)) * 8 / h;
            float2 a = x[k];
            float2 d = cmulc(x[k + h], pw[i]);
            if (mm != 0) d = cmulc(d, make_float2(C16(mm), -S16(mm)));
            x[k] = make_float2(a.x + d.x, a.y + d.y);
            x[k + h] = make_float2(a.x - d.x, a.y - d.y);
          }
        }
      }
    }
#pragma unroll
    for (int k = 0; k < R; ++k) bp[k * S + ((k * S) >> 5)] = x[k];
  }
  __syncthreads();
}

template <int LOGN>
DI void fft_fwd(float2* buf, int total) {
  if (LOGN == 14) { fft_pass<4, 10, false>(buf, total); fft_pass<4, 6, false>(buf, total); fft_pass<4, 2, false>(buf, total); fft_pass<2, 0, false>(buf, total); }
  else { fft_pass<4, 7, false>(buf, total); fft_pass<4, 3, false>(buf, total); fft_pass<3, 0, false>(buf, total); }
}
template <int LOGN>
DI void fft_inv(float2* buf, int total) {
  if (LOGN == 14) { fft_pass<2, 0, true>(buf, total); fft_pass<4, 2, true>(buf, total); fft_pass<4, 6, true>(buf, total); fft_pass<4, 10, true>(buf, total); }
  else { fft_pass<3, 0, true>(buf, total); fft_pass<4, 3, true>(buf, total); fft_pass<4, 7, true>(buf, total); }
}

template <int LOGN, int NB, int NSUB>
DI void hyena_item(char* smem, const Params& p, int c, int row_base  ) {
  constexpr int L = 1 << LOGN;
  constexpr int SPT = L / NTHR;
  constexpr int EPT = NB * L / NTHR;
  const int tid = opaque((int)threadIdx.x);
  float2* buf = (float2*)smem;
  float* sm_w3 = (float*)(smem + 135168);
  float* sm_red = sm_w3 + 128;
  char* scr = p.ws + WS_XB + (size_t)blockIdx.x * HY_SCR_PER_BLOCK;
  float* scrF = (float*)scr;
  float* scrB = scrF + L;
  float2* scrY = (float2*)(scr + 128 * 1024);
  float2* scrZ = (float2*)(scr + 256 * 1024);
  float2* scrS = (float2*)(scr + 384 * 1024);
  const bf16_t* UH = (const bf16_t*)p.out;
  bf16_t* OB = (bf16_t*)(p.ws + WS_R1);
  const float* h2 = (const float*)(p.ws + WS_MISC + (LOGN == 14 ? MS_H2P : MS_H2S));
  const float* w3 = p.in[21];
  const float* cw = p.in[14]; const float* cb = p.in[15]; const float* skp = p.in[22];
  const float delta = fabsf(-3.0701134573253945f + (float)c * ((-15.350567286626973f + 3.0701134573253945f) / 511.0f));
  const float invLm1 = 1.0f / (float)(L - 1);

  auto conv3 = [&](int b, int ch, int n) -> float {
    const bf16_t* u = UH + chm_index(1536, row_base + b * L, ch) + n;
    float v = bf2f(u[0]) * cw[1536 + ch] + cb[ch];
    if (n > 0) v += bf2f(u[-1]) * cw[ch];
    if (n < L - 1) v += bf2f(u[1]) * cw[2 * 1536 + ch];
    return v;
  };

#pragma unroll 1
  for (int o = 0; o < 2; ++o) {
    __syncthreads();
    if (tid < 128) sm_w3[tid] = w3[(size_t)(tid & 63) * 2048 + (o * 2 + (tid >> 6)) * 512 + c];
    __syncthreads();
    float asum = 0.f;
#pragma unroll 1
    for (int i = 0; i < SPT; ++i) {
      const int t = tid + NTHR * i;
      const float4* hr = (const float4*)(h2 + (size_t)t * 64);
      float f = 0.f, bk = 0.f;
#pragma unroll 4
      for (int q4 = 0; q4 < 16; ++q4) {
        float4 hv = hr[q4];
        const f32x4 wf = *(const volatile f32x4*)(sm_w3 + 4 * q4);
        const f32x4 wb = *(const volatile f32x4*)(sm_w3 + 64 + 4 * q4);
        f += hv.x * wf.x + hv.y * wf.y + hv.z * wf.z + hv.w * wf.w;
        bk += hv.x * wb.x + hv.y * wb.y + hv.z * wb.z + hv.w * wb.w;
      }
      const float dec = ex2(-(float)t * invLm1 * delta * LOG2E);
      f *= dec; bk *= dec;
      scrF[t] = f; scrB[t] = bk;
      asum += fabsf(f) + (t >= 1 ? fabsf(bk) : 0.f);
    }
#pragma unroll
    for (int s = 32; s >= 1; s >>= 1) asum += __shfl_xor(asum, s);
    if ((tid & 63) == 0) sm_red[tid >> 6] = asum;
    block_sync_global();
    float nrm = 0.f;
#pragma unroll
    for (int w = 0; w < 8; ++w) nrm += sm_red[w];
    const float inv_nrm = 1.0f / nrm;
    const float sk = skp[o * 512 + c];

#pragma unroll 1
    for (int par = 0; par < 2; ++par) {
#pragma unroll 2
      for (int i = 0; i < SPT; ++i) {
        const int n = tid + NTHR * i;
        const float f = scrF[n];
        const float br = (n == 0) ? 0.f : scrB[L - n];
        float2 v;
        if (par == 0) v = make_float2((f + br) * inv_nrm, 0.f);
        else { const float gm = (f - br) * inv_nrm; const float rev = -(float)n / (float)(2 * L); v = make_float2(gm * cos_rev(rev), gm * sin_rev(rev)); }
        buf[PADI(n)] = v;
      }
      __syncthreads();
      fft_fwd<LOGN>(buf, L);
#pragma unroll 2
      for (int i = 0; i < SPT; ++i) scrS[tid + NTHR * i] = buf[PADI(tid + NTHR * i)];
      __syncthreads();
#pragma unroll 1
      for (int sub = 0; sub < NSUB; ++sub) {
#pragma unroll 2
        for (int i = 0; i < EPT; ++i) {
          const int e = tid + NTHR * i; const int f = e >> LOGN, n = e & (L - 1);
          const int pp = sub * NB + f;
          float2 z;
          if (o == 0 && par == 0) { z = make_float2(conv3(2 * pp, c, n), conv3(2 * pp + 1, c, n)); scrZ[(size_t)pp * L + n] = z; }
          else z = scrZ[(size_t)pp * L + n];
          if (par == 1) { const float rev = -(float)n / (float)(2 * L); z = cmul(z, make_float2(cos_rev(rev), sin_rev(rev))); }
          buf[PADI(e)] = z;
        }
        __syncthreads();
        fft_fwd<LOGN>(buf, NB * L);
#pragma unroll 2
        for (int i = 0; i < EPT; ++i) {
          const int e = tid + NTHR * i;
          buf[PADI(e)] = cmul(buf[PADI(e)], scrS[e & (L - 1)]);
        }
        __syncthreads();
        fft_inv<LOGN>(buf, NB * L);
#pragma unroll 2
        for (int i = 0; i < EPT; ++i) {
          const int e = tid + NTHR * i; const int f = e >> LOGN, n = e & (L - 1);
          const int pp = sub * NB + f;
          float2 y = buf[PADI(e)];
          if (par == 0) { scrY[(size_t)pp * L + n] = y; }
          else {
            const float rev = -(float)n / (float)(2 * L);
            y = cmulc(y, make_float2(cos_rev(rev), sin_rev(rev)));
            const float2 ye = scrY[(size_t)pp * L + n];
            const float2 z = scrZ[(size_t)pp * L + n];
            const float sc = 0.5f / (float)L;
            const float c0 = (ye.x + y.x) * sc + sk * z.x;
            const float c1 = (ye.y + y.y) * sc + sk * z.y;
            const int gch = (o == 0 ? 512 : 1024) + c;
            const float z0 = conv3(2 * pp, gch, n) * c0;
            const float z1 = conv3(2 * pp + 1, gch, n) * c1;
            if (o == 0) scrZ[(size_t)pp * L + n] = make_float2(z0, z1);
            else {
              OB[(size_t)(row_base + (2 * pp) * L + n) * 512 + c] = f2bf(z0);
              OB[(size_t)(row_base + (2 * pp + 1) * L + n) * 512 + c] = f2bf(z1);
            }
          }
        }
        __syncthreads();
      }
    }
  }
}

struct WMat { const float* src; int K; int N; const float* gain; bf16_t* dst; };
DI WMat get_wmat(const Params& p, int id) {
  bf16_t* W = (bf16_t*)(p.ws + WS_W);
  WMat m;
  switch (id) {
    case 0: m = {p.in[9], 1024, 3072, p.in[5], W + W_INE}; break;
    case 1: m = {p.in[23], 1024, 1024, nullptr, W + W_OUTE}; break;
    case 2: m = {p.in[24], 1024, 2304, p.in[5] + 1024, W + W_INO}; break;
    case 3: m = {p.in[31], 1024, 1024, nullptr, W + W_OUTO}; break;
    case 4: m = {p.in[32], 1024, 256, p.in[6], W + W_Q}; break;
    case 5: m = {p.in[32] + 1024 * 256, 1024, 256, p.in[6] + 1024, W + W_Q + 256 * 1024}; break;
    case 6: m = {p.in[33], 1024, 512, p.in[7], W + W_KV}; break;
    case 7: m = {p.in[33] + 1024 * 512, 1024, 512, p.in[7] + 1024, W + W_KV + 512 * 1024}; break;
    case 8: m = {p.in[34], 256, 1024, nullptr, W + W_O}; break;
    case 9: m = {p.in[34] + 256 * 1024, 256, 1024, nullptr, W + W_O + 1024 * 256}; break;
    case 10: m = {p.in[37], 1024, 4096, p.in[8], W + W_1}; break;
    case 11: m = {p.in[37] + (size_t)1024 * 4096, 1024, 4096, p.in[8] + 1024, W + W_1 + (size_t)4096 * 1024}; break;
    case 12: m = {p.in[38], 4096, 1024, nullptr, W + W_2}; break;
    default: m = {p.in[38] + (size_t)4096 * 1024, 4096, 1024, nullptr, W + W_2 + (size_t)4096 * 1024}; break;
  }
  return m;
}

DI void prep_wtile(char* smem, const WMat& m, int tile) {
  float* t = (float*)smem;
  const int ntn = m.N >> 6;
  const int k0 = (tile / ntn) << 6, n0 = (tile % ntn) << 6;
  const int tid = threadIdx.x;
  __syncthreads();
  {
    const int kk = tid >> 4, n4 = (tid & 15) * 4;
#pragma unroll
    for (int i = 0; i < 2; ++i) {
      const int k = kk + 32 * i;
      float4 v = *(const float4*)(m.src + (size_t)(k0 + k) * m.N + n0 + n4);
      const float gk = m.gain ? m.gain[k0 + k] : 1.0f;
      t[k * 65 + n4] = v.x * gk; t[k * 65 + n4 + 1] = v.y * gk; t[k * 65 + n4 + 2] = v.z * gk; t[k * 65 + n4 + 3] = v.w * gk;
    }
  }
  __syncthreads();
  {
    const int n = tid >> 3, kc = tid & 7;
    uint4 u;
    u.x = pack2(t[(8 * kc) * 65 + n], t[(8 * kc + 1) * 65 + n]); u.y = pack2(t[(8 * kc + 2) * 65 + n], t[(8 * kc + 3) * 65 + n]);
    u.z = pack2(t[(8 * kc + 4) * 65 + n], t[(8 * kc + 5) * 65 + n]); u.w = pack2(t[(8 * kc + 6) * 65 + n], t[(8 * kc + 7) * 65 + n]);
    *(uint4*)(m.dst + (size_t)(n0 + n) * m.K + k0 + 8 * kc) = u;
  }
}

DI void prep_row(const float* src, bf16_t* dst, float* ssq) {
  const int lane = threadIdx.x & 63;
  float ss = 0.f;
#pragma unroll
  for (int i = 0; i < 4; ++i) {
    float4 v = *(const float4*)(src + (i * 64 + lane) * 4);
    ss += v.x * v.x + v.y * v.y + v.z * v.z + v.w * v.w;
    uint2 u; u.x = pack2(v.x, v.y); u.y = pack2(v.z, v.w);
    *(uint2*)(dst + (i * 64 + lane) * 4) = u;
  }
#pragma unroll
  for (int s = 32; s >= 1; s >>= 1) ss += __shfl_xor(ss, s);
  if (lane == 0) *ssq = ss;
}

DI void prep_h2(const Params& p, int L, int t, float* dst) {
  const int j = threadIdx.x & 63;
  const float* w1 = p.in[16]; const float* b1 = p.in[17]; const float* fr = p.in[18]; const float* w2 = p.in[19]; const float* b2 = p.in[20];
  const float t01 = (float)t / (float)(L - 1);
  const float tl = (float)t / (float)L;
  float a = t01 * w1[j] + b1[j];
#pragma unroll
  for (int k = 0; k < 8; ++k) {
    const float fk = 1e-4f + (float)k * ((7.0f - 1e-4f) / 7.0f);
    const float rev = tl * fk;
    a += cos_rev(rev) * w1[(1 + k) * 64 + j] - sin_rev(rev) * w1[(9 + k) * 64 + j];
  }
  const float h1 = sin_rev(fr[j] * a * 0.15915494309189535f);
  float a2 = b2[j];
  for (int i = 0; i < 64; ++i) a2 += __shfl(h1, i) * w2[i * 64 + j];
  dst[(size_t)t * 64 + j] = sin_rev(fr[64 + j] * a2 * 0.15915494309189535f);
}

constexpr int PREP_NW = 768 + 256 + 576 + 256 + 64 + 64 + 128 + 128 + 64 + 64 + 1024 + 1024 + 1024 + 1024;
constexpr int PREP_T_ROWS = PREP_NW;
constexpr int PREP_T_MEM = PREP_T_ROWS + 8192;
constexpr int PREP_T_H2 = PREP_T_MEM + 576;
constexpr int PREP_T_MISC = PREP_T_H2 + 2304;
constexpr int PREP_TOTAL = PREP_T_MISC + 1;

DI void phase_prep(char* smem, const Params& p) {
  const int tid = threadIdx.x, wave = tid >> 6;
#pragma unroll 1
  for (int task = blockIdx.x; task < PREP_TOTAL; task += gridDim.x) {
    if (task < PREP_NW) {
      int t = task, id = 0;
      for (; id < 14; ++id) { WMat m = get_wmat(p, id); int n = (m.K >> 6) * (m.N >> 6); if (t < n) break; t -= n; }
      WMat m = get_wmat(p, id);
      prep_wtile(smem, m, t);
    } else if (task < PREP_T_MEM) {
      const int row = (task - PREP_T_ROWS) * 8 + wave;
      const float* src = (row < T_P) ? p.in[0] + (size_t)row * DM : p.in[1] + (size_t)(row - T_P) * DM;
      float* RS = (float*)(p.ws + WS_MISC + MS_RS);
      prep_row(src, (bf16_t*)(p.ws + WS_XB) + (size_t)row * DM, RS + row);
      if ((tid & 63) < 5) RS[(size_t)(1 + (tid & 63)) * T_ALL + row] = 0.f;
    } else if (task < PREP_T_H2) {
      const int row = (task - PREP_T_MEM) * 8 + wave;
      const float* src = (row < 512) ? p.in[2] + (size_t)row * DM : p.in[3] + (size_t)(row - 512) * DM;
      prep_row(src, (bf16_t*)(p.ws + WS_R1) + (size_t)row * DM, (float*)(p.ws + WS_MISC + MS_RSM) + row);
    } else if (task < PREP_T_MISC) {
      const int t = (task - PREP_T_H2) * 8 + wave;
      if (t < LP) prep_h2(p, LP, t, (float*)(p.ws + WS_MISC + MS_H2P));
      else prep_h2(p, LS, t - LP, (float*)(p.ws + WS_MISC + MS_H2S));
    } else {
      float* lut = (float*)(p.ws + WS_MISC + MS_LUT);
      for (int i = tid; i < 8 * 257; i += NTHR) {
        const int hh = i / 257, rel = (i % 257) - 128;
        const int n = rel < 0 ? -rel : rel;
        int bkt;
        if (n < 8) bkt = n; else { bkt = 2 + (31 - __clz(n * n)); if (bkt > 15) bkt = 15; }
        if (rel > 0) bkt += 16;
        lut[i] = p.in[4][bkt * 8 + hh] * LOG2E;
      }
      if (tid < 64) {
        const float* lf = p.in[12];
        float a = lf[tid] * lf[64 + tid], b = lf[128 + tid] * lf[192 + tid];
#pragma unroll
        for (int s = 32; s >= 1; s >>= 1) { a += __shfl_xor(a, s); b += __shfl_xor(b, s); }
        if (tid == 0) *(float*)(p.ws + WS_MISC + MS_LAM) = expf(a) - expf(b) + 0.2f;
      }
    }
  }
}

DI Seg seg_inproj(const Params& p, int layer, int col0, const float* rs) {
  Seg s{}; s.rs = rs; s.scale = 1.0f;
  if (layer == 0) {
    if (col0 < 512) { s.type = SEG_NORM; s.dst = (bf16_t*)(p.ws + WS_R0); s.ld = 512; s.col = col0; s.gain = p.in[10]; s.scale = QSCALE; }
    else if (col0 < 1024) { s.type = SEG_NORM; s.dst = (bf16_t*)((char*)p.out + 192 * MiB); s.ld = 512; s.col = col0 - 512; s.gain = p.in[11]; }
    else if (col0 < 1536) { s.type = SEG_CHM; s.dst = (bf16_t*)(p.ws + WS_R2); s.CH = 512; s.col = col0 - 1024; }
    else { s.type = SEG_CHM; s.dst = (bf16_t*)p.out; s.CH = 1536; s.col = col0 - 1536; }
  } else {
    if (col0 < 512) { s.type = SEG_NORM; s.dst = (bf16_t*)(p.ws + WS_R0); s.ld = 512; s.col = col0; s.gain = p.in[25]; s.scale = QSCALE; }
    else if (col0 < 1024) { s.type = SEG_NORM; s.dst = (bf16_t*)(p.ws + WS_R1); s.ld = 512; s.col = col0 - 512; s.gain = p.in[26]; }
    else if (col0 < 1536) { s.type = SEG_CHM; s.dst = (bf16_t*)(p.ws + WS_R2); s.CH = 512; s.col = col0 - 1024; }
    else if (col0 < 2048) { s.type = SEG_NORM; s.dst = (bf16_t*)(p.ws + WS_R3); s.ld = 512; s.col = col0 - 1536; s.gain = p.in[28]; s.scale = QSCALE; }
    else if (col0 < 2176) { s.type = SEG_NORM; s.dst = (bf16_t*)(p.ws + WS_KD); s.ld = 128; s.col = col0 - 2048; s.gain = p.in[29]; }
    else { s.type = SEG_CHM; s.dst = (bf16_t*)(p.ws + WS_VDT); s.CH = 128; s.col = col0 - 2176; }
  }
  return s;
}

DI void phase_inproj(char* smem, const Params& p, int layer) {
  const int NTn = layer == 0 ? 24 : 18;
  const int n_main = 256 * NTn;
  const int n_total = n_main + (layer == 0 ? 144 : 0);
  const bf16_t* W = (const bf16_t*)(p.ws + WS_W);
  const int wn = (threadIdx.x >> 6) & 1;
#pragma unroll 1
  for (int tile = blockIdx.x; tile < n_total; tile += gridDim.x) {
    if (tile < n_main) {
      const int mt = tile / NTn, nt = tile % NTn;
      GemmArgs ga{(const bf16_t*)(p.ws + WS_XB), nullptr, 1 << 30, DM, W + (layer == 0 ? W_INE : W_INO), DM, DM};
      Seg s = seg_inproj(p, layer, nt * 128 + 64 * wn, (const float*)(p.ws + WS_MISC + MS_RS) + (size_t)(layer * 3) * T_ALL);
      s.col -= 64 * wn;
      gemm_tile(smem, ga, mt * 256, nt * 128, s);
    } else {
      const int t2 = tile - n_main; const int l = t2 / 72, r = t2 % 72; const int mt = r >> 2, nt = r & 3;
      GemmArgs ga{(const bf16_t*)(p.ws + WS_R1), nullptr, 1 << 30, DM, W + W_KV + (size_t)l * 512 * 1024, DM, DM};
      Seg s{}; s.rs = (const float*)(p.ws + WS_MISC + MS_RSM); s.scale = 1.0f;
      const int col0 = nt * 128 + 64 * wn;
      if (col0 < 256) { s.type = SEG_NORM; s.dst = (bf16_t*)(p.ws + WS_MISC + MS_MK) + (size_t)l * 18 * 256 * 256; s.ld = 256; s.col = col0 - 64 * wn; s.gain = p.in[36] + l * 64; }
      else { s.type = SEG_CHMEM; s.dst = (bf16_t*)(p.ws + WS_MISC + MS_MVT) + (size_t)l * 18 * 256 * 256; s.col = col0 - 256 - 64 * wn; }
      gemm_tile(smem, ga, mt * 256, nt * 128, s);
    }
  }
}

DI void phase_mixer0(char* smem, const Params& p) {
#pragma unroll 1
  for (int item = blockIdx.x; item < 2048; item += gridDim.x) {
    const int kind = item >> 9, idx = item & 511;
#ifndef SUBP
#define SUBP -1
#endif
    if (kind == 0 || kind == 2) { if (SUBP < 0 || SUBP == 0) diff_item(smem, p, (kind == 2 ? 512 : 0) + idx); }
    else if (kind == 1) { if (SUBP < 0 || SUBP == 1) hyena_item<14, 1, 1>(smem, p, idx, 0); }
    else { if (SUBP < 0 || SUBP == 2) hyena_item<11, 4, 2>(smem, p, idx, T_P); }
  }
}
DI void phase_mixer1(char* smem, const Params& p) {
#pragma unroll 1
  for (int item = blockIdx.x; item < 4096; item += gridDim.x) {
    if (item < 2048) na_item(smem, p, item); else wg_item(smem, p, item - 2048);
  }
}

DI void phase_post(char* smem, const Params& p, int layer) {
  const bf16_t* W = (const bf16_t*)(p.ws + WS_W);
  float* RS = (float*)(p.ws + WS_MISC + MS_RS);
  bf16_t* XB = (bf16_t*)(p.ws + WS_XB);
  bf16_t* H = (bf16_t*)(p.ws + (layer == 0 ? WS_H_L0 : WS_H_L1));
  bf16_t* QM = (bf16_t*)(p.ws + WS_QM);
  const int wn = (threadIdx.x >> 6) & 1;
#pragma unroll 1
  for (int mt = blockIdx.x; mt < 256; mt += gridDim.x) {
    const int m0 = mt * 256;
#ifndef CHAINP
#define CHAINP -1
#endif
    if (CHAINP < 0 || CHAINP == 1) {
      GemmArgs ga{(const bf16_t*)(p.ws + WS_R0), (const bf16_t*)(p.ws + (layer == 0 ? WS_R1 : WS_R3)), 512, 512, W + (layer == 0 ? W_OUTE : W_OUTO), DM, DM};
      Seg s{}; s.type = SEG_RESID; s.xin0 = layer == 0 ? p.in[0] : nullptr; s.xin1 = layer == 0 ? p.in[1] : nullptr;
      s.xout = p.out; s.xb = XB; s.rs_out = RS + (size_t)(layer * 3 + 1) * T_ALL;
      _Pragma("unroll 1") for (int nt = 0; nt < 8; ++nt) { s.col = nt * 128; gemm_tile(smem, ga, m0, nt * 128, s); }
    }
    block_sync_global();
    if (CHAINP < 0 || CHAINP == 2) {
      GemmArgs ga{XB, nullptr, 1 << 30, DM, W + W_Q + (size_t)layer * 256 * 1024, DM, DM};
      Seg s{}; s.type = SEG_NORM; s.rs = RS + (size_t)(layer * 3 + 1) * T_ALL; s.dst = QM; s.ld = 256; s.gain = p.in[35] + layer * 64; s.scale = QSCALE;
      _Pragma("unroll 1") for (int nt = 0; nt < 2; ++nt) { s.col = nt * 128; gemm_tile(smem, ga, m0, nt * 128, s); }
    }
    block_sync_global();
    if (CHAINP < 0 || CHAINP == 3) mem_attn_tile(smem, p, layer, m0);
    block_sync_global();
    if (CHAINP < 0 || CHAINP == 4) {
      GemmArgs ga{QM, nullptr, 1 << 30, 256, W + W_O + (size_t)layer * 1024 * 256, 256, 256};
      Seg s{}; s.type = SEG_RESID; s.xout = p.out; s.xb = XB; s.rs_out = RS + (size_t)(layer * 3 + 2) * T_ALL;
      _Pragma("unroll 1") for (int nt = 0; nt < 8; ++nt) { s.col = nt * 128; gemm_tile(smem, ga, m0, nt * 128, s); }
    }
    block_sync_global();
    if (CHAINP < 0 || CHAINP == 5) _Pragma("unroll 1") for (int hc = 0; hc < 4; ++hc) {
      {
        GemmArgs ga{XB, nullptr, 1 << 30, DM, W + W_1 + (size_t)layer * 4096 * 1024 + (size_t)hc * 1024 * 1024, DM, DM};
        Seg s{}; s.type = SEG_MLP1; s.rs = RS + (size_t)(layer * 3 + 2) * T_ALL; s.dst = H; s.ld = 1024;
        _Pragma("unroll 1") for (int nt = 0; nt < 8; ++nt) { s.col = nt * 128; gemm_tile(smem, ga, m0, nt * 128, s); }
      }
      block_sync_global();
      {
        GemmArgs ga{H, nullptr, 1 << 30, 1024, W + W_2 + (size_t)layer * 4096 * 1024 + (size_t)hc * 1024, 4096, 1024};
        Seg s{}; s.type = SEG_RESID; s.xout = p.out;
        if (hc == 3 && layer == 0) { s.xb = XB; s.rs_out = RS + (size_t)3 * T_ALL; }
        _Pragma("unroll 1") for (int nt = 0; nt < 8; ++nt) { s.col = nt * 128; gemm_tile(smem, ga, m0, nt * 128, s); }
      }
      block_sync_global();
    }
  }
  (void)wn;
}

__global__ void __launch_bounds__(NTHR) fwd_kernel(Params p, int ph_lo, int ph_hi) {
  extern __shared__ __attribute__((aligned(16))) char smem[];
#define RUN_PHASE(i_, call_) if (ph_lo <= (i_) && (i_) <= ph_hi) { if ((i_) > ph_lo) { __threadfence(); cg::this_grid().sync(); } call_; }
  RUN_PHASE(0, phase_prep(smem, p))
  RUN_PHASE(1, phase_inproj(smem, p, 0))
  RUN_PHASE(2, phase_mixer0(smem, p))
  RUN_PHASE(3, phase_post(smem, p, 0))
  RUN_PHASE(4, phase_inproj(smem, p, 1))
  RUN_PHASE(5, phase_mixer1(smem, p))
  RUN_PHASE(6, phase_post(smem, p, 1))
}

#ifndef ONE_LAUNCH
#define ONE_LAUNCH 1
#endif

extern "C" void kernel_launch(void* const* d_in, const int* in_sizes, int n_in, void* d_out, int out_size, void* d_ws, size_t ws_size,
                              hipStream_t stream) {
  static int grid = 0;
  if (grid == 0) {
    if (n_in != 39 || ws_size < WS_NEED || out_size != T_ALL * DM) { fprintf(stderr, "kernel_launch: unexpected shapes n_in %d ws %zu out %d\n", n_in, ws_size, out_size); grid = -1; return; }
    if (hipFuncSetAttribute((const void*)fwd_kernel, hipFuncAttributeMaxDynamicSharedMemorySize, SMEM_BYTES) != hipSuccess) { fprintf(stderr, "hipFuncSetAttribute failed\n"); grid = -1; return; }
    int dev = 0, cus = 0, per_cu = 0;
    hipGetDevice(&dev);
    hipDeviceGetAttribute(&cus, hipDeviceAttributeMultiprocessorCount, dev);
    hipOccupancyMaxActiveBlocksPerMultiprocessor(&per_cu, (const void*)fwd_kernel, NTHR, SMEM_BYTES);
    if (per_cu < 1 || cus < 1) { fprintf(stderr, "occupancy query: %d blocks/CU, %d CUs\n", per_cu, cus); grid = -1; return; }
    grid = cus;
  }
  if (grid < 0) return;
  Params p{};
  for (int i = 0; i < 39; ++i) p.in[i] = (const float*)d_in[i];
  p.out = (float*)d_out; p.ws = (char*)d_ws;
#if ONE_LAUNCH
  int lo = 0, hi = 6;
  void* args[] = {&p, &lo, &hi};
  hipError_t e = hipLaunchCooperativeKernel((const void*)fwd_kernel, dim3(grid), dim3(NTHR), args, SMEM_BYTES, stream);
  if (e != hipSuccess) fprintf(stderr, "cooperative launch failed: %s\n", hipGetErrorString(e));
#else
  for (int ph = 0; ph <= 6; ++ph) hipLaunchKernelGGL(fwd_kernel, dim3(grid), dim3(NTHR), SMEM_BYTES, stream, p, ph, ph);
#endif
}
```

```cpp
#include <hip/hip_runtime.h>
#include <hip/hip_cooperative_groups.h>
#include <cstdio>
namespace cg = cooperative_groups;

#define DI __device__ __forceinline__
#define PROBE 0
typedef unsigned short bf16_t;
using bf16x8 = __attribute__((ext_vector_type(8))) short;
using s16x4 = __attribute__((ext_vector_type(4))) short;
using f32x4 = __attribute__((ext_vector_type(4))) float;
#define MFMA16(a, b, c) __builtin_amdgcn_mfma_f32_16x16x32_bf16((a), (b), (c), 0, 0, 0)

constexpr int NTHR = 512;
constexpr int T_ALL = 65536;
constexpr int T_P = 32768;
constexpr int LP = 16384, LS = 2048;
constexpr int DM = 1024;
constexpr float EPS = 1e-6f;
constexpr float LOG2E = 1.4426950408889634f;
constexpr float QSCALE = 0.125f * 1.4426950408889634f;
constexpr int SMEM_BYTES = 144 * 1024;
constexpr size_t MiB = (size_t)1 << 20;

constexpr size_t WS_XB = 0;
constexpr size_t WS_W = 128 * MiB;
constexpr size_t W_INE = 0;
constexpr size_t W_OUTE = W_INE + (size_t)3072 * 1024;
constexpr size_t W_INO = W_OUTE + (size_t)1024 * 1024;
constexpr size_t W_OUTO = W_INO + (size_t)2304 * 1024;
constexpr size_t W_Q = W_OUTO + (size_t)1024 * 1024;
constexpr size_t W_KV = W_Q + (size_t)2 * 256 * 1024;
constexpr size_t W_O = W_KV + (size_t)2 * 512 * 1024;
constexpr size_t W_1 = W_O + (size_t)2 * 1024 * 256;
constexpr size_t W_2 = W_1 + (size_t)2 * 4096 * 1024;
constexpr size_t W_END = W_2 + (size_t)2 * 4096 * 1024;
static_assert(W_END * 2 <= 51 * MiB, "weights");
constexpr size_t WS_MISC = 179 * MiB;
constexpr size_t MS_RS = 0;
constexpr size_t MS_RSM = MS_RS + (size_t)6 * T_ALL * 4;
constexpr size_t MS_MK = MS_RSM + 32768;
constexpr size_t MS_MVT = MS_MK + (size_t)2 * 18 * 256 * 256 * 2;
constexpr size_t MS_H2P = MS_MVT + (size_t)2 * 18 * 256 * 256 * 2;
constexpr size_t MS_H2S = MS_H2P + (size_t)LP * 64 * 4;
constexpr size_t MS_LUT = MS_H2S + (size_t)LS * 64 * 4;
constexpr size_t MS_LAM = MS_LUT + 16384;
constexpr size_t MS_END = MS_LAM + 256;
static_assert(MS_END <= 16 * MiB, "misc");
constexpr size_t WS_R0 = 195 * MiB;
constexpr size_t WS_R1 = 259 * MiB;
constexpr size_t WS_R2 = 323 * MiB;
constexpr size_t WS_R3 = 387 * MiB;
constexpr size_t WS_KD = 451 * MiB;
constexpr size_t WS_VDT = 467 * MiB;
constexpr size_t WS_QM = 451 * MiB;
constexpr size_t WS_H_L0 = 323 * MiB;
constexpr size_t WS_H_L1 = 259 * MiB;
constexpr size_t WS_NEED = 512 * MiB;
constexpr size_t HY_SCR_PER_BLOCK = 512 * 1024;

struct Params {
  const float* in[39];
  float* out;
  char* ws;
};

DI unsigned short f2bf(float x) { unsigned u = __float_as_uint(x); u += 0x7fffu + ((u >> 16) & 1u); return (unsigned short)(u >> 16); }
DI unsigned pack2(float a, float b) { return (unsigned)f2bf(a) | ((unsigned)f2bf(b) << 16); }
DI float bf2f(unsigned short h) { return __uint_as_float(((unsigned)h) << 16); }
DI float ex2(float x) { return __builtin_amdgcn_exp2f(x); }
DI float sin_rev(float r) { return __builtin_amdgcn_sinf(r); }
DI float cos_rev(float r) { return __builtin_amdgcn_cosf(r); }
DI int opaque(int x) { asm volatile("" : "+v"(x)); return x; }
DI void block_sync_global() { __syncthreads(); }

DI size_t chm_index(int CH, int row, int ch) {
  if (row < T_P) { int b = row >> 14, t = row & (LP - 1); return ((size_t)(b * CH + ch) << 14) + t; }
  int r = row - T_P; int b = r >> 11, t = r & (LS - 1);
  return (size_t)T_P * CH + ((size_t)(b * CH + ch) << 11) + t;
}

struct GemmArgs {
  const bf16_t* A0; const bf16_t* A1; int ksplit; int lda;
  const bf16_t* Wt; int ldw; int K;
};
enum { SEG_NORM = 0, SEG_CHM = 1, SEG_CHMEM = 2, SEG_RESID = 3, SEG_MLP1 = 4 };
struct Seg {
  int type;
  bf16_t* dst; int ld; int col;
  const float* gain; float scale;
  int CH;
  const float* rs;
  const float* xin0; const float* xin1; float* xout; bf16_t* xb; float* rs_out;
};
constexpr int G_STAGE = (256 + 128) * 144;

DI void gemm_tile(char* smem, const GemmArgs& ga, int m0, int n0, const Seg& sg) {
  const int tid = opaque((int)threadIdx.x), lane = tid & 63, wave = tid >> 6;
  const int l16 = lane & 15, g = lane >> 4;
  const int wm = wave >> 1, wn = wave & 1;
  f32x4 acc[4][4];
#pragma unroll
  for (int i = 0; i < 4; ++i)
#pragma unroll
    for (int j = 0; j < 4; ++j) acc[i][j] = (f32x4){0.f, 0.f, 0.f, 0.f};
  const int lrow = tid >> 3, lkc = tid & 7;
  uint4 ra[4], rb[2];
  const int KT = ga.K >> 6;
  {
    const bf16_t* Ab = (0 < ga.ksplit) ? ga.A0 : ga.A1;
#pragma unroll
    for (int i = 0; i < 4; ++i) ra[i] = *(const uint4*)(Ab + (size_t)(m0 + lrow + 64 * i) * ga.lda + 8 * lkc);
#pragma unroll
    for (int i = 0; i < 2; ++i) rb[i] = *(const uint4*)(ga.Wt + (size_t)(n0 + lrow + 64 * i) * ga.ldw + 8 * lkc);
  }
  {
    char* As = smem; char* Bs = As + 256 * 144;
#pragma unroll
    for (int i = 0; i < 4; ++i) *(uint4*)(As + (lrow + 64 * i) * 144 + lkc * 16) = ra[i];
#pragma unroll
    for (int i = 0; i < 2; ++i) *(uint4*)(Bs + (lrow + 64 * i) * 144 + lkc * 16) = rb[i];
  }
  __syncthreads();
  for (int kt = 0; kt < KT; ++kt) {
    const int buf = kt & 1;
    if (kt + 1 < KT) {
      const int k0 = (kt + 1) << 6;
      const bf16_t* Ab = (k0 < ga.ksplit) ? ga.A0 + k0 : ga.A1 + (k0 - ga.ksplit);
#pragma unroll
      for (int i = 0; i < 4; ++i) ra[i] = *(const uint4*)(Ab + (size_t)(m0 + lrow + 64 * i) * ga.lda + 8 * lkc);
#pragma unroll
      for (int i = 0; i < 2; ++i) rb[i] = *(const uint4*)(ga.Wt + (size_t)(n0 + lrow + 64 * i) * ga.ldw + k0 + 8 * lkc);
    }
    const char* As = smem + buf * G_STAGE; const char* Bs = As + 256 * 144;
#pragma unroll
    for (int ks = 0; ks < 2; ++ks) {
      bf16x8 af[4], bfr[4];
#pragma unroll
      for (int mb = 0; mb < 4; ++mb) af[mb] = *(const bf16x8*)(As + (64 * wm + 16 * mb + l16) * 144 + (32 * ks + 8 * g) * 2);
#pragma unroll
      for (int nb = 0; nb < 4; ++nb) bfr[nb] = *(const bf16x8*)(Bs + (64 * wn + 16 * nb + l16) * 144 + (32 * ks + 8 * g) * 2);
#pragma unroll
      for (int mb = 0; mb < 4; ++mb)
#pragma unroll
        for (int nb = 0; nb < 4; ++nb) acc[mb][nb] = MFMA16(af[mb], bfr[nb], acc[mb][nb]);
    }
    if (kt + 1 < KT) {
      char* As2 = smem + (buf ^ 1) * G_STAGE; char* Bs2 = As2 + 256 * 144;
#pragma unroll
      for (int i = 0; i < 4; ++i) *(uint4*)(As2 + (lrow + 64 * i) * 144 + lkc * 16) = ra[i];
#pragma unroll
      for (int i = 0; i < 2; ++i) *(uint4*)(Bs2 + (lrow + 64 * i) * 144 + lkc * 16) = rb[i];
    }
    __syncthreads();
  }
  const int rbase = m0 + 64 * wm + 4 * g;
  const int lcb = 64 * wn + l16;
  if (sg.rs) {
#pragma unroll
    for (int mb = 0; mb < 4; ++mb)
#pragma unroll
      for (int r = 0; r < 4; ++r) {
        float s = rsqrtf(sg.rs[rbase + 16 * mb + r] * (1.0f / 1024.0f) + EPS);
#pragma unroll
        for (int nb = 0; nb < 4; ++nb) acc[mb][nb][r] *= s;
      }
  }
  if (sg.type == SEG_NORM) {
    float gn[4];
#pragma unroll
    for (int nb = 0; nb < 4; ++nb) gn[nb] = sg.gain[16 * nb + l16] * sg.scale;
#pragma unroll
    for (int mb = 0; mb < 4; ++mb)
#pragma unroll
      for (int r = 0; r < 4; ++r) {
        float ss = 0.f;
#pragma unroll
        for (int nb = 0; nb < 4; ++nb) ss += acc[mb][nb][r] * acc[mb][nb][r];
        ss += __shfl_xor(ss, 1); ss += __shfl_xor(ss, 2); ss += __shfl_xor(ss, 4); ss += __shfl_xor(ss, 8);
        float sc = rsqrtf(ss * (1.0f / 64.0f) + EPS);
        bf16_t* d = sg.dst + (size_t)(rbase + 16 * mb + r) * sg.ld + sg.col + lcb;
#pragma unroll
        for (int nb = 0; nb < 4; ++nb) d[16 * nb] = f2bf(acc[mb][nb][r] * sc * gn[nb]);
      }
  } else if (sg.type == SEG_CHM || sg.type == SEG_CHMEM) {
#pragma unroll
    for (int mb = 0; mb < 4; ++mb)
#pragma unroll
      for (int nb = 0; nb < 4; ++nb) {
        int row = rbase + 16 * mb; int ch = sg.col + lcb + 16 * nb;
        size_t off;
        if (sg.type == SEG_CHM) off = chm_index(sg.CH, row, ch);
        else off = ((size_t)((row >> 8) * 256 + ch) << 8) + (row & 255);
        uint2 v; v.x = pack2(acc[mb][nb][0], acc[mb][nb][1]); v.y = pack2(acc[mb][nb][2], acc[mb][nb][3]);
        *(uint2*)(sg.dst + off) = v;
      }
  } else {
    float* Cs = (float*)smem;
#pragma unroll
    for (int mb = 0; mb < 4; ++mb)
#pragma unroll
      for (int nb = 0; nb < 4; ++nb)
#pragma unroll
        for (int r = 0; r < 4; ++r) Cs[(64 * wm + 16 * mb + 4 * g + r) * 132 + 64 * wn + 16 * nb + l16] = acc[mb][nb][r];
    __syncthreads();
    const int rr = tid >> 5, c4 = (tid & 31) * 4;
#pragma unroll 2
    for (int it = 0; it < 16; ++it) {
      const int lr = it * 16 + rr; const int row = m0 + lr;
      f32x4 v = *(const f32x4*)(Cs + lr * 132 + c4);
      if (sg.type == SEG_MLP1) {
        v[0] = fmaxf(v[0], 0.f); v[1] = fmaxf(v[1], 0.f); v[2] = fmaxf(v[2], 0.f); v[3] = fmaxf(v[3], 0.f);
        uint2 u; u.x = pack2(v[0] * v[0], v[1] * v[1]); u.y = pack2(v[2] * v[2], v[3] * v[3]);
        *(uint2*)(sg.dst + (size_t)row * sg.ld + sg.col + c4) = u;
      } else {
        const float* xo;
        if (sg.xin0) xo = (row < T_P) ? sg.xin0 + (size_t)row * DM : sg.xin1 + (size_t)(row - T_P) * DM;
        else xo = sg.xout + (size_t)row * DM;
        const f32x4 x = *(const f32x4*)(xo + sg.col + c4);
        v += x;
        *(f32x4*)(sg.xout + (size_t)row * DM + sg.col + c4) = v;
        if (sg.xb) { uint2 u; u.x = pack2(v[0], v[1]); u.y = pack2(v[2], v[3]); *(uint2*)(sg.xb + (size_t)row * DM + sg.col + c4) = u; }
        if (sg.rs_out) {
          float ss = v[0] * v[0] + v[1] * v[1] + v[2] * v[2] + v[3] * v[3];
          ss += __shfl_xor(ss, 1); ss += __shfl_xor(ss, 2); ss += __shfl_xor(ss, 4); ss += __shfl_xor(ss, 8); ss += __shfl_xor(ss, 16);
          if ((tid & 31) == 0) atomicAdd(sg.rs_out + row, ss);
        }
      }
    }
    __syncthreads();
  }
}

enum { AM_MEM = 0, AM_DIFF = 1, AM_WG = 2, AM_NA = 3 };
constexpr int ATT_LUT_OFS = 2 * (64 + 128) * 144;

template <int VD, int MODE>
DI void attn_core(char* smem, const bf16_t* Q, int ldq, const bf16_t* K, int ldk, const bf16_t* Vt, int ldv,
                  int qpos0, int kbeg, int kend, int nrows, float sink_l2, float (&O)[2][VD / 16][4]) {
  constexpr int NDB = VD / 16;
  constexpr int STAGE = (64 + VD) * 144;
  const int tid = opaque((int)threadIdx.x), lane = tid & 63, wave = tid >> 6;
  const int l16 = lane & 15, g = lane >> 4;
  const float* lut = (const float*)(smem + ATT_LUT_OFS);
  bf16x8 qf[2][2];
#pragma unroll
  for (int qb = 0; qb < 2; ++qb)
#pragma unroll
    for (int kk = 0; kk < 2; ++kk) qf[qb][kk] = *(const bf16x8*)(Q + (size_t)(32 * wave + 16 * qb + l16) * ldq + 32 * kk + 8 * g);
  float m[2] = {-1e30f, -1e30f}, l[2] = {0.f, 0.f};
#pragma unroll
  for (int qb = 0; qb < 2; ++qb)
#pragma unroll
    for (int db = 0; db < NDB; ++db)
#pragma unroll
      for (int r = 0; r < 4; ++r) O[qb][db][r] = 0.f;
  const int wq0 = qpos0 + 32 * wave;
  const int lrow = tid >> 3, lc = tid & 7;
  uint4 rk, rv0, rv1;
  rv1 = make_uint4(0, 0, 0, 0);
#define ATT_GLOAD(k0_) do { \
    rk = *(const uint4*)(K + (size_t)((k0_) + lrow) * ldk + 8 * lc); \
    rv0 = *(const uint4*)(Vt + (size_t)(lrow) * ldv + (k0_) + 8 * lc); \
    if (VD == 128) rv1 = *(const uint4*)(Vt + (size_t)(lrow + 64) * ldv + (k0_) + 8 * lc); } while (0)
#define ATT_SWRITE(buf_) do { \
    char* Ks_ = smem + (buf_) * STAGE; char* Vs_ = Ks_ + 64 * 144; \
    *(uint4*)(Ks_ + lrow * 144 + lc * 16) = rk; \
    *(uint4*)(Vs_ + lrow * 144 + lc * 16) = rv0; \
    if (VD == 128) *(uint4*)(Vs_ + (lrow + 64) * 144 + lc * 16) = rv1; } while (0)
  ATT_GLOAD(kbeg); ATT_SWRITE(0);
  __syncthreads();
  int it = 0;
  for (int k0 = kbeg; k0 < kend; k0 += 64, ++it) {
    const int buf = it & 1;
    const bool more = (k0 + 64 < kend);
    if (more) ATT_GLOAD(k0 + 64);
    const char* Ks = smem + buf * STAGE; const char* Vs = Ks + 64 * 144;
    bool active = true;
    if (MODE == AM_WG) active = !(k0 + 63 < wq0 - 128 || k0 > wq0 + 31 + 128);
    int na_rs = 0; const int qr = wq0 >> 6, kr = k0 >> 6;
    if (MODE == AM_NA) { na_rs = min(max(qr - 4, 0), nrows - 8); active = (kr >= na_rs && kr < na_rs + 8); }
    if (active) {
      f32x4 S[2][4];
#pragma unroll
      for (int kb = 0; kb < 4; ++kb) {
        bf16x8 kf0 = *(const bf16x8*)(Ks + (16 * kb + l16) * 144 + (8 * g) * 2);
        bf16x8 kf1 = *(const bf16x8*)(Ks + (16 * kb + l16) * 144 + (32 + 8 * g) * 2);
#pragma unroll
        for (int qb = 0; qb < 2; ++qb) {
          f32x4 z = (f32x4){0.f, 0.f, 0.f, 0.f};
          z = MFMA16(kf0, qf[qb][0], z);
          S[qb][kb] = MFMA16(kf1, qf[qb][1], z);
        }
      }
#pragma unroll
      for (int qb = 0; qb < 2; ++qb) {
        const int q = wq0 + 16 * qb + l16;
        if (MODE == AM_DIFF || MODE == AM_WG) {
          if (MODE == AM_DIFF && k0 + 63 - wq0 <= -128) {
            const float c = lut[0];
#pragma unroll
            for (int kb = 0; kb < 4; ++kb)
#pragma unroll
              for (int r = 0; r < 4; ++r) S[qb][kb][r] += c;
          } else if (MODE == AM_DIFF && k0 - (wq0 + 31) >= 128) {
            const float c = lut[256];
#pragma unroll
            for (int kb = 0; kb < 4; ++kb)
#pragma unroll
              for (int r = 0; r < 4; ++r) S[qb][kb][r] += c;
          } else {
#pragma unroll
            for (int kb = 0; kb < 4; ++kb)
#pragma unroll
              for (int r = 0; r < 4; ++r) {
                const int rel = k0 + 16 * kb + 4 * g + r - q;
                const int rc = min(max(rel, -128), 128);
                float s = S[qb][kb][r] + lut[rc + 128];
                if (MODE == AM_WG && (rel > 128 || rel < -128)) s = -1e30f;
                S[qb][kb][r] = s;
              }
          }
        } else if (MODE == AM_NA) {
          const int qc = q & 63;
          const int cs = min(max(qc - 8, 0), 48);
          const int dr = kr - qr + 7;
#pragma unroll
          for (int kb = 0; kb < 4; ++kb)
#pragma unroll
            for (int r = 0; r < 4; ++r) {
              const int kc = 16 * kb + 4 * g + r;
              const bool ok = (kc >= cs) && (kc < cs + 16);
              const int dc = min(max(kc - qc + 15, 0), 30);
              float s = S[qb][kb][r] + lut[dr * 31 + dc];
              S[qb][kb][r] = ok ? s : -1e30f;
            }
        }
      }
#pragma unroll
      for (int qb = 0; qb < 2; ++qb) {
        float mx = -1e30f;
#pragma unroll
        for (int kb = 0; kb < 4; ++kb)
#pragma unroll
          for (int r = 0; r < 4; ++r) mx = fmaxf(mx, S[qb][kb][r]);
        mx = fmaxf(mx, __shfl_xor(mx, 16)); mx = fmaxf(mx, __shfl_xor(mx, 32));
        const float mn = fmaxf(m[qb], mx);
        const float alpha = ex2(m[qb] - mn);
        m[qb] = mn;
        float ps = 0.f;
#pragma unroll
        for (int kb = 0; kb < 4; ++kb)
#pragma unroll
          for (int r = 0; r < 4; ++r) { float p = ex2(S[qb][kb][r] - mn); S[qb][kb][r] = p; ps += p; }
        l[qb] = l[qb] * alpha + ps;
#pragma unroll
        for (int db = 0; db < NDB; ++db)
#pragma unroll
          for (int r = 0; r < 4; ++r) O[qb][db][r] *= alpha;
      }
#pragma unroll
      for (int ks = 0; ks < 2; ++ks) {
        bf16x8 pf[2];
#pragma unroll
        for (int qb = 0; qb < 2; ++qb) {
          uint4 u;
          u.x = pack2(S[qb][2 * ks][0], S[qb][2 * ks][1]); u.y = pack2(S[qb][2 * ks][2], S[qb][2 * ks][3]);
          u.z = pack2(S[qb][2 * ks + 1][0], S[qb][2 * ks + 1][1]); u.w = pack2(S[qb][2 * ks + 1][2], S[qb][2 * ks + 1][3]);
          pf[qb] = __builtin_bit_cast(bf16x8, u);
        }
#pragma unroll
        for (int db = 0; db < NDB; ++db) {
          const char* vrow = Vs + (16 * db + l16) * 144 + (32 * ks + 4 * g) * 2;
          uint2 v0 = *(const uint2*)(vrow);
          uint2 v1 = *(const uint2*)(vrow + 32);
          uint4 u; u.x = v0.x; u.y = v0.y; u.z = v1.x; u.w = v1.y;
          bf16x8 vf = __builtin_bit_cast(bf16x8, u);
#pragma unroll
          for (int qb = 0; qb < 2; ++qb) {
            f32x4 o = (f32x4){O[qb][db][0], O[qb][db][1], O[qb][db][2], O[qb][db][3]};
            o = MFMA16(vf, pf[qb], o);
            O[qb][db][0] = o[0]; O[qb][db][1] = o[1]; O[qb][db][2] = o[2]; O[qb][db][3] = o[3];
          }
        }
      }
    }
    if (more) ATT_SWRITE(buf ^ 1);
    __syncthreads();
  }
#pragma unroll
  for (int qb = 0; qb < 2; ++qb) {
    float lt = l[qb];
    lt += __shfl_xor(lt, 16); lt += __shfl_xor(lt, 32);
    if (MODE == AM_WG) lt += ex2(sink_l2 - m[qb]);
    const float inv = 1.0f / lt;
#pragma unroll
    for (int db = 0; db < NDB; ++db)
#pragma unroll
      for (int r = 0; r < 4; ++r) O[qb][db][r] *= inv;
  }
}

template <int NDB>
DI void attn_store(bf16_t* dst, int ld, const float (&O)[2][NDB][4]) {
  const int lane = threadIdx.x & 63, wave = threadIdx.x >> 6, l16 = lane & 15, g = lane >> 4;
#pragma unroll
  for (int qb = 0; qb < 2; ++qb)
#pragma unroll
    for (int db = 0; db < NDB; ++db) {
      uint2 v; v.x = pack2(O[qb][db][0], O[qb][db][1]); v.y = pack2(O[qb][db][2], O[qb][db][3]);
      *(uint2*)(dst + (size_t)(32 * wave + 16 * qb + l16) * ld + 16 * db + 4 * g) = v;
    }
}

DI void seq_of_row(int row0, int& L, int& seq_row0, int& b_glob) {
  if (row0 < T_P) { L = LP; int b = row0 >> 14; seq_row0 = b << 14; b_glob = b; }
  else { L = LS; int b = (row0 - T_P) >> 11; seq_row0 = T_P + (b << 11); b_glob = 2 + b; }
}

DI void diff_item(char* smem, const Params& p, int item, bool dry = false) {
  bf16_t* QA = (bf16_t*)(p.ws + WS_R0);
  const bf16_t* KA = (const bf16_t*)((const char*)p.out + 192 * MiB);
  const bf16_t* VAt = (const bf16_t*)(p.ws + WS_R2);
  const float* misc_lut = (const float*)(p.ws + WS_MISC + MS_LUT);
  const float lam = *(const float*)(p.ws + WS_MISC + MS_LAM);
  int h, row0;
  if (item < 512) { h = item & 3; row0 = (item >> 2) * 256; }
  else { int i2 = item - 512; h = i2 & 3; row0 = T_P + (i2 >> 2) * 256; }
  int L, srow0, bg; seq_of_row(row0, L, srow0, bg);
  const int qpos0 = row0 - srow0;
  const bf16_t* Vt = VAt + chm_index(512, srow0, h * 128);
  float O[2][8][4];
  unsigned* o0s = (unsigned*)(smem + 57344) + threadIdx.x;
  const int tid = threadIdx.x;
#pragma unroll 1
  for (int mp = 0; mp < 2; ++mp) {
    __syncthreads();
    for (int i = tid; i < 257; i += NTHR) ((float*)(smem + ATT_LUT_OFS))[i] = misc_lut[(h * 2 + mp) * 257 + i];
    __syncthreads();
    attn_core<128, AM_DIFF>(smem, QA + (size_t)row0 * 512 + h * 128 + mp * 64, 512, KA + (size_t)srow0 * 512 + h * 128 + mp * 64, 512,
                            Vt, L, qpos0, 0, L, 0, 0.f, O);
    if (mp == 0) {
#pragma unroll
      for (int qb = 0; qb < 2; ++qb)
#pragma unroll
        for (int db = 0; db < 8; ++db) { o0s[((qb * 8 + db) * 2) * NTHR] = pack2(O[qb][db][0], O[qb][db][1]); o0s[((qb * 8 + db) * 2 + 1) * NTHR] = pack2(O[qb][db][2], O[qb][db][3]); }
    }
  }
  const int lane = tid & 63, l16 = lane & 15, g = lane >> 4;
  const float* sg = p.in[13];
#pragma unroll
  for (int qb = 0; qb < 2; ++qb) {
    float ss = 0.f;
#pragma unroll
    for (int db = 0; db < 8; ++db) {
      const unsigned w0 = o0s[((qb * 8 + db) * 2) * NTHR], w1 = o0s[((qb * 8 + db) * 2 + 1) * NTHR];
      float a0 = bf2f((unsigned short)(w0 & 0xffff)), a1 = bf2f((unsigned short)(w0 >> 16));
      float a2 = bf2f((unsigned short)(w1 & 0xffff)), a3 = bf2f((unsigned short)(w1 >> 16));
      O[qb][db][0] = a0 - lam * O[qb][db][0]; O[qb][db][1] = a1 - lam * O[qb][db][1];
      O[qb][db][2] = a2 - lam * O[qb][db][2]; O[qb][db][3] = a3 - lam * O[qb][db][3];
#pragma unroll
      for (int r = 0; r < 4; ++r) ss += O[qb][db][r] * O[qb][db][r];
    }
    ss += __shfl_xor(ss, 16); ss += __shfl_xor(ss, 32);
    const float sc = rsqrtf(ss * (1.0f / 128.0f) + EPS) * 0.8f;
#pragma unroll
    for (int db = 0; db < 8; ++db)
#pragma unroll
      for (int r = 0; r < 4; ++r) O[qb][db][r] *= sc * sg[16 * db + 4 * g + r];
  }
  if (dry) attn_store<8>((bf16_t*)(p.ws + WS_R3), 512, O); else attn_store<8>(QA + (size_t)row0 * 512 + h * 128, 512, O);
}

DI void wg_item(char* smem, const Params& p, int item, bool dry = false) {
  bf16_t* QD = (bf16_t*)(p.ws + WS_R3);
  const bf16_t* KD = (const bf16_t*)(p.ws + WS_KD);
  const bf16_t* VDt = (const bf16_t*)(p.ws + WS_VDT);
  const float* misc_lut = (const float*)(p.ws + WS_MISC + MS_LUT);
  const int hq = item & 7; const int row0 = (item >> 3) * 256;
  int L, srow0, bg; seq_of_row(row0, L, srow0, bg);
  const int qpos0 = row0 - srow0;
  const int kvh = hq >> 2;
  __syncthreads();
  for (int i = threadIdx.x; i < 257; i += NTHR) ((float*)(smem + ATT_LUT_OFS))[i] = misc_lut[hq * 257 + i];
  __syncthreads();
  float O[2][4][4];
  const int kbeg = max(0, qpos0 - 128), kend = min(L, qpos0 + 256 + 128);
  attn_core<64, AM_WG>(smem, QD + (size_t)row0 * 512 + hq * 64, 512, KD + (size_t)srow0 * 128 + kvh * 64, 128,
                       VDt + chm_index(128, srow0, kvh * 64), L, qpos0, kbeg, kend, 0, p.in[30][hq] * LOG2E, O);
  if (dry) attn_store<4>((bf16_t*)(p.ws + 484 * MiB), 512, O); else attn_store<4>(QD + (size_t)row0 * 512 + hq * 64, 512, O);
}

DI void na_item(char* smem, const Params& p, int item, bool dry = false) {
  bf16_t* QC = (bf16_t*)(p.ws + WS_R0);
  const bf16_t* KC = (const bf16_t*)(p.ws + WS_R1);
  const bf16_t* VCt = (const bf16_t*)(p.ws + WS_R2);
  const int h = item & 7; const int row0 = (item >> 3) * 256;
  int L, srow0, bg; seq_of_row(row0, L, srow0, bg);
  const int qpos0 = row0 - srow0;
  const int nrows = L >> 6;
  __syncthreads();
  for (int i = threadIdx.x; i < 465; i += NTHR) ((float*)(smem + ATT_LUT_OFS))[i] = p.in[27][h * 465 + i] * LOG2E;
  __syncthreads();
  const int qr0 = qpos0 >> 6;
  const int rs0 = min(max(qr0 - 4, 0), nrows - 8), rs3 = min(max(qr0 + 3 - 4, 0), nrows - 8);
  float O[2][4][4];
  attn_core<64, AM_NA>(smem, QC + (size_t)row0 * 512 + h * 64, 512, KC + (size_t)srow0 * 512 + h * 64, 512,
                       VCt + chm_index(512, srow0, h * 64), L, qpos0, rs0 * 64, (rs3 + 8) * 64, nrows, 0.f, O);
  if (dry) attn_store<4>((bf16_t*)(p.ws + 484 * MiB), 512, O); else attn_store<4>(QC + (size_t)row0 * 512 + h * 64, 512, O);
}

DI void mem_attn_tile(char* smem, const Params& p, int layer, int row0) {
  bf16_t* QM = (bf16_t*)(p.ws + WS_QM);
  const bf16_t* MK = (const bf16_t*)(p.ws + WS_MISC + MS_MK) + (size_t)layer * 18 * 256 * 256;
  const bf16_t* MVt = (const bf16_t*)(p.ws + WS_MISC + MS_MVT) + (size_t)layer * 18 * 256 * 256;
  int L, srow0, bg; seq_of_row(row0, L, srow0, bg);
#pragma unroll 1
  for (int h = 0; h < 4; ++h) {
    float O[2][4][4];
    attn_core<64, AM_MEM>(smem, QM + (size_t)row0 * 256 + h * 64, 256, MK + (size_t)bg * 256 * 256 + h * 64, 256,
                          MVt + ((size_t)(bg * 256 + h * 64) << 8), 256, 0, 0, 256, 0, 0.f, O);
    attn_store<4>(QM + (size_t)row0 * 256 + h * 64, 256, O);
  }
}

DI int PADI(int i) { return i + (i >> 5); }
DI float2 cmul(float2 a, float2 b) { return make_float2(a.x * b.x - a.y * b.y, a.x * b.y + a.y * b.x); }
DI float2 cmulc(float2 a, float2 b) { return make_float2(a.x * b.x + a.y * b.y, a.y * b.x - a.x * b.y); }
DI constexpr float C16(int m) { return m == 0 ? 1.f : m == 1 ? 0.92387953251128674f : m == 2 ? 0.70710678118654752f : m == 3 ? 0.38268343236508977f : m == 4 ? 0.f : m == 5 ? -0.38268343236508977f : m == 6 ? -0.70710678118654752f : -0.92387953251128674f; }
DI constexpr float S16(int m) { return m == 0 ? 0.f : m == 1 ? 0.38268343236508977f : m == 2 ? 0.70710678118654752f : m == 3 ? 0.92387953251128674f : m == 4 ? 1.f : m == 5 ? 0.92387953251128674f : m == 6 ? 0.70710678118654752f : 0.38268343236508977f; }

template <int LOGR, int LOGS, bool INV>
DI void fft_pass(float2* buf, int total) {
  constexpr int R = 1 << LOGR;
  constexpr int S = 1 << LOGS;
  const int tid0 = opaque((int)threadIdx.x);
#pragma unroll 1
  for (int u = tid0; u < (total >> LOGR); u += NTHR) {
    const int j = u & (S - 1);
    const int base = ((u >> LOGS) << (LOGS + LOGR)) + j;
    float2* bp = buf + PADI(base);
    float2 x[R];
#pragma unroll
    for (int k = 0; k < R; ++k) x[k] = bp[k * S + ((k * S) >> 5)];
    float2 pw[LOGR];
    {
      const float rev = -(float)j * (1.0f / (float)(R * S));
      pw[0] = make_float2(cos_rev(rev), sin_rev(rev));
#pragma unroll
      for (int i = 1; i < LOGR; ++i) pw[i] = cmul(pw[i - 1], pw[i - 1]);
    }
    if (!INV) {
#pragma unroll
      for (int i = 0; i < LOGR; ++i) {
        const int h = R >> (i + 1);
#pragma unroll
        for (int k = 0; k < R; ++k) {
          if ((k & h) == 0) {
            const int mm = (k & (h - 1)) * 8 / h;
            float2 a = x[k], b = x[k + h];
            x[k] = make_float2(a.x + b.x, a.y + b.y);
            float2 d = make_float2(a.x - b.x, a.y - b.y);
            if (mm != 0) d = cmul(d, make_float2(C16(mm), -S16(mm)));
            x[k + h] = cmul(d, pw[i]);
          }
        }
      }
    } else {
#pragma unroll
      for (int i = LOGR - 1; i >= 0; --i) {
        const int h = R >> (i + 1);
#pragma unroll
        for (int k = 0; k < R; ++k) {
          if ((k & h) == 0) {
            const int mm = (k & (h - 1)) * 8 / h;
            float2 a = x[k];
            float2 d = cmulc(x[k + h], pw[i]);
            if (mm != 0) d = cmulc(d, make_float2(C16(mm), -S16(mm)));
            x[k] = make_float2(a.x + d.x, a.y + d.y);
            x[k + h] = make_float2(a.x - d.x, a.y - d.y);
          }
        }
      }
    }
#pragma unroll
    for (int k = 0; k < R; ++k) bp[k * S + ((k * S) >> 5)] = x[k];
  }
  __syncthreads();
}

template <int LOGN>
DI void fft_fwd(float2* buf, int total) {
  if (LOGN == 14) { fft_pass<4, 10, false>(buf, total); fft_pass<4, 6, false>(buf, total); fft_pass<4, 2, false>(buf, total); fft_pass<2, 0, false>(buf, total); }
  else { fft_pass<4, 7, false>(buf, total); fft_pass<4, 3, false>(buf, total); fft_pass<3, 0, false>(buf, total); }
}
template <int LOGN>
DI void fft_inv(float2* buf, int total) {
  if (LOGN == 14) { fft_pass<2, 0, true>(buf, total); fft_pass<4, 2, true>(buf, total); fft_pass<4, 6, true>(buf, total); fft_pass<4, 10, true>(buf, total); }
  else { fft_pass<3, 0, true>(buf, total); fft_pass<4, 3, true>(buf, total); fft_pass<4, 7, true>(buf, total); }
}

template <int LOGN, int NB, int NSUB>
DI void hyena_item(char* smem, const Params& p, int c, int row_base  ) {
  constexpr int L = 1 << LOGN;
  constexpr int SPT = L / NTHR;
  constexpr int EPT = NB * L / NTHR;
  const int tid = opaque((int)threadIdx.x);
  float2* buf = (float2*)smem;
  float* sm_w3 = (float*)(smem + 135168);
  float* sm_red = sm_w3 + 128;
  char* scr = p.ws + WS_XB + (size_t)blockIdx.x * HY_SCR_PER_BLOCK;
  float* scrF = (float*)scr;
  float* scrB = scrF + L;
  float2* scrY = (float2*)(scr + 128 * 1024);
  float2* scrZ = (float2*)(scr + 256 * 1024);
  float2* scrS = (float2*)(scr + 384 * 1024);
  const bf16_t* UH = (const bf16_t*)p.out;
  bf16_t* OB = (bf16_t*)(p.ws + WS_R1);
  const float* h2 = (const float*)(p.ws + WS_MISC + (LOGN == 14 ? MS_H2P : MS_H2S));
  const float* w3 = p.in[21];
  const float* cw = p.in[14]; const float* cb = p.in[15]; const float* skp = p.in[22];
  const float delta = fabsf(-3.0701134573253945f + (float)c * ((-15.350567286626973f + 3.0701134573253945f) / 511.0f));
  const float invLm1 = 1.0f / (float)(L - 1);

  auto conv3 = [&](int b, int ch, int n) -> float {
    const bf16_t* u = UH + chm_index(1536, row_base + b * L, ch) + n;
    float v = bf2f(u[0]) * cw[1536 + ch] + cb[ch];
    if (n > 0) v += bf2f(u[-1]) * cw[ch];
    if (n < L - 1) v += bf2f(u[1]) * cw[2 * 1536 + ch];
    return v;
  };

#pragma unroll 1
  for (int o = 0; o < 2; ++o) {
    __syncthreads();
    if (tid < 128) sm_w3[tid] = w3[(size_t)(tid & 63) * 2048 + (o * 2 + (tid >> 6)) * 512 + c];
    __syncthreads();
    float asum = 0.f;
#pragma unroll 1
    for (int i = 0; i < SPT; ++i) {
      const int t = tid + NTHR * i;
      const float4* hr = (const float4*)(h2 + (size_t)t * 64);
      float f = 0.f, bk = 0.f;
#pragma unroll 4
      for (int q4 = 0; q4 < 16; ++q4) {
        float4 hv = hr[q4];
        const f32x4 wf = *(const volatile f32x4*)(sm_w3 + 4 * q4);
        const f32x4 wb = *(const volatile f32x4*)(sm_w3 + 64 + 4 * q4);
        f += hv.x * wf.x + hv.y * wf.y + hv.z * wf.z + hv.w * wf.w;
        bk += hv.x * wb.x + hv.y * wb.y + hv.z * wb.z + hv.w * wb.w;
      }
      const float dec = ex2(-(float)t * invLm1 * delta * LOG2E);
      f *= dec; bk *= dec;
      scrF[t] = f; scrB[t] = bk;
      asum += fabsf(f) + (t >= 1 ? fabsf(bk) : 0.f);
    }
#pragma unroll
    for (int s = 32; s >= 1; s >>= 1) asum += __shfl_xor(asum, s);
    if ((tid & 63) == 0) sm_red[tid >> 6] = asum;
    block_sync_global();
    float nrm = 0.f;
#pragma unroll
    for (int w = 0; w < 8; ++w) nrm += sm_red[w];
    const float inv_nrm = 1.0f / nrm;
    const float sk = skp[o * 512 + c];

#pragma unroll 1
    for (int par = 0; par < 2; ++par) {
#pragma unroll 2
      for (int i = 0; i < SPT; ++i) {
        const int n = tid + NTHR * i;
        const float f = scrF[n];
        const float br = (n == 0) ? 0.f : scrB[L - n];
        float2 v;
        if (par == 0) v = make_float2((f + br) * inv_nrm, 0.f);
        else { const float gm = (f - br) * inv_nrm; const float rev = -(float)n / (float)(2 * L); v = make_float2(gm * cos_rev(rev), gm * sin_rev(rev)); }
        buf[PADI(n)] = v;
      }
      __syncthreads();
      fft_fwd<LOGN>(buf, L);
#pragma unroll 2
      for (int i = 0; i < SPT; ++i) scrS[tid + NTHR * i] = buf[PADI(tid + NTHR * i)];
      __syncthreads();
#pragma unroll 1
      for (int sub = 0; sub < NSUB; ++sub) {
#pragma unroll 2
        for (int i = 0; i < EPT; ++i) {
          const int e = tid + NTHR * i; const int f = e >> LOGN, n = e & (L - 1);
          const int pp = sub * NB + f;
          float2 z;
          if (o == 0 && par == 0) { z = make_float2(conv3(2 * pp, c, n), conv3(2 * pp + 1, c, n)); scrZ[(size_t)pp * L + n] = z; }
          else z = scrZ[(size_t)pp * L + n];
          if (par == 1) { const float rev = -(float)n / (float)(2 * L); z = cmul(z, make_float2(cos_rev(rev), sin_rev(rev))); }
          buf[PADI(e)] = z;
        }
        __syncthreads();
        fft_fwd<LOGN>(buf, NB * L);
#pragma unroll 2
        for (int i = 0; i < EPT; ++i) {
          const int e = tid + NTHR * i;
          buf[PADI(e)] = cmul(buf[PADI(e)], scrS[e & (L - 1)]);
        }
        __syncthreads();
        fft_inv<LOGN>(buf, NB * L);
#pragma unroll 2
        for (int i = 0; i < EPT; ++i) {
          const int e = tid + NTHR * i; const int f = e >> LOGN, n = e & (L - 1);
          const int pp = sub * NB + f;
          float2 y = buf[PADI(e)];
          if (par == 0) { scrY[(size_t)pp * L + n] = y; }
          else {
            const float rev = -(float)n / (float)(2 * L);
            y = cmulc(y, make_float2(cos_rev(rev), sin_rev(rev)));
            const float2 ye = scrY[(size_t)pp * L + n];
            const float2 z = scrZ[(size_t)pp * L + n];
            const float sc = 0.5f / (float)L;
            const float c0 = (ye.x + y.x) * sc + sk * z.x;
            const float c1 = (ye.y + y.y) * sc + sk * z.y;
            const int gch = (o == 0 ? 512 : 1024) + c;
            const float z0 = conv3(2 * pp, gch, n) * c0;
            const float z1 = conv3(2 * pp + 1, gch, n) * c1;
            if (o == 0) scrZ[(size_t)pp * L + n] = make_float2(z0, z1);
            else {
              OB[(size_t)(row_base + (2 * pp) * L + n) * 512 + c] = f2bf(z0);
              OB[(size_t)(row_base + (2 * pp + 1) * L + n) * 512 + c] = f2bf(z1);
            }
          }
        }
        __syncthreads();
      }
    }
  }
}

struct WMat { const float* src; int K; int N; const float* gain; bf16_t* dst; };
DI WMat get_wmat(const Params& p, int id) {
  bf16_t* W = (bf16_t*)(p.ws + WS_W);
  WMat m;
  switch (id) {
    case 0: m = {p.in[9], 1024, 3072, p.in[5], W + W_INE}; break;
    case 1: m = {p.in[23], 1024, 1024, nullptr, W + W_OUTE}; break;
    case 2: m = {p.in[24], 1024, 2304, p.in[5] + 1024, W + W_INO}; break;
    case 3: m = {p.in[31], 1024, 1024, nullptr, W + W_OUTO}; break;
    case 4: m = {p.in[32], 1024, 256, p.in[6], W + W_Q}; break;
    case 5: m = {p.in[32] + 1024 * 256, 1024, 256, p.in[6] + 1024, W + W_Q + 256 * 1024}; break;
    case 6: m = {p.in[33], 1024, 512, p.in[7], W + W_KV}; break;
    case 7: m = {p.in[33] + 1024 * 512, 1024, 512, p.in[7] + 1024, W + W_KV + 512 * 1024}; break;
    case 8: m = {p.in[34], 256, 1024, nullptr, W + W_O}; break;
    case 9: m = {p.in[34] + 256 * 1024, 256, 1024, nullptr, W + W_O + 1024 * 256}; break;
    case 10: m = {p.in[37], 1024, 4096, p.in[8], W + W_1}; break;
    case 11: m = {p.in[37] + (size_t)1024 * 4096, 1024, 4096, p.in[8] + 1024, W + W_1 + (size_t)4096 * 1024}; break;
    case 12: m = {p.in[38], 4096, 1024, nullptr, W + W_2}; break;
    default: m = {p.in[38] + (size_t)4096 * 1024, 4096, 1024, nullptr, W + W_2 + (size_t)4096 * 1024}; break;
  }
  return m;
}

DI void prep_wtile(char* smem, const WMat& m, int tile) {
  float* t = (float*)smem;
  const int ntn = m.N >> 6;
  const int k0 = (tile / ntn) << 6, n0 = (tile % ntn) << 6;
  const int tid = threadIdx.x;
  __syncthreads();
  {
    const int kk = tid >> 4, n4 = (tid & 15) * 4;
#pragma unroll
    for (int i = 0; i < 2; ++i) {
      const int k = kk + 32 * i;
      float4 v = *(const float4*)(m.src + (size_t)(k0 + k) * m.N + n0 + n4);
      const float gk = m.gain ? m.gain[k0 + k] : 1.0f;
      t[k * 65 + n4] = v.x * gk; t[k * 65 + n4 + 1] = v.y * gk; t[k * 65 + n4 + 2] = v.z * gk; t[k * 65 + n4 + 3] = v.w * gk;
    }
  }
  __syncthreads();
  {
    const int n = tid >> 3, kc = tid & 7;
    uint4 u;
    u.x = pack2(t[(8 * kc) * 65 + n], t[(8 * kc + 1) * 65 + n]); u.y = pack2(t[(8 * kc + 2) * 65 + n], t[(8 * kc + 3) * 65 + n]);
    u.z = pack2(t[(8 * kc + 4) * 65 + n], t[(8 * kc + 5) * 65 + n]); u.w = pack2(t[(8 * kc + 6) * 65 + n], t[(8 * kc + 7) * 65 + n]);
    *(uint4*)(m.dst + (size_t)(n0 + n) * m.K + k0 + 8 * kc) = u;
  }
}

DI void prep_row(const float* src, bf16_t* dst, float* ssq) {
  const int lane = threadIdx.x & 63;
  float ss = 0.f;
#pragma unroll
  for (int i = 0; i < 4; ++i) {
    float4 v = *(const float4*)(src + (i * 64 + lane) * 4);
    ss += v.x * v.x + v.y * v.y + v.z * v.z + v.w * v.w;
    uint2 u; u.x = pack2(v.x, v.y); u.y = pack2(v.z, v.w);
    *(uint2*)(dst + (i * 64 + lane) * 4) = u;
  }
#pragma unroll
  for (int s = 32; s >= 1; s >>= 1) ss += __shfl_xor(ss, s);
  if (lane == 0) *ssq = ss;
}

DI void prep_h2(const Params& p, int L, int t, float* dst) {
  const int j = threadIdx.x & 63;
  const float* w1 = p.in[16]; const float* b1 = p.in[17]; const float* fr = p.in[18]; const float* w2 = p.in[19]; const float* b2 = p.in[20];
  const float t01 = (float)t / (float)(L - 1);
  const float tl = (float)t / (float)L;
  float a = t01 * w1[j] + b1[j];
#pragma unroll
  for (int k = 0; k < 8; ++k) {
    const float fk = 1e-4f + (float)k * ((7.0f - 1e-4f) / 7.0f);
    const float rev = tl * fk;
    a += cos_rev(rev) * w1[(1 + k) * 64 + j] - sin_rev(rev) * w1[(9 + k) * 64 + j];
  }
  const float h1 = sin_rev(fr[j] * a * 0.15915494309189535f);
  float a2 = b2[j];
  for (int i = 0; i < 64; ++i) a2 += __shfl(h1, i) * w2[i * 64 + j];
  dst[(size_t)t * 64 + j] = sin_rev(fr[64 + j] * a2 * 0.15915494309189535f);
}

constexpr int PREP_NW = 768 + 256 + 576 + 256 + 64 + 64 + 128 + 128 + 64 + 64 + 1024 + 1024 + 1024 + 1024;
constexpr int PREP_T_ROWS = PREP_NW;
constexpr int PREP_T_MEM = PREP_T_ROWS + 8192;
constexpr int PREP_T_H2 = PREP_T_MEM + 576;
constexpr int PREP_T_MISC = PREP_T_H2 + 2304;
constexpr int PREP_TOTAL = PREP_T_MISC + 1;

DI void phase_prep(char* smem, const Params& p) {
  const int tid = threadIdx.x, wave = tid >> 6;
#pragma unroll 1
  for (int task = blockIdx.x; task < PREP_TOTAL; task += gridDim.x) {
    if (task < PREP_NW) {
      int t = task, id = 0;
      for (; id < 14; ++id) { WMat m = get_wmat(p, id); int n = (m.K >> 6) * (m.N >> 6); if (t < n) break; t -= n; }
      WMat m = get_wmat(p, id);
      prep_wtile(smem, m, t);
    } else if (task < PREP_T_MEM) {
      const int row = (task - PREP_T_ROWS) * 8 + wave;
      const float* src = (row < T_P) ? p.in[0] + (size_t)row * DM : p.in[1] + (size_t)(row - T_P) * DM;
      float* RS = (float*)(p.ws + WS_MISC + MS_RS);
      prep_row(src, (bf16_t*)(p.ws + WS_XB) + (size_t)row * DM, RS + row);
      if ((tid & 63) < 5) RS[(size_t)(1 + (tid & 63)) * T_ALL + row] = 0.f;
    } else if (task < PREP_T_H2) {
      const int row = (task - PREP_T_MEM) * 8 + wave;
      const float* src = (row < 512) ? p.in[2] + (size_t)row * DM : p.in[3] + (size_t)(row - 512) * DM;
      prep_row(src, (bf16_t*)(p.ws + WS_R1) + (size_t)row * DM, (float*)(p.ws + WS_MISC + MS_RSM) + row);
    } else if (task < PREP_T_MISC) {
      const int t = (task - PREP_T_H2) * 8 + wave;
      if (t < LP) prep_h2(p, LP, t, (float*)(p.ws + WS_MISC + MS_H2P));
      else prep_h2(p, LS, t - LP, (float*)(p.ws + WS_MISC + MS_H2S));
    } else {
      float* lut = (float*)(p.ws + WS_MISC + MS_LUT);
      for (int i = tid; i < 8 * 257; i += NTHR) {
        const int hh = i / 257, rel = (i % 257) - 128;
        const int n = rel < 0 ? -rel : rel;
        int bkt;
        if (n < 8) bkt = n; else { bkt = 2 + (31 - __clz(n * n)); if (bkt > 15) bkt = 15; }
        if (rel > 0) bkt += 16;
        lut[i] = p.in[4][bkt * 8 + hh] * LOG2E;
      }
      if (tid < 64) {
        const float* lf = p.in[12];
        float a = lf[tid] * lf[64 + tid], b = lf[128 + tid] * lf[192 + tid];
#pragma unroll
        for (int s = 32; s >= 1; s >>= 1) { a += __shfl_xor(a, s); b += __shfl_xor(b, s); }
        if (tid == 0) *(float*)(p.ws + WS_MISC + MS_LAM) = expf(a) - expf(b) + 0.2f;
      }
    }
  }
}

DI Seg seg_inproj(const Params& p, int layer, int col0, const float* rs) {
  Seg s{}; s.rs = rs; s.scale = 1.0f;
  if (layer == 0) {
    if (col0 < 512) { s.type = SEG_NORM; s.dst = (bf16_t*)(p.ws + WS_R0); s.ld = 512; s.col = col0; s.gain = p.in[10]; s.scale = QSCALE; }
    else if (col0 < 1024) { s.type = SEG_NORM; s.dst = (bf16_t*)((char*)p.out + 192 * MiB); s.ld = 512; s.col = col0 - 512; s.gain = p.in[11]; }
    else if (col0 < 1536) { s.type = SEG_CHM; s.dst = (bf16_t*)(p.ws + WS_R2); s.CH = 512; s.col = col0 - 1024; }
    else { s.type = SEG_CHM; s.dst = (bf16_t*)p.out; s.CH = 1536; s.col = col0 - 1536; }
  } else {
    if (col0 < 512) { s.type = SEG_NORM; s.dst = (bf16_t*)(p.ws + WS_R0); s.ld = 512; s.col = col0; s.gain = p.in[25]; s.scale = QSCALE; }
    else if (col0 < 1024) { s.type = SEG_NORM; s.dst = (bf16_t*)(p.ws + WS_R1); s.ld = 512; s.col = col0 - 512; s.gain = p.in[26]; }
    else if (col0 < 1536) { s.type = SEG_CHM; s.dst = (bf16_t*)(p.ws + WS_R2); s.CH = 512; s.col = col0 - 1024; }
    else if (col0 < 2048) { s.type = SEG_NORM; s.dst = (bf16_t*)(p.ws + WS_R3); s.ld = 512; s.col = col0 - 1536; s.gain = p.in[28]; s.scale = QSCALE; }
    else if (col0 < 2176) { s.type = SEG_NORM; s.dst = (bf16_t*)(p.ws + WS_KD); s.ld = 128; s.col = col0 - 2048; s.gain = p.in[29]; }
    else { s.type = SEG_CHM; s.dst = (bf16_t*)(p.ws + WS_VDT); s.CH = 128; s.col = col0 - 2176; }
  }
  return s;
}

DI void phase_inproj(char* smem, const Params& p, int layer) {
  const int NTn = layer == 0 ? 24 : 18;
  const int n_main = 256 * NTn;
  const int n_total = n_main + (layer == 0 ? 144 : 0);
  const bf16_t* W = (const bf16_t*)(p.ws + WS_W);
  const int wn = (threadIdx.x >> 6) & 1;
#pragma unroll 1
  for (int tile = blockIdx.x; tile < n_total; tile += gridDim.x) {
    if (tile < n_main) {
      const int mt = tile / NTn, nt = tile % NTn;
      GemmArgs ga{(const bf16_t*)(p.ws + WS_XB), nullptr, 1 << 30, DM, W + (layer == 0 ? W_INE : W_INO), DM, DM};
      Seg s = seg_inproj(p, layer, nt * 128 + 64 * wn, (const float*)(p.ws + WS_MISC + MS_RS) + (size_t)(layer * 3) * T_ALL);
      s.col -= 64 * wn;
      gemm_tile(smem, ga, mt * 256, nt * 128, s);
    } else {
      const int t2 = tile - n_main; const int l = t2 / 72, r = t2 % 72; const int mt = r >> 2, nt = r & 3;
      GemmArgs ga{(const bf16_t*)(p.ws + WS_R1), nullptr, 1 << 30, DM, W + W_KV + (size_t)l * 512 * 1024, DM, DM};
      Seg s{}; s.rs = (const float*)(p.ws + WS_MISC + MS_RSM); s.scale = 1.0f;
      const int col0 = nt * 128 + 64 * wn;
      if (col0 < 256) { s.type = SEG_NORM; s.dst = (bf16_t*)(p.ws + WS_MISC + MS_MK) + (size_t)l * 18 * 256 * 256; s.ld = 256; s.col = col0 - 64 * wn; s.gain = p.in[36] + l * 64; }
      else { s.type = SEG_CHMEM; s.dst = (bf16_t*)(p.ws + WS_MISC + MS_MVT) + (size_t)l * 18 * 256 * 256; s.col = col0 - 256 - 64 * wn; }
      gemm_tile(smem, ga, mt * 256, nt * 128, s);
    }
  }
}

DI void phase_mixer0(char* smem, const Params& p) {
#pragma unroll 1
  for (int item = blockIdx.x; item < 2048; item += gridDim.x) {
    const int kind = item >> 9, idx = item & 511;
#ifndef SUBP
#define SUBP -1
#endif
    if (kind == 0 || kind == 2) {
      if (PROBE & 4) diff_item(smem, p, (kind == 2 ? 512 : 0) + idx, true);
      diff_item(smem, p, (kind == 2 ? 512 : 0) + idx);
    } else if (kind == 1) {
      if (PROBE & 8) hyena_item<14, 1, 1>(smem, p, idx, 0);
      hyena_item<14, 1, 1>(smem, p, idx, 0);
    } else {
      if (PROBE & 8) hyena_item<11, 4, 2>(smem, p, idx, T_P);
      hyena_item<11, 4, 2>(smem, p, idx, T_P);
    }
  }
}
DI void phase_mixer1(char* smem, const Params& p) {
#pragma unroll 1
  for (int item = blockIdx.x; item < 4096; item += gridDim.x) {
    if (PROBE & 16) { if (item < 2048) na_item(smem, p, item, true); else wg_item(smem, p, item - 2048, true); }
    if (item < 2048) na_item(smem, p, item); else wg_item(smem, p, item - 2048);
  }
}

DI void phase_post(char* smem, const Params& p, int layer) {
  const bf16_t* W = (const bf16_t*)(p.ws + WS_W);
  float* RS = (float*)(p.ws + WS_MISC + MS_RS);
  bf16_t* XB = (bf16_t*)(p.ws + WS_XB);
  bf16_t* H = (bf16_t*)(p.ws + (layer == 0 ? WS_H_L0 : WS_H_L1));
  bf16_t* QM = (bf16_t*)(p.ws + WS_QM);
  const int wn = (threadIdx.x >> 6) & 1;
#pragma unroll 1
  for (int mt = blockIdx.x; mt < 256; mt += gridDim.x) {
    const int m0 = mt * 256;
#ifndef CHAINP
#define CHAINP -1
#endif
    if (CHAINP < 0 || CHAINP == 1) {
      GemmArgs ga{(const bf16_t*)(p.ws + WS_R0), (const bf16_t*)(p.ws + (layer == 0 ? WS_R1 : WS_R3)), 512, 512, W + (layer == 0 ? W_OUTE : W_OUTO), DM, DM};
      Seg s{}; s.type = SEG_RESID; s.xin0 = layer == 0 ? p.in[0] : nullptr; s.xin1 = layer == 0 ? p.in[1] : nullptr;
      s.xout = p.out; s.xb = XB; s.rs_out = RS + (size_t)(layer * 3 + 1) * T_ALL;
      _Pragma("unroll 1") for (int nt = 0; nt < 8; ++nt) { s.col = nt * 128; gemm_tile(smem, ga, m0, nt * 128, s); }
    }
    block_sync_global();
    if (CHAINP < 0 || CHAINP == 2) {
      GemmArgs ga{XB, nullptr, 1 << 30, DM, W + W_Q + (size_t)layer * 256 * 1024, DM, DM};
      Seg s{}; s.type = SEG_NORM; s.rs = RS + (size_t)(layer * 3 + 1) * T_ALL; s.dst = QM; s.ld = 256; s.gain = p.in[35] + layer * 64; s.scale = QSCALE;
      _Pragma("unroll 1") for (int nt = 0; nt < 2; ++nt) { s.col = nt * 128; gemm_tile(smem, ga, m0, nt * 128, s); }
    }
    block_sync_global();
    if (CHAINP < 0 || CHAINP == 3) mem_attn_tile(smem, p, layer, m0);
    block_sync_global();
    if (CHAINP < 0 || CHAINP == 4) {
      GemmArgs ga{QM, nullptr, 1 << 30, 256, W + W_O + (size_t)layer * 1024 * 256, 256, 256};
      Seg s{}; s.type = SEG_RESID; s.xout = p.out; s.xb = XB; s.rs_out = RS + (size_t)(layer * 3 + 2) * T_ALL;
      _Pragma("unroll 1") for (int nt = 0; nt < 8; ++nt) { s.col = nt * 128; gemm_tile(smem, ga, m0, nt * 128, s); }
    }
    block_sync_global();
    if (CHAINP < 0 || CHAINP == 5) _Pragma("unroll 1") for (int hc = 0; hc < 4; ++hc) {
      {
        GemmArgs ga{XB, nullptr, 1 << 30, DM, W + W_1 + (size_t)layer * 4096 * 1024 + (size_t)hc * 1024 * 1024, DM, DM};
        Seg s{}; s.type = SEG_MLP1; s.rs = RS + (size_t)(layer * 3 + 2) * T_ALL; s.dst = H; s.ld = 1024;
        _Pragma("unroll 1") for (int nt = 0; nt < 8; ++nt) { s.col = nt * 128; gemm_tile(smem, ga, m0, nt * 128, s); }
      }
      block_sync_global();
      {
        GemmArgs ga{H, nullptr, 1 << 30, 1024, W + W_2 + (size_t)layer * 4096 * 1024 + (size_t)hc * 1024, 4096, 1024};
        Seg s{}; s.type = SEG_RESID; s.xout = p.out;
        if (hc == 3 && layer == 0) { s.xb = XB; s.rs_out = RS + (size_t)3 * T_ALL; }
        _Pragma("unroll 1") for (int nt = 0; nt < 8; ++nt) { s.col = nt * 128; gemm_tile(smem, ga, m0, nt * 128, s); }
      }
      block_sync_global();
    }
  }
  (void)wn;
}

__global__ void __launch_bounds__(NTHR) fwd_kernel(Params p, int ph_lo, int ph_hi) {
  extern __shared__ __attribute__((aligned(16))) char smem[];
#define RUN_PHASE(i_, call_) if (ph_lo <= (i_) && (i_) <= ph_hi) { if ((i_) > ph_lo) { __threadfence(); cg::this_grid().sync(); } call_; }
  RUN_PHASE(0, phase_prep(smem, p))
  if (PROBE & 1) { __syncthreads(); phase_prep(smem, p); }
  RUN_PHASE(1, phase_inproj(smem, p, 0))
  if (PROBE & 2) { __syncthreads(); phase_inproj(smem, p, 0); }
  RUN_PHASE(2, phase_mixer0(smem, p))
  RUN_PHASE(3, phase_post(smem, p, 0))
  RUN_PHASE(4, phase_inproj(smem, p, 1))
  if (PROBE & 2) { __syncthreads(); phase_inproj(smem, p, 1); }
  RUN_PHASE(5, phase_mixer1(smem, p))
  RUN_PHASE(6, phase_post(smem, p, 1))
}

#ifndef ONE_LAUNCH
#define ONE_LAUNCH 1
#endif

extern "C" void kernel_launch(void* const* d_in, const int* in_sizes, int n_in, void* d_out, int out_size, void* d_ws, size_t ws_size,
                              hipStream_t stream) {
  static int grid = 0;
  if (grid == 0) {
    if (n_in != 39 || ws_size < WS_NEED || out_size != T_ALL * DM) { fprintf(stderr, "kernel_launch: unexpected shapes n_in %d ws %zu out %d\n", n_in, ws_size, out_size); grid = -1; return; }
    if (hipFuncSetAttribute((const void*)fwd_kernel, hipFuncAttributeMaxDynamicSharedMemorySize, SMEM_BYTES) != hipSuccess) { fprintf(stderr, "hipFuncSetAttribute failed\n"); grid = -1; return; }
    int dev = 0, cus = 0, per_cu = 0;
    hipGetDevice(&dev);
    hipDeviceGetAttribute(&cus, hipDeviceAttributeMultiprocessorCount, dev);
    hipOccupancyMaxActiveBlocksPerMultiprocessor(&per_cu, (const void*)fwd_kernel, NTHR, SMEM_BYTES);
    if (per_cu < 1 || cus < 1) { fprintf(stderr, "occupancy query: %d blocks/CU, %d CUs\n", per_cu, cus); grid = -1; return; }
    grid = cus;
  }
  if (grid < 0) return;
  Params p{};
  for (int i = 0; i < 39; ++i) p.in[i] = (const float*)d_in[i];
  p.out = (float*)d_out; p.ws = (char*)d_ws;
#if ONE_LAUNCH
  int lo = 0, hi = 6;
  void* args[] = {&p, &lo, &hi};
  hipError_t e = hipLaunchCooperativeKernel((const void*)fwd_kernel, dim3(grid), dim3(NTHR), args, SMEM_BYTES, stream);
  if (e != hipSuccess) fprintf(stderr, "cooperative launch failed: %s\n", hipGetErrorString(e));
#else
  for (int ph = 0; ph <= 6; ++ph) hipLaunchKernelGGL(fwd_kernel, dim3(grid), dim3(NTHR), SMEM_BYTES, stream, p, ph, ph);
#endif
}
```

```cpp
#include <hip/hip_runtime.h>
#include <hip/hip_cooperative_groups.h>
#include <cstdio>
namespace cg = cooperative_groups;

#define DI __device__ __forceinline__
#define PROBE 0
typedef unsigned short bf16_t;
using bf16x8 = __attribute__((ext_vector_type(8))) short;
using s16x4 = __attribute__((ext_vector_type(4))) short;
using f32x4 = __attribute__((ext_vector_type(4))) float;
#define MFMA16(a, b, c) __builtin_amdgcn_mfma_f32_16x16x32_bf16((a), (b), (c), 0, 0, 0)

constexpr int NTHR = 512;
constexpr int T_ALL = 65536;
constexpr int T_P = 32768;
constexpr int LP = 16384, LS = 2048;
constexpr int DM = 1024;
constexpr float EPS = 1e-6f;
constexpr float LOG2E = 1.4426950408889634f;
constexpr float QSCALE = 0.125f * 1.4426950408889634f;
constexpr int SMEM_BYTES = 144 * 1024;
constexpr size_t MiB = (size_t)1 << 20;

constexpr size_t WS_XB = 0;
constexpr size_t WS_W = 128 * MiB;
constexpr size_t W_INE = 0;
constexpr size_t W_OUTE = W_INE + (size_t)3072 * 1024;
constexpr size_t W_INO = W_OUTE + (size_t)1024 * 1024;
constexpr size_t W_OUTO = W_INO + (size_t)2304 * 1024;
constexpr size_t W_Q = W_OUTO + (size_t)1024 * 1024;
constexpr size_t W_KV = W_Q + (size_t)2 * 256 * 1024;
constexpr size_t W_O = W_KV + (size_t)2 * 512 * 1024;
constexpr size_t W_1 = W_O + (size_t)2 * 1024 * 256;
constexpr size_t W_2 = W_1 + (size_t)2 * 4096 * 1024;
constexpr size_t W_END = W_2 + (size_t)2 * 4096 * 1024;
static_assert(W_END * 2 <= 51 * MiB, "weights");
constexpr size_t WS_MISC = 179 * MiB;
constexpr size_t MS_RS = 0;
constexpr size_t MS_RSM = MS_RS + (size_t)6 * T_ALL * 4;
constexpr size_t MS_MK = MS_RSM + 32768;
constexpr size_t MS_MVT = MS_MK + (size_t)2 * 18 * 256 * 256 * 2;
constexpr size_t MS_H2P = MS_MVT + (size_t)2 * 18 * 256 * 256 * 2;
constexpr size_t MS_H2S = MS_H2P + (size_t)LP * 64 * 4;
constexpr size_t MS_LUT = MS_H2S + (size_t)LS * 64 * 4;
constexpr size_t MS_LAM = MS_LUT + 16384;
constexpr size_t MS_END = MS_LAM + 256;
static_assert(MS_END <= 16 * MiB, "misc");
constexpr size_t WS_R0 = 195 * MiB;
constexpr size_t WS_R1 = 259 * MiB;
constexpr size_t WS_R2 = 323 * MiB;
constexpr size_t WS_R3 = 387 * MiB;
constexpr size_t WS_KD = 451 * MiB;
constexpr size_t WS_VDT = 467 * MiB;
constexpr size_t WS_QM = 451 * MiB;
constexpr size_t WS_H_L0 = 323 * MiB;
constexpr size_t WS_H_L1 = 259 * MiB;
constexpr size_t WS_NEED = 512 * MiB;
constexpr size_t HY_SCR_PER_BLOCK = 512 * 1024;

struct Params {
  const float* in[39];
  float* out;
  char* ws;
};

DI unsigned short f2bf(float x) { unsigned u = __float_as_uint(x); u += 0x7fffu + ((u >> 16) & 1u); return (unsigned short)(u >> 16); }
DI unsigned pack2(float a, float b) { return (unsigned)f2bf(a) | ((unsigned)f2bf(b) << 16); }
DI float bf2f(unsigned short h) { return __uint_as_float(((unsigned)h) << 16); }
DI float ex2(float x) { return __builtin_amdgcn_exp2f(x); }
DI float sin_rev(float r) { return __builtin_amdgcn_sinf(r); }
DI float cos_rev(float r) { return __builtin_amdgcn_cosf(r); }
DI int opaque(int x) { asm volatile("" : "+v"(x)); return x; }
DI void block_sync_global() { __syncthreads(); }

DI size_t chm_index(int CH, int row, int ch) {
  if (row < T_P) { int b = row >> 14, t = row & (LP - 1); return ((size_t)(b * CH + ch) << 14) + t; }
  int r = row - T_P; int b = r >> 11, t = r & (LS - 1);
  return (size_t)T_P * CH + ((size_t)(b * CH + ch) << 11) + t;
}

struct GemmArgs {
  const bf16_t* A0; const bf16_t* A1; int ksplit; int lda;
  const bf16_t* Wt; int ldw; int K;
};
enum { SEG_NORM = 0, SEG_CHM = 1, SEG_CHMEM = 2, SEG_RESID = 3, SEG_MLP1 = 4 };
struct Seg {
  int type;
  bf16_t* dst; int ld; int col;
  const float* gain; float scale;
  int CH;
  const float* rs;
  const float* xin0; const float* xin1; float* xout; bf16_t* xb; float* rs_out;
};
constexpr int G_TILE_B = 256 * 64 * 2, G_STAGE_B = 2 * G_TILE_B;
DI int g_lds_byte(int r, int c) { int st = (r >> 4) * 2 + (c >> 5), ob = (r & 15) * 64 + (c & 31) * 2; return st * 1024 + (ob ^ (((ob >> 9) & 1) << 5)); }
DI void g_stage_rc(int b, int& R, int& C) { int st = b >> 10, sb = b & 1023, swz = sb ^ (((sb >> 9) & 1) << 5); R = (st >> 1) * 16 + swz / 64; C = (st & 1) * 32 + (swz % 64) / 2; }
#define WAIT_V0() asm volatile("s_waitcnt vmcnt(0)" ::: "memory")

DI void gemm_tile(char* smem_generic, const GemmArgs& ga, int m0, int n0, const Seg& sg) {
  extern __shared__ __attribute__((aligned(16))) char shm[];
  (void)smem_generic;
  const int tid = opaque((int)threadIdx.x), lane = tid & 63, wid = tid >> 6;
  const int l16 = lane & 15, g = lane >> 4;
  const int wr = wid >> 2, wc = wid & 3;
  int sR[4], sC[4];
#pragma unroll
  for (int i = 0; i < 4; ++i) g_stage_rc(wid * 1024 + i * 8192 + lane * 16, sR[i], sC[i]);
  const int KT = ga.K >> 6;
#define G_STAGE(buf_, kt_) do { const int k0_ = (kt_) << 6; \
    const bf16_t* Ab_ = (k0_ < ga.ksplit) ? ga.A0 + k0_ : ga.A1 + (k0_ - ga.ksplit); \
    _Pragma("unroll") for (int i = 0; i < 4; ++i) { \
      __builtin_amdgcn_global_load_lds((const unsigned*)(Ab_ + (size_t)(m0 + sR[i]) * ga.lda + sC[i]), (__attribute__((address_space(3))) unsigned*)(shm + (buf_) * G_STAGE_B + wid * 1024 + i * 8192), 16, 0, 0); \
      __builtin_amdgcn_global_load_lds((const unsigned*)(ga.Wt + (size_t)(n0 + sR[i]) * ga.ldw + k0_ + sC[i]), (__attribute__((address_space(3))) unsigned*)(shm + (buf_) * G_STAGE_B + G_TILE_B + wid * 1024 + i * 8192), 16, 0, 0); } } while (0)
  f32x4 acc[8][4];
#pragma unroll
  for (int i = 0; i < 8; ++i)
#pragma unroll
    for (int j = 0; j < 4; ++j) acc[i][j] = (f32x4){0.f, 0.f, 0.f, 0.f};
  G_STAGE(0, 0); WAIT_V0(); __syncthreads();
#pragma unroll 1
  for (int t = 0; t < KT; ++t) {
    const int cur = t & 1;
    if (t + 1 < KT) G_STAGE(cur ^ 1, t + 1);
    const char* SAp = shm + cur * G_STAGE_B; const char* SBp = SAp + G_TILE_B;
#pragma unroll
    for (int ks = 0; ks < 2; ++ks) {
      bf16x8 At[8], Bf[4];
#pragma unroll
      for (int m = 0; m < 8; ++m) At[m] = *(const bf16x8*)(SAp + g_lds_byte(wr * 128 + m * 16 + l16, ks * 32 + g * 8));
#pragma unroll
      for (int n = 0; n < 4; ++n) Bf[n] = *(const bf16x8*)(SBp + g_lds_byte(wc * 64 + n * 16 + l16, ks * 32 + g * 8));
#pragma unroll
      for (int m = 0; m < 8; ++m)
#pragma unroll
        for (int n = 0; n < 4; ++n) acc[m][n] = MFMA16(At[m], Bf[n], acc[m][n]);
      __builtin_amdgcn_sched_barrier(0);
    }
    WAIT_V0(); __syncthreads();
  }
  const int rbase = m0 + 128 * wr + 4 * g;
  if (sg.rs) {
#pragma unroll
    for (int m = 0; m < 8; ++m)
#pragma unroll
      for (int r = 0; r < 4; ++r) {
        const float sc = rsqrtf(sg.rs[rbase + 16 * m + r] * (1.0f / 1024.0f) + EPS);
#pragma unroll
        for (int n = 0; n < 4; ++n) acc[m][n][r] *= sc;
      }
  }
  if (sg.type == SEG_NORM) {
    float gn[4];
#pragma unroll
    for (int n = 0; n < 4; ++n) gn[n] = sg.gain[16 * n + l16] * sg.scale;
#pragma unroll
    for (int m = 0; m < 8; ++m) {
#pragma unroll
      for (int r = 0; r < 4; ++r) {
        float ss = 0.f;
#pragma unroll
        for (int n = 0; n < 4; ++n) ss += acc[m][n][r] * acc[m][n][r];
        ss += __shfl_xor(ss, 1); ss += __shfl_xor(ss, 2); ss += __shfl_xor(ss, 4); ss += __shfl_xor(ss, 8);
        const float sc = rsqrtf(ss * (1.0f / 64.0f) + EPS);
        bf16_t* d = sg.dst + (size_t)(rbase + 16 * m + r) * sg.ld + sg.col + l16;
#pragma unroll
        for (int n = 0; n < 4; ++n) d[16 * n] = f2bf(acc[m][n][r] * sc * gn[n]);
      }
      __builtin_amdgcn_sched_barrier(0);
    }
  } else if (sg.type == SEG_CHM || sg.type == SEG_CHMEM) {
#pragma unroll
    for (int m = 0; m < 8; ++m) {
#pragma unroll
      for (int n = 0; n < 4; ++n) {
        const int row = rbase + 16 * m; const int ch = sg.col + l16 + 16 * n;
        size_t off;
        if (sg.type == SEG_CHM) off = chm_index(sg.CH, row, ch);
        else off = ((size_t)((row >> 8) * 256 + ch) << 8) + (row & 255);
        uint2 v; v.x = pack2(acc[m][n][0], acc[m][n][1]); v.y = pack2(acc[m][n][2], acc[m][n][3]);
        *(uint2*)(sg.dst + off) = v;
      }
      __builtin_amdgcn_sched_barrier(0);
    }
  } else {
    float* Cs = (float*)shm;
    const int rr = tid >> 5, c4 = (tid & 31) * 4;
#pragma unroll 1
    for (int half = 0; half < 2; ++half) {
      if ((wc >> 1) == half) {
#pragma unroll
        for (int m = 0; m < 8; ++m)
#pragma unroll
          for (int n = 0; n < 4; ++n)
#pragma unroll
            for (int r = 0; r < 4; ++r) Cs[(128 * wr + 16 * m + 4 * g + r) * 132 + 64 * (wc & 1) + 16 * n + l16] = acc[m][n][r];
      }
      __syncthreads();
      const int cg = sg.col + 128 * half + c4;
#pragma unroll 2
      for (int it = 0; it < 16; ++it) {
        const int lr = it * 16 + rr; const int row = m0 + lr;
        f32x4 v = *(const f32x4*)(Cs + lr * 132 + c4);
        if (sg.type == SEG_MLP1) {
          v[0] = fmaxf(v[0], 0.f); v[1] = fmaxf(v[1], 0.f); v[2] = fmaxf(v[2], 0.f); v[3] = fmaxf(v[3], 0.f);
          uint2 u; u.x = pack2(v[0] * v[0], v[1] * v[1]); u.y = pack2(v[2] * v[2], v[3] * v[3]);
          *(uint2*)(sg.dst + (size_t)row * sg.ld + cg) = u;
        } else {
          const float* xo;
          if (sg.xin0) xo = (row < T_P) ? sg.xin0 + (size_t)row * DM : sg.xin1 + (size_t)(row - T_P) * DM;
          else xo = sg.xout + (size_t)row * DM;
          const f32x4 x = *(const f32x4*)(xo + cg);
          v += x;
          *(f32x4*)(sg.xout + (size_t)row * DM + cg) = v;
          if (sg.xb) { uint2 u; u.x = pack2(v[0], v[1]); u.y = pack2(v[2], v[3]); *(uint2*)(sg.xb + (size_t)row * DM + cg) = u; }
          if (sg.rs_out) {
            float ss = v[0] * v[0] + v[1] * v[1] + v[2] * v[2] + v[3] * v[3];
            ss += __shfl_xor(ss, 1); ss += __shfl_xor(ss, 2); ss += __shfl_xor(ss, 4); ss += __shfl_xor(ss, 8); ss += __shfl_xor(ss, 16);
            if ((tid & 31) == 0) atomicAdd(sg.rs_out + row, ss);
          }
        }
      }
      __syncthreads();
    }
  }
}

enum { AM_MEM = 0, AM_DIFF = 1, AM_WG = 2, AM_NA = 3 };
constexpr int ATT_LUT_OFS = 2 * (64 + 128) * 144;

template <int VD, int MODE>
DI void attn_core(char* smem, const bf16_t* Q, int ldq, const bf16_t* K, int ldk, const bf16_t* Vt, int ldv,
                  int qpos0, int kbeg, int kend, int nrows, float sink_l2, float (&O)[2][VD / 16][4]) {
  constexpr int NDB = VD / 16;
  constexpr int STAGE = (64 + VD) * 144;
  const int tid = opaque((int)threadIdx.x), lane = tid & 63, wave = tid >> 6;
  const int l16 = lane & 15, g = lane >> 4;
  const float* lut = (const float*)(smem + ATT_LUT_OFS);
  bf16x8 qf[2][2];
#pragma unroll
  for (int qb = 0; qb < 2; ++qb)
#pragma unroll
    for (int kk = 0; kk < 2; ++kk) qf[qb][kk] = *(const bf16x8*)(Q + (size_t)(32 * wave + 16 * qb + l16) * ldq + 32 * kk + 8 * g);
  float m[2] = {-1e30f, -1e30f}, l[2] = {0.f, 0.f};
#pragma unroll
  for (int qb = 0; qb < 2; ++qb)
#pragma unroll
    for (int db = 0; db < NDB; ++db)
#pragma unroll
      for (int r = 0; r < 4; ++r) O[qb][db][r] = 0.f;
  const int wq0 = qpos0 + 32 * wave;
  const int lrow = tid >> 3, lc = tid & 7;
  uint4 rk, rv0, rv1;
  rv1 = make_uint4(0, 0, 0, 0);
#define ATT_GLOAD(k0_) do { \
    rk = *(const uint4*)(K + (size_t)((k0_) + lrow) * ldk + 8 * lc); \
    rv0 = *(const uint4*)(Vt + (size_t)(lrow) * ldv + (k0_) + 8 * lc); \
    if (VD == 128) rv1 = *(const uint4*)(Vt + (size_t)(lrow + 64) * ldv + (k0_) + 8 * lc); } while (0)
#define ATT_SWRITE(buf_) do { \
    char* Ks_ = smem + (buf_) * STAGE; char* Vs_ = Ks_ + 64 * 144; \
    *(uint4*)(Ks_ + lrow * 144 + lc * 16) = rk; \
    *(uint4*)(Vs_ + lrow * 144 + lc * 16) = rv0; \
    if (VD == 128) *(uint4*)(Vs_ + (lrow + 64) * 144 + lc * 16) = rv1; } while (0)
  ATT_GLOAD(kbeg); ATT_SWRITE(0);
  __syncthreads();
  int it = 0;
  for (int k0 = kbeg; k0 < kend; k0 += 64, ++it) {
    const int buf = it & 1;
    const bool more = (k0 + 64 < kend);
    if (more) ATT_GLOAD(k0 + 64);
    const char* Ks = smem + buf * STAGE; const char* Vs = Ks + 64 * 144;
    bool active = true;
    if (MODE == AM_WG) active = !(k0 + 63 < wq0 - 128 || k0 > wq0 + 31 + 128);
    int na_rs = 0; const int qr = wq0 >> 6, kr = k0 >> 6;
    if (MODE == AM_NA) { na_rs = min(max(qr - 4, 0), nrows - 8); active = (kr >= na_rs && kr < na_rs + 8); }
    if (active) {
      f32x4 S[2][4];
#pragma unroll
      for (int kb = 0; kb < 4; ++kb) {
        bf16x8 kf0 = *(const bf16x8*)(Ks + (16 * kb + l16) * 144 + (8 * g) * 2);
        bf16x8 kf1 = *(const bf16x8*)(Ks + (16 * kb + l16) * 144 + (32 + 8 * g) * 2);
#pragma unroll
        for (int qb = 0; qb < 2; ++qb) {
          f32x4 z = (f32x4){0.f, 0.f, 0.f, 0.f};
          z = MFMA16(kf0, qf[qb][0], z);
          S[qb][kb] = MFMA16(kf1, qf[qb][1], z);
        }
      }
#pragma unroll
      for (int qb = 0; qb < 2; ++qb) {
        const int q = wq0 + 16 * qb + l16;
        if (MODE == AM_DIFF || MODE == AM_WG) {
          if (MODE == AM_DIFF && k0 + 63 - wq0 <= -128) {
            const float c = lut[0];
#pragma unroll
            for (int kb = 0; kb < 4; ++kb)
#pragma unroll
              for (int r = 0; r < 4; ++r) S[qb][kb][r] += c;
          } else if (MODE == AM_DIFF && k0 - (wq0 + 31) >= 128) {
            const float c = lut[256];
#pragma unroll
            for (int kb = 0; kb < 4; ++kb)
#pragma unroll
              for (int r = 0; r < 4; ++r) S[qb][kb][r] += c;
          } else {
#pragma unroll
            for (int kb = 0; kb < 4; ++kb)
#pragma unroll
              for (int r = 0; r < 4; ++r) {
                const int rel = k0 + 16 * kb + 4 * g + r - q;
                const int rc = min(max(rel, -128), 128);
                float s = S[qb][kb][r] + lut[rc + 128];
                if (MODE == AM_WG && (rel > 128 || rel < -128)) s = -1e30f;
                S[qb][kb][r] = s;
              }
          }
        } else if (MODE == AM_NA) {
          const int qc = q & 63;
          const int cs = min(max(qc - 8, 0), 48);
          const int dr = kr - qr + 7;
#pragma unroll
          for (int kb = 0; kb < 4; ++kb)
#pragma unroll
            for (int r = 0; r < 4; ++r) {
              const int kc = 16 * kb + 4 * g + r;
              const bool ok = (kc >= cs) && (kc < cs + 16);
              const int dc = min(max(kc - qc + 15, 0), 30);
              float s = S[qb][kb][r] + lut[dr * 31 + dc];
              S[qb][kb][r] = ok ? s : -1e30f;
            }
        }
      }
#pragma unroll
      for (int qb = 0; qb < 2; ++qb) {
        float mx = -1e30f;
#pragma unroll
        for (int kb = 0; kb < 4; ++kb)
#pragma unroll
          for (int r = 0; r < 4; ++r) mx = fmaxf(mx, S[qb][kb][r]);
        mx = fmaxf(mx, __shfl_xor(mx, 16)); mx = fmaxf(mx, __shfl_xor(mx, 32));
        const float mn = fmaxf(m[qb], mx);
        const float alpha = ex2(m[qb] - mn);
        m[qb] = mn;
        float ps = 0.f;
#pragma unroll
        for (int kb = 0; kb < 4; ++kb)
#pragma unroll
          for (int r = 0; r < 4; ++r) { float p = ex2(S[qb][kb][r] - mn); S[qb][kb][r] = p; ps += p; }
        l[qb] = l[qb] * alpha + ps;
#pragma unroll
        for (int db = 0; db < NDB; ++db)
#pragma unroll
          for (int r = 0; r < 4; ++r) O[qb][db][r] *= alpha;
      }
#pragma unroll
      for (int ks = 0; ks < 2; ++ks) {
        bf16x8 pf[2];
#pragma unroll
        for (int qb = 0; qb < 2; ++qb) {
          uint4 u;
          u.x = pack2(S[qb][2 * ks][0], S[qb][2 * ks][1]); u.y = pack2(S[qb][2 * ks][2], S[qb][2 * ks][3]);
          u.z = pack2(S[qb][2 * ks + 1][0], S[qb][2 * ks + 1][1]); u.w = pack2(S[qb][2 * ks + 1][2], S[qb][2 * ks + 1][3]);
          pf[qb] = __builtin_bit_cast(bf16x8, u);
        }
#pragma unroll
        for (int db = 0; db < NDB; ++db) {
          const char* vrow = Vs + (16 * db + l16) * 144 + (32 * ks + 4 * g) * 2;
          uint2 v0 = *(const uint2*)(vrow);
          uint2 v1 = *(const uint2*)(vrow + 32);
          uint4 u; u.x = v0.x; u.y = v0.y; u.z = v1.x; u.w = v1.y;
          bf16x8 vf = __builtin_bit_cast(bf16x8, u);
#pragma unroll
          for (int qb = 0; qb < 2; ++qb) {
            f32x4 o = (f32x4){O[qb][db][0], O[qb][db][1], O[qb][db][2], O[qb][db][3]};
            o = MFMA16(vf, pf[qb], o);
            O[qb][db][0] = o[0]; O[qb][db][1] = o[1]; O[qb][db][2] = o[2]; O[qb][db][3] = o[3];
          }
        }
      }
    }
    if (more) ATT_SWRITE(buf ^ 1);
    __syncthreads();
  }
#pragma unroll
  for (int qb = 0; qb < 2; ++qb) {
    float lt = l[qb];
    lt += __shfl_xor(lt, 16); lt += __shfl_xor(lt, 32);
    if (MODE == AM_WG) lt += ex2(sink_l2 - m[qb]);
    const float inv = 1.0f / lt;
#pragma unroll
    for (int db = 0; db < NDB; ++db)
#pragma unroll
      for (int r = 0; r < 4; ++r) O[qb][db][r] *= inv;
  }
}

template <int NDB>
DI void attn_store(bf16_t* dst, int ld, const float (&O)[2][NDB][4]) {
  const int lane = threadIdx.x & 63, wave = threadIdx.x >> 6, l16 = lane & 15, g = lane >> 4;
#pragma unroll
  for (int qb = 0; qb < 2; ++qb)
#pragma unroll
    for (int db = 0; db < NDB; ++db) {
      uint2 v; v.x = pack2(O[qb][db][0], O[qb][db][1]); v.y = pack2(O[qb][db][2], O[qb][db][3]);
      *(uint2*)(dst + (size_t)(32 * wave + 16 * qb + l16) * ld + 16 * db + 4 * g) = v;
    }
}

DI void seq_of_row(int row0, int& L, int& seq_row0, int& b_glob) {
  if (row0 < T_P) { L = LP; int b = row0 >> 14; seq_row0 = b << 14; b_glob = b; }
  else { L = LS; int b = (row0 - T_P) >> 11; seq_row0 = T_P + (b << 11); b_glob = 2 + b; }
}

DI void diff_item(char* smem, const Params& p, int item, bool dry = false) {
  bf16_t* QA = (bf16_t*)(p.ws + WS_R0);
  const bf16_t* KA = (const bf16_t*)((const char*)p.out + 192 * MiB);
  const bf16_t* VAt = (const bf16_t*)(p.ws + WS_R2);
  const float* misc_lut = (const float*)(p.ws + WS_MISC + MS_LUT);
  const float lam = *(const float*)(p.ws + WS_MISC + MS_LAM);
  int h, row0;
  if (item < 512) { h = item & 3; row0 = (item >> 2) * 256; }
  else { int i2 = item - 512; h = i2 & 3; row0 = T_P + (i2 >> 2) * 256; }
  int L, srow0, bg; seq_of_row(row0, L, srow0, bg);
  const int qpos0 = row0 - srow0;
  const bf16_t* Vt = VAt + chm_index(512, srow0, h * 128);
  float O[2][8][4];
  unsigned* o0s = (unsigned*)(smem + 57344) + threadIdx.x;
  const int tid = threadIdx.x;
#pragma unroll 1
  for (int mp = 0; mp < 2; ++mp) {
    __syncthreads();
    for (int i = tid; i < 257; i += NTHR) ((float*)(smem + ATT_LUT_OFS))[i] = misc_lut[(h * 2 + mp) * 257 + i];
    __syncthreads();
    attn_core<128, AM_DIFF>(smem, QA + (size_t)row0 * 512 + h * 128 + mp * 64, 512, KA + (size_t)srow0 * 512 + h * 128 + mp * 64, 512,
                            Vt, L, qpos0, 0, L, 0, 0.f, O);
    if (mp == 0) {
#pragma unroll
      for (int qb = 0; qb < 2; ++qb)
#pragma unroll
        for (int db = 0; db < 8; ++db) { o0s[((qb * 8 + db) * 2) * NTHR] = pack2(O[qb][db][0], O[qb][db][1]); o0s[((qb * 8 + db) * 2 + 1) * NTHR] = pack2(O[qb][db][2], O[qb][db][3]); }
    }
  }
  const int lane = tid & 63, l16 = lane & 15, g = lane >> 4;
  const float* sg = p.in[13];
#pragma unroll
  for (int qb = 0; qb < 2; ++qb) {
    float ss = 0.f;
#pragma unroll
    for (int db = 0; db < 8; ++db) {
      const unsigned w0 = o0s[((qb * 8 + db) * 2) * NTHR], w1 = o0s[((qb * 8 + db) * 2 + 1) * NTHR];
      float a0 = bf2f((unsigned short)(w0 & 0xffff)), a1 = bf2f((unsigned short)(w0 >> 16));
      float a2 = bf2f((unsigned short)(w1 & 0xffff)), a3 = bf2f((unsigned short)(w1 >> 16));
      O[qb][db][0] = a0 - lam * O[qb][db][0]; O[qb][db][1] = a1 - lam * O[qb][db][1];
      O[qb][db][2] = a2 - lam * O[qb][db][2]; O[qb][db][3] = a3 - lam * O[qb][db][3];
#pragma unroll
      for (int r = 0; r < 4; ++r) ss += O[qb][db][r] * O[qb][db][r];
    }
    ss += __shfl_xor(ss, 16); ss += __shfl_xor(ss, 32);
    const float sc = rsqrtf(ss * (1.0f / 128.0f) + EPS) * 0.8f;
#pragma unroll
    for (int db = 0; db < 8; ++db)
#pragma unroll
      for (int r = 0; r < 4; ++r) O[qb][db][r] *= sc * sg[16 * db + 4 * g + r];
  }
  if (dry) attn_store<8>((bf16_t*)(p.ws + WS_R3), 512, O); else attn_store<8>(QA + (size_t)row0 * 512 + h * 128, 512, O);
}

DI void wg_item(char* smem, const Params& p, int item, bool dry = false) {
  bf16_t* QD = (bf16_t*)(p.ws + WS_R3);
  const bf16_t* KD = (const bf16_t*)(p.ws + WS_KD);
  const bf16_t* VDt = (const bf16_t*)(p.ws + WS_VDT);
  const float* misc_lut = (const float*)(p.ws + WS_MISC + MS_LUT);
  const int hq = item & 7; const int row0 = (item >> 3) * 256;
  int L, srow0, bg; seq_of_row(row0, L, srow0, bg);
  const int qpos0 = row0 - srow0;
  const int kvh = hq >> 2;
  __syncthreads();
  for (int i = threadIdx.x; i < 257; i += NTHR) ((float*)(smem + ATT_LUT_OFS))[i] = misc_lut[hq * 257 + i];
  __syncthreads();
  float O[2][4][4];
  const int kbeg = max(0, qpos0 - 128), kend = min(L, qpos0 + 256 + 128);
  attn_core<64, AM_WG>(smem, QD + (size_t)row0 * 512 + hq * 64, 512, KD + (size_t)srow0 * 128 + kvh * 64, 128,
                       VDt + chm_index(128, srow0, kvh * 64), L, qpos0, kbeg, kend, 0, p.in[30][hq] * LOG2E, O);
  if (dry) attn_store<4>((bf16_t*)(p.ws + 484 * MiB), 512, O); else attn_store<4>(QD + (size_t)row0 * 512 + hq * 64, 512, O);
}

DI void na_item(char* smem, const Params& p, int item, bool dry = false) {
  bf16_t* QC = (bf16_t*)(p.ws + WS_R0);
  const bf16_t* KC = (const bf16_t*)(p.ws + WS_R1);
  const bf16_t* VCt = (const bf16_t*)(p.ws + WS_R2);
  const int h = item & 7; const int row0 = (item >> 3) * 256;
  int L, srow0, bg; seq_of_row(row0, L, srow0, bg);
  const int qpos0 = row0 - srow0;
  const int nrows = L >> 6;
  __syncthreads();
  for (int i = threadIdx.x; i < 465; i += NTHR) ((float*)(smem + ATT_LUT_OFS))[i] = p.in[27][h * 465 + i] * LOG2E;
  __syncthreads();
  const int qr0 = qpos0 >> 6;
  const int rs0 = min(max(qr0 - 4, 0), nrows - 8), rs3 = min(max(qr0 + 3 - 4, 0), nrows - 8);
  float O[2][4][4];
  attn_core<64, AM_NA>(smem, QC + (size_t)row0 * 512 + h * 64, 512, KC + (size_t)srow0 * 512 + h * 64, 512,
                       VCt + chm_index(512, srow0, h * 64), L, qpos0, rs0 * 64, (rs3 + 8) * 64, nrows, 0.f, O);
  if (dry) attn_store<4>((bf16_t*)(p.ws + 484 * MiB), 512, O); else attn_store<4>(QC + (size_t)row0 * 512 + h * 64, 512, O);
}

DI void mem_attn_tile(char* smem, const Params& p, int layer, int row0) {
  bf16_t* QM = (bf16_t*)(p.ws + WS_QM);
  const bf16_t* MK = (const bf16_t*)(p.ws + WS_MISC + MS_MK) + (size_t)layer * 18 * 256 * 256;
  const bf16_t* MVt = (const bf16_t*)(p.ws + WS_MISC + MS_MVT) + (size_t)layer * 18 * 256 * 256;
  int L, srow0, bg; seq_of_row(row0, L, srow0, bg);
#pragma unroll 1
  for (int h = 0; h < 4; ++h) {
    float O[2][4][4];
    attn_core<64, AM_MEM>(smem, QM + (size_t)row0 * 256 + h * 64, 256, MK + (size_t)bg * 256 * 256 + h * 64, 256,
                          MVt + ((size_t)(bg * 256 + h * 64) << 8), 256, 0, 0, 256, 0, 0.f, O);
    attn_store<4>(QM + (size_t)row0 * 256 + h * 64, 256, O);
  }
}

DI int PADI(int i) { return i + (i >> 5); }
DI float2 cmul(float2 a, float2 b) { return make_float2(a.x * b.x - a.y * b.y, a.x * b.y + a.y * b.x); }
DI float2 cmulc(float2 a, float2 b) { return make_float2(a.x * b.x + a.y * b.y, a.y * b.x - a.x * b.y); }
DI constexpr float C16(int m) { return m == 0 ? 1.f : m == 1 ? 0.92387953251128674f : m == 2 ? 0.70710678118654752f : m == 3 ? 0.38268343236508977f : m == 4 ? 0.f : m == 5 ? -0.38268343236508977f : m == 6 ? -0.70710678118654752f : -0.92387953251128674f; }
DI constexpr float S16(int m) { return m == 0 ? 0.f : m == 1 ? 0.38268343236508977f : m == 2 ? 0.70710678118654752f : m == 3 ? 0.92387953251128674f : m == 4 ? 1.f : m == 5 ? 0.92387953251128674f : m == 6 ? 0.70710678118654752f : 0.38268343236508977f; }

template <int LOGR, int LOGS, bool INV>
DI void fft_pass(float2* buf, int total) {
  constexpr int R = 1 << LOGR;
  constexpr int S = 1 << LOGS;
  const int tid0 = opaque((int)threadIdx.x);
#pragma unroll 1
  for (int u = tid0; u < (total >> LOGR); u += NTHR) {
    const int j = u & (S - 1);
    const int base = ((u >> LOGS) << (LOGS + LOGR)) + j;
    float2* bp = buf + PADI(base);
    float2 x[R];
#pragma unroll
    for (int k = 0; k < R; ++k) x[k] = bp[k * S + ((k * S) >> 5)];
    float2 pw[LOGR];
    {
      const float rev = -(float)j * (1.0f / (float)(R * S));
      pw[0] = make_float2(cos_rev(rev), sin_rev(rev));
#pragma unroll
      for (int i = 1; i < LOGR; ++i) pw[i] = cmul(pw[i - 1], pw[i - 1]);
    }
    if (!INV) {
#pragma unroll
      for (int i = 0; i < LOGR; ++i) {
        const int h = R >> (i + 1);
#pragma unroll
        for (int k = 0; k < R; ++k) {
          if ((k & h) == 0) {
            const int mm = (k & (h - 1)) * 8 / h;
            float2 a = x[k], b = x[k + h];
            x[k] = make_float2(a.x + b.x, a.y + b.y);
            float2 d = make_float2(a.x - b.x, a.y - b.y);
            if (mm != 0) d = cmul(d, make_float2(C16(mm), -S16(mm)));
            x[k + h] = cmul(d, pw[i]);
          }
        }
      }
    } else {
#pragma unroll
      for (int i = LOGR - 1; i >= 0; --i) {
        const int h = R >> (i + 1);
#pragma unroll
        for (int k = 0; k < R; ++k) {
          if ((k & h) == 0) {
            const int mm = (k & (h - 1)) * 8 / h;
            float2 a = x[k];
            float2 d = cmulc(x[k + h], pw[i]);
            if (mm != 0) d = cmulc(d, make_float2(C16(mm), -S16(mm)));
            x[k] = make_float2(a.x + d.x, a.y + d.y);
            x[k + h] = make_float2(a.x - d.x, a.y - d.y);
          }
        }
      }
    }
#pragma unroll
    for (int k = 0; k < R; ++k) bp[k * S + ((k * S) >> 5)] = x[k];
  }
  __syncthreads();
}

template <int LOGN>
DI void fft_fwd(float2* buf, int total) {
  if (LOGN == 14) { fft_pass<4, 10, false>(buf, total); fft_pass<4, 6, false>(buf, total); fft_pass<4, 2, false>(buf, total); fft_pass<2, 0, false>(buf, total); }
  else { fft_pass<4, 7, false>(buf, total); fft_pass<4, 3, false>(buf, total); fft_pass<3, 0, false>(buf, total); }
}
template <int LOGN>
DI void fft_inv(float2* buf, int total) {
  if (LOGN == 14) { fft_pass<2, 0, true>(buf, total); fft_pass<4, 2, true>(buf, total); fft_pass<4, 6, true>(buf, total); fft_pass<4, 10, true>(buf, total); }
  else { fft_pass<3, 0, true>(buf, total); fft_pass<4, 3, true>(buf, total); fft_pass<4, 7, true>(buf, total); }
}

template <int LOGN, int NB, int NSUB>
DI void hyena_item(char* smem, const Params& p, int c, int row_base  ) {
  constexpr int L = 1 << LOGN;
  constexpr int SPT = L / NTHR;
  constexpr int EPT = NB * L / NTHR;
  const int tid = opaque((int)threadIdx.x);
  float2* buf = (float2*)smem;
  float* sm_w3 = (float*)(smem + 135168);
  float* sm_red = sm_w3 + 128;
  char* scr = p.ws + WS_XB + (size_t)blockIdx.x * HY_SCR_PER_BLOCK;
  float* scrF = (float*)scr;
  float* scrB = scrF + L;
  float2* scrY = (float2*)(scr + 128 * 1024);
  float2* scrZ = (float2*)(scr + 256 * 1024);
  float2* scrS = (float2*)(scr + 384 * 1024);
  const bf16_t* UH = (const bf16_t*)p.out;
  bf16_t* OB = (bf16_t*)(p.ws + WS_R1);
  const float* h2 = (const float*)(p.ws + WS_MISC + (LOGN == 14 ? MS_H2P : MS_H2S));
  const float* w3 = p.in[21];
  const float* cw = p.in[14]; const float* cb = p.in[15]; const float* skp = p.in[22];
  const float delta = fabsf(-3.0701134573253945f + (float)c * ((-15.350567286626973f + 3.0701134573253945f) / 511.0f));
  const float invLm1 = 1.0f / (float)(L - 1);

  auto conv3 = [&](int b, int ch, int n) -> float {
    const bf16_t* u = UH + chm_index(1536, row_base + b * L, ch) + n;
    float v = bf2f(u[0]) * cw[1536 + ch] + cb[ch];
    if (n > 0) v += bf2f(u[-1]) * cw[ch];
    if (n < L - 1) v += bf2f(u[1]) * cw[2 * 1536 + ch];
    return v;
  };

#pragma unroll 1
  for (int o = 0; o < 2; ++o) {
    __syncthreads();
    if (tid < 128) sm_w3[tid] = w3[(size_t)(tid & 63) * 2048 + (o * 2 + (tid >> 6)) * 512 + c];
    __syncthreads();
    float asum = 0.f;
#pragma unroll 1
    for (int i = 0; i < SPT; ++i) {
      const int t = tid + NTHR * i;
      const float4* hr = (const float4*)(h2 + (size_t)t * 64);
      float f = 0.f, bk = 0.f;
#pragma unroll 4
      for (int q4 = 0; q4 < 16; ++q4) {
        float4 hv = hr[q4];
        const f32x4 wf = *(const volatile f32x4*)(sm_w3 + 4 * q4);
        const f32x4 wb = *(const volatile f32x4*)(sm_w3 + 64 + 4 * q4);
        f += hv.x * wf.x + hv.y * wf.y + hv.z * wf.z + hv.w * wf.w;
        bk += hv.x * wb.x + hv.y * wb.y + hv.z * wb.z + hv.w * wb.w;
      }
      const float dec = ex2(-(float)t * invLm1 * delta * LOG2E);
      f *= dec; bk *= dec;
      scrF[t] = f; scrB[t] = bk;
      asum += fabsf(f) + (t >= 1 ? fabsf(bk) : 0.f);
    }
#pragma unroll
    for (int s = 32; s >= 1; s >>= 1) asum += __shfl_xor(asum, s);
    if ((tid & 63) == 0) sm_red[tid >> 6] = asum;
    block_sync_global();
    float nrm = 0.f;
#pragma unroll
    for (int w = 0; w < 8; ++w) nrm += sm_red[w];
    const float inv_nrm = 1.0f / nrm;
    const float sk = skp[o * 512 + c];

#pragma unroll 1
    for (int par = 0; par < 2; ++par) {
#pragma unroll 2
      for (int i = 0; i < SPT; ++i) {
        const int n = tid + NTHR * i;
        const float f = scrF[n];
        const float br = (n == 0) ? 0.f : scrB[L - n];
        float2 v;
        if (par == 0) v = make_float2((f + br) * inv_nrm, 0.f);
        else { const float gm = (f - br) * inv_nrm; const float rev = -(float)n / (float)(2 * L); v = make_float2(gm * cos_rev(rev), gm * sin_rev(rev)); }
        buf[PADI(n)] = v;
      }
      __syncthreads();
      fft_fwd<LOGN>(buf, L);
#pragma unroll 2
      for (int i = 0; i < SPT; ++i) scrS[tid + NTHR * i] = buf[PADI(tid + NTHR * i)];
      __syncthreads();
#pragma unroll 1
      for (int sub = 0; sub < NSUB; ++sub) {
#pragma unroll 2
        for (int i = 0; i < EPT; ++i) {
          const int e = tid + NTHR * i; const int f = e >> LOGN, n = e & (L - 1);
          const int pp = sub * NB + f;
          float2 z;
          if (o == 0 && par == 0) { z = make_float2(conv3(2 * pp, c, n), conv3(2 * pp + 1, c, n)); scrZ[(size_t)pp * L + n] = z; }
          else z = scrZ[(size_t)pp * L + n];
          if (par == 1) { const float rev = -(float)n / (float)(2 * L); z = cmul(z, make_float2(cos_rev(rev), sin_rev(rev))); }
          buf[PADI(e)] = z;
        }
        __syncthreads();
        fft_fwd<LOGN>(buf, NB * L);
#pragma unroll 2
        for (int i = 0; i < EPT; ++i) {
          const int e = tid + NTHR * i;
          buf[PADI(e)] = cmul(buf[PADI(e)], scrS[e & (L - 1)]);
        }
        __syncthreads();
        fft_inv<LOGN>(buf, NB * L);
#pragma unroll 2
        for (int i = 0; i < EPT; ++i) {
          const int e = tid + NTHR * i; const int f = e >> LOGN, n = e & (L - 1);
          const int pp = sub * NB + f;
          float2 y = buf[PADI(e)];
          if (par == 0) { scrY[(size_t)pp * L + n] = y; }
          else {
            const float rev = -(float)n / (float)(2 * L);
            y = cmulc(y, make_float2(cos_rev(rev), sin_rev(rev)));
            const float2 ye = scrY[(size_t)pp * L + n];
            const float2 z = scrZ[(size_t)pp * L + n];
            const float sc = 0.5f / (float)L;
            const float c0 = (ye.x + y.x) * sc + sk * z.x;
            const float c1 = (ye.y + y.y) * sc + sk * z.y;
            const int gch = (o == 0 ? 512 : 1024) + c;
            const float z0 = conv3(2 * pp, gch, n) * c0;
            const float z1 = conv3(2 * pp + 1, gch, n) * c1;
            if (o == 0) scrZ[(size_t)pp * L + n] = make_float2(z0, z1);
            else {
              OB[(size_t)(row_base + (2 * pp) * L + n) * 512 + c] = f2bf(z0);
              OB[(size_t)(row_base + (2 * pp + 1) * L + n) * 512 + c] = f2bf(z1);
            }
          }
        }
        __syncthreads();
      }
    }
  }
}

struct WMat { const float* src; int K; int N; const float* gain; bf16_t* dst; };
DI WMat get_wmat(const Params& p, int id) {
  bf16_t* W = (bf16_t*)(p.ws + WS_W);
  WMat m;
  switch (id) {
    case 0: m = {p.in[9], 1024, 3072, p.in[5], W + W_INE}; break;
    case 1: m = {p.in[23], 1024, 1024, nullptr, W + W_OUTE}; break;
    case 2: m = {p.in[24], 1024, 2304, p.in[5] + 1024, W + W_INO}; break;
    case 3: m = {p.in[31], 1024, 1024, nullptr, W + W_OUTO}; break;
    case 4: m = {p.in[32], 1024, 256, p.in[6], W + W_Q}; break;
    case 5: m = {p.in[32] + 1024 * 256, 1024, 256, p.in[6] + 1024, W + W_Q + 256 * 1024}; break;
    case 6: m = {p.in[33], 1024, 512, p.in[7], W + W_KV}; break;
    case 7: m = {p.in[33] + 1024 * 512, 1024, 512, p.in[7] + 1024, W + W_KV + 512 * 1024}; break;
    case 8: m = {p.in[34], 256, 1024, nullptr, W + W_O}; break;
    case 9: m = {p.in[34] + 256 * 1024, 256, 1024, nullptr, W + W_O + 1024 * 256}; break;
    case 10: m = {p.in[37], 1024, 4096, p.in[8], W + W_1}; break;
    case 11: m = {p.in[37] + (size_t)1024 * 4096, 1024, 4096, p.in[8] + 1024, W + W_1 + (size_t)4096 * 1024}; break;
    case 12: m = {p.in[38], 4096, 1024, nullptr, W + W_2}; break;
    default: m = {p.in[38] + (size_t)4096 * 1024, 4096, 1024, nullptr, W + W_2 + (size_t)4096 * 1024}; break;
  }
  return m;
}

DI void prep_wtile(char* smem, const WMat& m, int tile) {
  float* t = (float*)smem;
  const int ntn = m.N >> 6;
  const int k0 = (tile / ntn) << 6, n0 = (tile % ntn) << 6;
  const int tid = threadIdx.x;
  __syncthreads();
  {
    const int kk = tid >> 4, n4 = (tid & 15) * 4;
#pragma unroll
    for (int i = 0; i < 2; ++i) {
      const int k = kk + 32 * i;
      float4 v = *(const float4*)(m.src + (size_t)(k0 + k) * m.N + n0 + n4);
      const float gk = m.gain ? m.gain[k0 + k] : 1.0f;
      t[k * 65 + n4] = v.x * gk; t[k * 65 + n4 + 1] = v.y * gk; t[k * 65 + n4 + 2] = v.z * gk; t[k * 65 + n4 + 3] = v.w * gk;
    }
  }
  __syncthreads();
  {
    const int n = tid >> 3, kc = tid & 7;
    uint4 u;
    u.x = pack2(t[(8 * kc) * 65 + n], t[(8 * kc + 1) * 65 + n]); u.y = pack2(t[(8 * kc + 2) * 65 + n], t[(8 * kc + 3) * 65 + n]);
    u.z = pack2(t[(8 * kc + 4) * 65 + n], t[(8 * kc + 5) * 65 + n]); u.w = pack2(t[(8 * kc + 6) * 65 + n], t[(8 * kc + 7) * 65 + n]);
    *(uint4*)(m.dst + (size_t)(n0 + n) * m.K + k0 + 8 * kc) = u;
  }
}

DI void prep_row(const float* src, bf16_t* dst, float* ssq) {
  const int lane = threadIdx.x & 63;
  float ss = 0.f;
#pragma unroll
  for (int i = 0; i < 4; ++i) {
    float4 v = *(const float4*)(src + (i * 64 + lane) * 4);
    ss += v.x * v.x + v.y * v.y + v.z * v.z + v.w * v.w;
    uint2 u; u.x = pack2(v.x, v.y); u.y = pack2(v.z, v.w);
    *(uint2*)(dst + (i * 64 + lane) * 4) = u;
  }
#pragma unroll
  for (int s = 32; s >= 1; s >>= 1) ss += __shfl_xor(ss, s);
  if (lane == 0) *ssq = ss;
}

DI void prep_h2(const Params& p, int L, int t, float* dst) {
  const int j = threadIdx.x & 63;
  const float* w1 = p.in[16]; const float* b1 = p.in[17]; const float* fr = p.in[18]; const float* w2 = p.in[19]; const float* b2 = p.in[20];
  const float t01 = (float)t / (float)(L - 1);
  const float tl = (float)t / (float)L;
  float a = t01 * w1[j] + b1[j];
#pragma unroll
  for (int k = 0; k < 8; ++k) {
    const float fk = 1e-4f + (float)k * ((7.0f - 1e-4f) / 7.0f);
    const float rev = tl * fk;
    a += cos_rev(rev) * w1[(1 + k) * 64 + j] - sin_rev(rev) * w1[(9 + k) * 64 + j];
  }
  const float h1 = sin_rev(fr[j] * a * 0.15915494309189535f);
  float a2 = b2[j];
  for (int i = 0; i < 64; ++i) a2 += __shfl(h1, i) * w2[i * 64 + j];
  dst[(size_t)t * 64 + j] = sin_rev(fr[64 + j] * a2 * 0.15915494309189535f);
}

constexpr int PREP_NW = 768 + 256 + 576 + 256 + 64 + 64 + 128 + 128 + 64 + 64 + 1024 + 1024 + 1024 + 1024;
constexpr int PREP_T_ROWS = PREP_NW;
constexpr int PREP_T_MEM = PREP_T_ROWS + 8192;
constexpr int PREP_T_H2 = PREP_T_MEM + 576;
constexpr int PREP_T_MISC = PREP_T_H2 + 2304;
constexpr int PREP_TOTAL = PREP_T_MISC + 1;

DI void phase_prep(char* smem, const Params& p) {
  const int tid = threadIdx.x, wave = tid >> 6;
#pragma unroll 1
  for (int task = blockIdx.x; task < PREP_TOTAL; task += gridDim.x) {
    if (task < PREP_NW) {
      int t = task, id = 0;
      for (; id < 14; ++id) { WMat m = get_wmat(p, id); int n = (m.K >> 6) * (m.N >> 6); if (t < n) break; t -= n; }
      WMat m = get_wmat(p, id);
      prep_wtile(smem, m, t);
    } else if (task < PREP_T_MEM) {
      const int row = (task - PREP_T_ROWS) * 8 + wave;
      const float* src = (row < T_P) ? p.in[0] + (size_t)row * DM : p.in[1] + (size_t)(row - T_P) * DM;
      float* RS = (float*)(p.ws + WS_MISC + MS_RS);
      prep_row(src, (bf16_t*)(p.ws + WS_XB) + (size_t)row * DM, RS + row);
      if ((tid & 63) < 5) RS[(size_t)(1 + (tid & 63)) * T_ALL + row] = 0.f;
    } else if (task < PREP_T_H2) {
      const int row = (task - PREP_T_MEM) * 8 + wave;
      const float* src = (row < 512) ? p.in[2] + (size_t)row * DM : p.in[3] + (size_t)(row - 512) * DM;
      prep_row(src, (bf16_t*)(p.ws + WS_R1) + (size_t)row * DM, (float*)(p.ws + WS_MISC + MS_RSM) + row);
    } else if (task < PREP_T_MISC) {
      const int t = (task - PREP_T_H2) * 8 + wave;
      if (t < LP) prep_h2(p, LP, t, (float*)(p.ws + WS_MISC + MS_H2P));
      else prep_h2(p, LS, t - LP, (float*)(p.ws + WS_MISC + MS_H2S));
    } else {
      float* lut = (float*)(p.ws + WS_MISC + MS_LUT);
      for (int i = tid; i < 8 * 257; i += NTHR) {
        const int hh = i / 257, rel = (i % 257) - 128;
        const int n = rel < 0 ? -rel : rel;
        int bkt;
        if (n < 8) bkt = n; else { bkt = 2 + (31 - __clz(n * n)); if (bkt > 15) bkt = 15; }
        if (rel > 0) bkt += 16;
        lut[i] = p.in[4][bkt * 8 + hh] * LOG2E;
      }
      if (tid < 64) {
        const float* lf = p.in[12];
        float a = lf[tid] * lf[64 + tid], b = lf[128 + tid] * lf[192 + tid];
#pragma unroll
        for (int s = 32; s >= 1; s >>= 1) { a += __shfl_xor(a, s); b += __shfl_xor(b, s); }
        if (tid == 0) *(float*)(p.ws + WS_MISC + MS_LAM) = expf(a) - expf(b) + 0.2f;
      }
    }
  }
}

DI Seg seg_inproj(const Params& p, int layer, int col0, const float* rs) {
  Seg s{}; s.rs = rs; s.scale = 1.0f;
  if (layer == 0) {
    if (col0 < 512) { s.type = SEG_NORM; s.dst = (bf16_t*)(p.ws + WS_R0); s.ld = 512; s.col = col0; s.gain = p.in[10]; s.scale = QSCALE; }
    else if (col0 < 1024) { s.type = SEG_NORM; s.dst = (bf16_t*)((char*)p.out + 192 * MiB); s.ld = 512; s.col = col0 - 512; s.gain = p.in[11]; }
    else if (col0 < 1536) { s.type = SEG_CHM; s.dst = (bf16_t*)(p.ws + WS_R2); s.CH = 512; s.col = col0 - 1024; }
    else { s.type = SEG_CHM; s.dst = (bf16_t*)p.out; s.CH = 1536; s.col = col0 - 1536; }
  } else {
    if (col0 < 512) { s.type = SEG_NORM; s.dst = (bf16_t*)(p.ws + WS_R0); s.ld = 512; s.col = col0; s.gain = p.in[25]; s.scale = QSCALE; }
    else if (col0 < 1024) { s.type = SEG_NORM; s.dst = (bf16_t*)(p.ws + WS_R1); s.ld = 512; s.col = col0 - 512; s.gain = p.in[26]; }
    else if (col0 < 1536) { s.type = SEG_CHM; s.dst = (bf16_t*)(p.ws + WS_R2); s.CH = 512; s.col = col0 - 1024; }
    else if (col0 < 2048) { s.type = SEG_NORM; s.dst = (bf16_t*)(p.ws + WS_R3); s.ld = 512; s.col = col0 - 1536; s.gain = p.in[28]; s.scale = QSCALE; }
    else if (col0 < 2176) { s.type = SEG_NORM; s.dst = (bf16_t*)(p.ws + WS_KD); s.ld = 128; s.col = col0 - 2048; s.gain = p.in[29]; }
    else { s.type = SEG_CHM; s.dst = (bf16_t*)(p.ws + WS_VDT); s.CH = 128; s.col = col0 - 2176; }
  }
  return s;
}

DI void phase_inproj(char* smem, const Params& p, int layer) {
  const int NTn = layer == 0 ? 12 : 9;
  const int n_main = 256 * NTn;
  const int n_total = n_main + (layer == 0 ? 72 : 0);
  const bf16_t* W = (const bf16_t*)(p.ws + WS_W);
  const int wc = (threadIdx.x >> 6) & 3;
#pragma unroll 1
  for (int tile = blockIdx.x; tile < n_total; tile += gridDim.x) {
    if (tile < n_main) {
      const int mt = tile / NTn, nt = tile % NTn;
      GemmArgs ga{(const bf16_t*)(p.ws + WS_XB), nullptr, 1 << 30, DM, W + (layer == 0 ? W_INE : W_INO), DM, DM};
      Seg s = seg_inproj(p, layer, nt * 256 + 64 * wc, (const float*)(p.ws + WS_MISC + MS_RS) + (size_t)(layer * 3) * T_ALL);
      gemm_tile(smem, ga, mt * 256, nt * 256, s);
    } else {
      const int t2 = tile - n_main; const int l = t2 / 36, r = t2 % 36; const int mt = r >> 1, nt = r & 1;
      GemmArgs ga{(const bf16_t*)(p.ws + WS_R1), nullptr, 1 << 30, DM, W + W_KV + (size_t)l * 512 * 1024, DM, DM};
      Seg s{}; s.rs = (const float*)(p.ws + WS_MISC + MS_RSM); s.scale = 1.0f;
      const int col0 = nt * 256 + 64 * wc;
      if (col0 < 256) { s.type = SEG_NORM; s.dst = (bf16_t*)(p.ws + WS_MISC + MS_MK) + (size_t)l * 18 * 256 * 256; s.ld = 256; s.col = col0; s.gain = p.in[36] + l * 64; }
      else { s.type = SEG_CHMEM; s.dst = (bf16_t*)(p.ws + WS_MISC + MS_MVT) + (size_t)l * 18 * 256 * 256; s.col = col0 - 256; }
      gemm_tile(smem, ga, mt * 256, nt * 256, s);
    }
  }
}

DI void phase_mixer0(char* smem, const Params& p) {
#pragma unroll 1
  for (int item = blockIdx.x; item < 2048; item += gridDim.x) {
    const int kind = item >> 9, idx = item & 511;
#ifndef SUBP
#define SUBP -1
#endif
    if (kind == 0 || kind == 2) {
      if (PROBE & 4) diff_item(smem, p, (kind == 2 ? 512 : 0) + idx, true);
      diff_item(smem, p, (kind == 2 ? 512 : 0) + idx);
    } else if (kind == 1) {
      if (PROBE & 8) hyena_item<14, 1, 1>(smem, p, idx, 0);
      hyena_item<14, 1, 1>(smem, p, idx, 0);
    } else {
      if (PROBE & 8) hyena_item<11, 4, 2>(smem, p, idx, T_P);
      hyena_item<11, 4, 2>(smem, p, idx, T_P);
    }
  }
}
DI void phase_mixer1(char* smem, const Params& p) {
#pragma unroll 1
  for (int item = blockIdx.x; item < 4096; item += gridDim.x) {
    if (PROBE & 16) { if (item < 2048) na_item(smem, p, item, true); else wg_item(smem, p, item - 2048, true); }
    if (item < 2048) na_item(smem, p, item); else wg_item(smem, p, item - 2048);
  }
}

DI void phase_post(char* smem, const Params& p, int layer) {
  const bf16_t* W = (const bf16_t*)(p.ws + WS_W);
  float* RS = (float*)(p.ws + WS_MISC + MS_RS);
  bf16_t* XB = (bf16_t*)(p.ws + WS_XB);
  bf16_t* H = (bf16_t*)(p.ws + (layer == 0 ? WS_H_L0 : WS_H_L1));
  bf16_t* QM = (bf16_t*)(p.ws + WS_QM);
  const int wn = (threadIdx.x >> 6) & 1;
#pragma unroll 1
  for (int mt = blockIdx.x; mt < 256; mt += gridDim.x) {
    const int m0 = mt * 256;
#ifndef CHAINP
#define CHAINP -1
#endif
    if (CHAINP < 0 || CHAINP == 1) {
      GemmArgs ga{(const bf16_t*)(p.ws + WS_R0), (const bf16_t*)(p.ws + (layer == 0 ? WS_R1 : WS_R3)), 512, 512, W + (layer == 0 ? W_OUTE : W_OUTO), DM, DM};
      Seg s{}; s.type = SEG_RESID; s.xin0 = layer == 0 ? p.in[0] : nullptr; s.xin1 = layer == 0 ? p.in[1] : nullptr;
      s.xout = p.out; s.xb = XB; s.rs_out = RS + (size_t)(layer * 3 + 1) * T_ALL;
      _Pragma("unroll 1") for (int nt = 0; nt < 4; ++nt) { s.col = nt * 256; gemm_tile(smem, ga, m0, nt * 256, s); }
    }
    block_sync_global();
    if (CHAINP < 0 || CHAINP == 2) {
      GemmArgs ga{XB, nullptr, 1 << 30, DM, W + W_Q + (size_t)layer * 256 * 1024, DM, DM};
      Seg s{}; s.type = SEG_NORM; s.rs = RS + (size_t)(layer * 3 + 1) * T_ALL; s.dst = QM; s.ld = 256; s.gain = p.in[35] + layer * 64; s.scale = QSCALE;
      s.col = 64 * ((threadIdx.x >> 6) & 3);
      gemm_tile(smem, ga, m0, 0, s);
    }
    block_sync_global();
    if (CHAINP < 0 || CHAINP == 3) mem_attn_tile(smem, p, layer, m0);
    block_sync_global();
    if (CHAINP < 0 || CHAINP == 4) {
      GemmArgs ga{QM, nullptr, 1 << 30, 256, W + W_O + (size_t)layer * 1024 * 256, 256, 256};
      Seg s{}; s.type = SEG_RESID; s.xout = p.out; s.xb = XB; s.rs_out = RS + (size_t)(layer * 3 + 2) * T_ALL;
      _Pragma("unroll 1") for (int nt = 0; nt < 4; ++nt) { s.col = nt * 256; gemm_tile(smem, ga, m0, nt * 256, s); }
    }
    block_sync_global();
    if (CHAINP < 0 || CHAINP == 5) _Pragma("unroll 1") for (int hc = 0; hc < 4; ++hc) {
      {
        GemmArgs ga{XB, nullptr, 1 << 30, DM, W + W_1 + (size_t)layer * 4096 * 1024 + (size_t)hc * 1024 * 1024, DM, DM};
        Seg s{}; s.type = SEG_MLP1; s.rs = RS + (size_t)(layer * 3 + 2) * T_ALL; s.dst = H; s.ld = 1024;
        _Pragma("unroll 1") for (int nt = 0; nt < 4; ++nt) { s.col = nt * 256; gemm_tile(smem, ga, m0, nt * 256, s); }
      }
      block_sync_global();
      {
        GemmArgs ga{H, nullptr, 1 << 30, 1024, W + W_2 + (size_t)layer * 4096 * 1024 + (size_t)hc * 1024, 4096, 1024};
        Seg s{}; s.type = SEG_RESID; s.xout = p.out;
        if (hc == 3 && layer == 0) { s.xb = XB; s.rs_out = RS + (size_t)3 * T_ALL; }
        _Pragma("unroll 1") for (int nt = 0; nt < 4; ++nt) { s.col = nt * 256; gemm_tile(smem, ga, m0, nt * 256, s); }
      }
      block_sync_global();
    }
  }
  (void)wn;
}

__global__ void __launch_bounds__(NTHR) fwd_kernel(Params p, int ph_lo, int ph_hi) {
  extern __shared__ __attribute__((aligned(16))) char smem[];
#define RUN_PHASE(i_, call_) if (ph_lo <= (i_) && (i_) <= ph_hi) { if ((i_) > ph_lo) { __threadfence(); cg::this_grid().sync(); } call_; }
  RUN_PHASE(0, phase_prep(smem, p))
  if (PROBE & 1) { __syncthreads(); phase_prep(smem, p); }
  RUN_PHASE(1, phase_inproj(smem, p, 0))
  if (PROBE & 2) { __syncthreads(); phase_inproj(smem, p, 0); }
  RUN_PHASE(2, phase_mixer0(smem, p))
  RUN_PHASE(3, phase_post(smem, p, 0))
  RUN_PHASE(4, phase_inproj(smem, p, 1))
  if (PROBE & 2) { __syncthreads(); phase_inproj(smem, p, 1); }
  RUN_PHASE(5, phase_mixer1(smem, p))
  RUN_PHASE(6, phase_post(smem, p, 1))
}

#ifndef ONE_LAUNCH
#define ONE_LAUNCH 1
#endif

extern "C" void kernel_launch(void* const* d_in, const int* in_sizes, int n_in, void* d_out, int out_size, void* d_ws, size_t ws_size,
                              hipStream_t stream) {
  static int grid = 0;
  if (grid == 0) {
    if (n_in != 39 || ws_size < WS_NEED || out_size != T_ALL * DM) { fprintf(stderr, "kernel_launch: unexpected shapes n_in %d ws %zu out %d\n", n_in, ws_size, out_size); grid = -1; return; }
    if (hipFuncSetAttribute((const void*)fwd_kernel, hipFuncAttributeMaxDynamicSharedMemorySize, SMEM_BYTES) != hipSuccess) { fprintf(stderr, "hipFuncSetAttribute failed\n"); grid = -1; return; }
    int dev = 0, cus = 0, per_cu = 0;
    hipGetDevice(&dev);
    hipDeviceGetAttribute(&cus, hipDeviceAttributeMultiprocessorCount, dev);
    hipOccupancyMaxActiveBlocksPerMultiprocessor(&per_cu, (const void*)fwd_kernel, NTHR, SMEM_BYTES);
    if (per_cu < 1 || cus < 1) { fprintf(stderr, "occupancy query: %d blocks/CU, %d CUs\n", per_cu, cus); grid = -1; return; }
    grid = cus;
  }
  if (grid < 0) return;
  Params p{};
  for (int i = 0; i < 39; ++i) p.in[i] = (const float*)d_in[i];
  p.out = (float*)d_out; p.ws = (char*)d_ws;
#if ONE_LAUNCH
  int lo = 0, hi = 6;
  void* args[] = {&p, &lo, &hi};
  hipError_t e = hipLaunchCooperativeKernel((const void*)fwd_kernel, dim3(grid), dim3(NTHR), args, SMEM_BYTES, stream);
  if (e != hipSuccess) fprintf(stderr, "cooperative launch failed: %s\n", hipGetErrorString(e));
#else
  for (int ph = 0; ph <= 6; ++ph) hipLaunchKernelGGL(fwd_kernel, dim3(grid), dim3(NTHR), SMEM_BYTES, stream, p, ph, ph);
#endif
}
```

```cpp
#include <hip/hip_runtime.h>
#include <hip/hip_cooperative_groups.h>
#include <cstdio>
namespace cg = cooperative_groups;

#define DI __device__ __forceinline__
#define PROBE 0
typedef unsigned short bf16_t;
using bf16x8 = __attribute__((ext_vector_type(8))) short;
using s16x4 = __attribute__((ext_vector_type(4))) short;
using f32x4 = __attribute__((ext_vector_type(4))) float;
#define MFMA16(a, b, c) __builtin_amdgcn_mfma_f32_16x16x32_bf16((a), (b), (c), 0, 0, 0)

constexpr int NTHR = 512;
constexpr int T_ALL = 65536;
constexpr int T_P = 32768;
constexpr int LP = 16384, LS = 2048;
constexpr int DM = 1024;
constexpr float EPS = 1e-6f;
constexpr float LOG2E = 1.4426950408889634f;
constexpr float QSCALE = 0.125f * 1.4426950408889634f;
constexpr int SMEM_BYTES = 144 * 1024;
constexpr size_t MiB = (size_t)1 << 20;

constexpr size_t WS_XB = 0;
constexpr size_t WS_W = 128 * MiB;
constexpr size_t W_INE = 0;
constexpr size_t W_OUTE = W_INE + (size_t)3072 * 1024;
constexpr size_t W_INO = W_OUTE + (size_t)1024 * 1024;
constexpr size_t W_OUTO = W_INO + (size_t)2304 * 1024;
constexpr size_t W_Q = W_OUTO + (size_t)1024 * 1024;
constexpr size_t W_KV = W_Q + (size_t)2 * 256 * 1024;
constexpr size_t W_O = W_KV + (size_t)2 * 512 * 1024;
constexpr size_t W_1 = W_O + (size_t)2 * 1024 * 256;
constexpr size_t W_2 = W_1 + (size_t)2 * 4096 * 1024;
constexpr size_t W_END = W_2 + (size_t)2 * 4096 * 1024;
static_assert(W_END * 2 <= 51 * MiB, "weights");
constexpr size_t WS_MISC = 179 * MiB;
constexpr size_t MS_RS = 0;
constexpr size_t MS_RSM = MS_RS + (size_t)6 * T_ALL * 4;
constexpr size_t MS_MK = MS_RSM + 32768;
constexpr size_t MS_MVT = MS_MK + (size_t)2 * 18 * 256 * 256 * 2;
constexpr size_t MS_H2P = MS_MVT + (size_t)2 * 18 * 256 * 256 * 2;
constexpr size_t MS_H2S = MS_H2P + (size_t)LP * 64 * 4;
constexpr size_t MS_LUT = MS_H2S + (size_t)LS * 64 * 4;
constexpr size_t MS_LAM = MS_LUT + 16384;
constexpr size_t MS_END = MS_LAM + 256;
static_assert(MS_END <= 16 * MiB, "misc");
constexpr size_t WS_R0 = 195 * MiB;
constexpr size_t WS_R1 = 259 * MiB;
constexpr size_t WS_R2 = 323 * MiB;
constexpr size_t WS_R3 = 387 * MiB;
constexpr size_t WS_KD = 451 * MiB;
constexpr size_t WS_VDT = 467 * MiB;
constexpr size_t WS_QM = 451 * MiB;
constexpr size_t WS_H_L0 = 323 * MiB;
constexpr size_t WS_H_L1 = 259 * MiB;
constexpr size_t WS_NEED = 512 * MiB;
constexpr size_t HY_SCR_PER_BLOCK = 512 * 1024;

struct Params {
  const float* in[39];
  float* out;
  char* ws;
};

DI unsigned short f2bf(float x) { unsigned u = __float_as_uint(x); u += 0x7fffu + ((u >> 16) & 1u); return (unsigned short)(u >> 16); }
DI unsigned pack2(float a, float b) { return (unsigned)f2bf(a) | ((unsigned)f2bf(b) << 16); }
DI float bf2f(unsigned short h) { return __uint_as_float(((unsigned)h) << 16); }
DI float ex2(float x) { return __builtin_amdgcn_exp2f(x); }
DI float sin_rev(float r) { return __builtin_amdgcn_sinf(r); }
DI float cos_rev(float r) { return __builtin_amdgcn_cosf(r); }
DI int opaque(int x) { asm volatile("" : "+v"(x)); return x; }
DI float dpp_f(float v, int ctrl_sel) {
  int x = __float_as_int(v), r;
  if (ctrl_sel == 0) r = __builtin_amdgcn_update_dpp(x, x, 0xB1, 0xF, 0xF, false);
  else if (ctrl_sel == 1) r = __builtin_amdgcn_update_dpp(x, x, 0x4E, 0xF, 0xF, false);
  else if (ctrl_sel == 2) r = __builtin_amdgcn_update_dpp(x, x, 0x141, 0xF, 0xF, false);
  else r = __builtin_amdgcn_update_dpp(x, x, 0x140, 0xF, 0xF, false);
  return __int_as_float(r);
}
DI float row16_sum(float v) { v += dpp_f(v, 0); v += dpp_f(v, 1); v += dpp_f(v, 2); v += dpp_f(v, 3); return v; }
DI void block_sync_global() { __syncthreads(); }

DI size_t chm_index(int CH, int row, int ch) {
  if (row < T_P) { int b = row >> 14, t = row & (LP - 1); return ((size_t)(b * CH + ch) << 14) + t; }
  int r = row - T_P; int b = r >> 11, t = r & (LS - 1);
  return (size_t)T_P * CH + ((size_t)(b * CH + ch) << 11) + t;
}

struct GemmArgs {
  const bf16_t* A0; const bf16_t* A1; int ksplit; int lda;
  const bf16_t* Wt; int ldw; int K;
};
enum { SEG_NORM = 0, SEG_CHM = 1, SEG_CHMEM = 2, SEG_RESID = 3, SEG_MLP1 = 4 };
struct Seg {
  int type;
  bf16_t* dst; int ld; int col;
  const float* gain; float scale;
  int CH;
  const float* rs;
  const float* xin0; const float* xin1; float* xout; bf16_t* xb; float* rs_out;
};
constexpr int G_TILE_B = 256 * 64 * 2, G_STAGE_B = 2 * G_TILE_B;
DI int g_lds_byte(int r, int c) { int st = (r >> 4) * 2 + (c >> 5), ob = (r & 15) * 64 + (c & 31) * 2; return st * 1024 + (ob ^ (((ob >> 9) & 1) << 5)); }
DI void g_stage_rc(int b, int& R, int& C) { int st = b >> 10, sb = b & 1023, swz = sb ^ (((sb >> 9) & 1) << 5); R = (st >> 1) * 16 + swz / 64; C = (st & 1) * 32 + (swz % 64) / 2; }
#define WAIT_V0() asm volatile("s_waitcnt vmcnt(0)" ::: "memory")

DI void gemm_tile(char* smem_generic, const GemmArgs& ga, int m0, int n0, const Seg& sg) {
  extern __shared__ __attribute__((aligned(16))) char shm[];
  (void)smem_generic;
  const int tid = opaque((int)threadIdx.x), lane = tid & 63, wid = tid >> 6;
  const int l16 = lane & 15, g = lane >> 4;
  const int wr = wid >> 2, wc = wid & 3;
  int sR[4], sC[4];
#pragma unroll
  for (int i = 0; i < 4; ++i) g_stage_rc(wid * 1024 + i * 8192 + lane * 16, sR[i], sC[i]);
  const int KT = ga.K >> 6;
#define G_STAGE(buf_, kt_) do { const int k0_ = (kt_) << 6; \
    const bf16_t* Ab_ = (k0_ < ga.ksplit) ? ga.A0 + k0_ : ga.A1 + (k0_ - ga.ksplit); \
    _Pragma("unroll") for (int i = 0; i < 4; ++i) { \
      __builtin_amdgcn_global_load_lds((const unsigned*)(Ab_ + (size_t)(m0 + sR[i]) * ga.lda + sC[i]), (__attribute__((address_space(3))) unsigned*)(shm + (buf_) * G_STAGE_B + wid * 1024 + i * 8192), 16, 0, 0); \
      __builtin_amdgcn_global_load_lds((const unsigned*)(ga.Wt + (size_t)(n0 + sR[i]) * ga.ldw + k0_ + sC[i]), (__attribute__((address_space(3))) unsigned*)(shm + (buf_) * G_STAGE_B + G_TILE_B + wid * 1024 + i * 8192), 16, 0, 0); } } while (0)
  f32x4 acc[8][4];
#pragma unroll
  for (int i = 0; i < 8; ++i)
#pragma unroll
    for (int j = 0; j < 4; ++j) acc[i][j] = (f32x4){0.f, 0.f, 0.f, 0.f};
  float* rs_lds = (float*)(shm + 143360);
  G_STAGE(0, 0);
  if (sg.rs && tid < 256) rs_lds[tid] = rsqrtf(sg.rs[m0 + tid] * (1.0f / 1024.0f) + EPS);
  WAIT_V0(); __syncthreads();
#pragma unroll 1
  for (int t = 0; t < KT; ++t) {
    const int cur = t & 1;
    if (t + 1 < KT) G_STAGE(cur ^ 1, t + 1);
    const char* SAp = shm + cur * G_STAGE_B; const char* SBp = SAp + G_TILE_B;
#pragma unroll
    for (int ks = 0; ks < 2; ++ks) {
      bf16x8 At[8], Bf[4];
#pragma unroll
      for (int m = 0; m < 8; ++m) At[m] = *(const bf16x8*)(SAp + g_lds_byte(wr * 128 + m * 16 + l16, ks * 32 + g * 8));
#pragma unroll
      for (int n = 0; n < 4; ++n) Bf[n] = *(const bf16x8*)(SBp + g_lds_byte(wc * 64 + n * 16 + l16, ks * 32 + g * 8));
#pragma unroll
      for (int m = 0; m < 8; ++m)
#pragma unroll
        for (int n = 0; n < 4; ++n) acc[m][n] = MFMA16(At[m], Bf[n], acc[m][n]);
      __builtin_amdgcn_sched_barrier(0);
    }
    WAIT_V0(); __syncthreads();
  }
  const int rbase = m0 + 128 * wr + 4 * g;
  if (sg.rs) {
#pragma unroll
    for (int m = 0; m < 8; ++m)
#pragma unroll
      for (int r = 0; r < 4; ++r) {
        const float sc = rs_lds[128 * wr + 4 * g + 16 * m + r];
#pragma unroll
        for (int n = 0; n < 4; ++n) acc[m][n][r] *= sc;
      }
  }
  if (sg.type == SEG_NORM) {
    float gn[4];
#pragma unroll
    for (int n = 0; n < 4; ++n) gn[n] = sg.gain[16 * n + l16] * sg.scale;
#pragma unroll
    for (int m = 0; m < 8; ++m) {
#pragma unroll
      for (int r = 0; r < 4; ++r) {
        float ss = 0.f;
#pragma unroll
        for (int n = 0; n < 4; ++n) ss += acc[m][n][r] * acc[m][n][r];
        ss = row16_sum(ss);
        const float sc = rsqrtf(ss * (1.0f / 64.0f) + EPS);
        bf16_t* d = sg.dst + (size_t)(rbase + 16 * m + r) * sg.ld + sg.col + l16;
#pragma unroll
        for (int n = 0; n < 4; ++n) d[16 * n] = f2bf(acc[m][n][r] * sc * gn[n]);
      }
      __builtin_amdgcn_sched_barrier(0);
    }
  } else if (sg.type == SEG_CHM || sg.type == SEG_CHMEM) {
#pragma unroll
    for (int m = 0; m < 8; ++m) {
#pragma unroll
      for (int n = 0; n < 4; ++n) {
        const int row = rbase + 16 * m; const int ch = sg.col + l16 + 16 * n;
        size_t off;
        if (sg.type == SEG_CHM) off = chm_index(sg.CH, row, ch);
        else off = ((size_t)((row >> 8) * 256 + ch) << 8) + (row & 255);
        uint2 v; v.x = pack2(acc[m][n][0], acc[m][n][1]); v.y = pack2(acc[m][n][2], acc[m][n][3]);
        *(uint2*)(sg.dst + off) = v;
      }
      __builtin_amdgcn_sched_barrier(0);
    }
  } else {
    float* Cs = (float*)shm;
    const int rr = tid >> 5, c4 = (tid & 31) * 4;
#pragma unroll 1
    for (int half = 0; half < 2; ++half) {
      if ((wc >> 1) == half) {
#pragma unroll
        for (int m = 0; m < 8; ++m)
#pragma unroll
          for (int n = 0; n < 4; ++n)
#pragma unroll
            for (int r = 0; r < 4; ++r) Cs[(128 * wr + 16 * m + 4 * g + r) * 132 + 64 * (wc & 1) + 16 * n + l16] = acc[m][n][r];
      }
      __syncthreads();
      const int cg = sg.col + 128 * half + c4;
      if (sg.type == SEG_MLP1) {
#pragma unroll 4
        for (int it = 0; it < 16; ++it) {
          const int lr = it * 16 + rr; const int row = m0 + lr;
          f32x4 v = *(const f32x4*)(Cs + lr * 132 + c4);
          v[0] = fmaxf(v[0], 0.f); v[1] = fmaxf(v[1], 0.f); v[2] = fmaxf(v[2], 0.f); v[3] = fmaxf(v[3], 0.f);
          uint2 u; u.x = pack2(v[0] * v[0], v[1] * v[1]); u.y = pack2(v[2] * v[2], v[3] * v[3]);
          *(uint2*)(sg.dst + (size_t)row * sg.ld + cg) = u;
        }
      } else {
#pragma unroll 1
        for (int it0 = 0; it0 < 16; it0 += 8) {
          f32x4 xv[8];
#pragma unroll
          for (int k = 0; k < 8; ++k) {
            const int row = m0 + (it0 + k) * 16 + rr;
            const float* xo;
            if (sg.xin0) xo = (row < T_P) ? sg.xin0 + (size_t)row * DM : sg.xin1 + (size_t)(row - T_P) * DM;
            else xo = sg.xout + (size_t)row * DM;
            xv[k] = *(const f32x4*)(xo + cg);
          }
#pragma unroll
          for (int k = 0; k < 8; ++k) {
            const int lr = (it0 + k) * 16 + rr; const int row = m0 + lr;
            f32x4 v = *(const f32x4*)(Cs + lr * 132 + c4);
            v += xv[k];
            *(f32x4*)(sg.xout + (size_t)row * DM + cg) = v;
            if (sg.xb) { uint2 u; u.x = pack2(v[0], v[1]); u.y = pack2(v[2], v[3]); *(uint2*)(sg.xb + (size_t)row * DM + cg) = u; }
            if (sg.rs_out) {
              float ss = v[0] * v[0] + v[1] * v[1] + v[2] * v[2] + v[3] * v[3];
              ss = row16_sum(ss); ss += __shfl_xor(ss, 16);
              if ((tid & 31) == 0) atomicAdd(sg.rs_out + row, ss);
            }
          }
        }
      }
      __syncthreads();
    }
  }
}

enum { AM_MEM = 0, AM_DIFF = 1, AM_WG = 2, AM_NA = 3 };
constexpr int ATT_LUT_OFS = 2 * (64 + 128) * 144;

template <int VD, int MODE>
DI void attn_core(char* smem, const bf16_t* Q, int ldq, const bf16_t* K, int ldk, const bf16_t* Vt, int ldv,
                  int qpos0, int kbeg, int kend, int nrows, float sink_l2, float (&O)[2][VD / 16][4]) {
  constexpr int NDB = VD / 16;
  constexpr int STAGE = (64 + VD) * 144;
  const int tid = opaque((int)threadIdx.x), lane = tid & 63, wave = tid >> 6;
  const int l16 = lane & 15, g = lane >> 4;
  const float* lut = (const float*)(smem + ATT_LUT_OFS);
  bf16x8 qf[2][2];
#pragma unroll
  for (int qb = 0; qb < 2; ++qb)
#pragma unroll
    for (int kk = 0; kk < 2; ++kk) qf[qb][kk] = *(const bf16x8*)(Q + (size_t)(32 * wave + 16 * qb + l16) * ldq + 32 * kk + 8 * g);
  float m[2] = {-1e30f, -1e30f}, l[2] = {0.f, 0.f};
#pragma unroll
  for (int qb = 0; qb < 2; ++qb)
#pragma unroll
    for (int db = 0; db < NDB; ++db)
#pragma unroll
      for (int r = 0; r < 4; ++r) O[qb][db][r] = 0.f;
  const int wq0 = qpos0 + 32 * wave;
  const int lrow = tid >> 3, lc = tid & 7;
  uint4 rk, rv0, rv1;
  rv1 = make_uint4(0, 0, 0, 0);
#define ATT_GLOAD(k0_) do { \
    rk = *(const uint4*)(K + (size_t)((k0_) + lrow) * ldk + 8 * lc); \
    rv0 = *(const uint4*)(Vt + (size_t)(lrow) * ldv + (k0_) + 8 * lc); \
    if (VD == 128) rv1 = *(const uint4*)(Vt + (size_t)(lrow + 64) * ldv + (k0_) + 8 * lc); } while (0)
#define ATT_SWRITE(buf_) do { \
    char* Ks_ = smem + (buf_) * STAGE; char* Vs_ = Ks_ + 64 * 144; \
    *(uint4*)(Ks_ + lrow * 144 + lc * 16) = rk; \
    *(uint4*)(Vs_ + lrow * 144 + lc * 16) = rv0; \
    if (VD == 128) *(uint4*)(Vs_ + (lrow + 64) * 144 + lc * 16) = rv1; } while (0)
  ATT_GLOAD(kbeg); ATT_SWRITE(0);
  __syncthreads();
  int it = 0;
  for (int k0 = kbeg; k0 < kend; k0 += 64, ++it) {
    const int buf = it & 1;
    const bool more = (k0 + 64 < kend);
    if (more) ATT_GLOAD(k0 + 64);
    const char* Ks = smem + buf * STAGE; const char* Vs = Ks + 64 * 144;
    bool active = true;
    if (MODE == AM_WG) active = !(k0 + 63 < wq0 - 128 || k0 > wq0 + 31 + 128);
    int na_rs = 0; const int qr = wq0 >> 6, kr = k0 >> 6;
    if (MODE == AM_NA) { na_rs = min(max(qr - 4, 0), nrows - 8); active = (kr >= na_rs && kr < na_rs + 8); }
    if (active) {
      f32x4 S[2][4];
#pragma unroll
      for (int kb = 0; kb < 4; ++kb) {
        bf16x8 kf0 = *(const bf16x8*)(Ks + (16 * kb + l16) * 144 + (8 * g) * 2);
        bf16x8 kf1 = *(const bf16x8*)(Ks + (16 * kb + l16) * 144 + (32 + 8 * g) * 2);
#pragma unroll
        for (int qb = 0; qb < 2; ++qb) {
          f32x4 z = (f32x4){0.f, 0.f, 0.f, 0.f};
          z = MFMA16(kf0, qf[qb][0], z);
          S[qb][kb] = MFMA16(kf1, qf[qb][1], z);
        }
      }
#pragma unroll
      for (int qb = 0; qb < 2; ++qb) {
        const int q = wq0 + 16 * qb + l16;
        if (MODE == AM_DIFF || MODE == AM_WG) {
          if (MODE == AM_DIFF && k0 + 63 - wq0 <= -128) {
            const float c = lut[0];
#pragma unroll
            for (int kb = 0; kb < 4; ++kb)
#pragma unroll
              for (int r = 0; r < 4; ++r) S[qb][kb][r] += c;
          } else if (MODE == AM_DIFF && k0 - (wq0 + 31) >= 128) {
            const float c = lut[256];
#pragma unroll
            for (int kb = 0; kb < 4; ++kb)
#pragma unroll
              for (int r = 0; r < 4; ++r) S[qb][kb][r] += c;
          } else {
#pragma unroll
            for (int kb = 0; kb < 4; ++kb)
#pragma unroll
              for (int r = 0; r < 4; ++r) {
                const int rel = k0 + 16 * kb + 4 * g + r - q;
                const int rc = min(max(rel, -128), 128);
                float s = S[qb][kb][r] + lut[rc + 128];
                if (MODE == AM_WG && (rel > 128 || rel < -128)) s = -1e30f;
                S[qb][kb][r] = s;
              }
          }
        } else if (MODE == AM_NA) {
          const int qc = q & 63;
          const int cs = min(max(qc - 8, 0), 48);
          const int dr = kr - qr + 7;
#pragma unroll
          for (int kb = 0; kb < 4; ++kb)
#pragma unroll
            for (int r = 0; r < 4; ++r) {
              const int kc = 16 * kb + 4 * g + r;
              const bool ok = (kc >= cs) && (kc < cs + 16);
              const int dc = min(max(kc - qc + 15, 0), 30);
              float s = S[qb][kb][r] + lut[dr * 31 + dc];
              S[qb][kb][r] = ok ? s : -1e30f;
            }
        }
      }
#pragma unroll
      for (int qb = 0; qb < 2; ++qb) {
        float mx = -1e30f;
#pragma unroll
        for (int kb = 0; kb < 4; ++kb)
#pragma unroll
          for (int r = 0; r < 4; ++r) mx = fmaxf(mx, S[qb][kb][r]);
        mx = fmaxf(mx, __shfl_xor(mx, 16)); mx = fmaxf(mx, __shfl_xor(mx, 32));
        const float mn = fmaxf(m[qb], mx);
        const float alpha = ex2(m[qb] - mn);
        m[qb] = mn;
        float ps = 0.f;
#pragma unroll
        for (int kb = 0; kb < 4; ++kb)
#pragma unroll
          for (int r = 0; r < 4; ++r) { float p = ex2(S[qb][kb][r] - mn); S[qb][kb][r] = p; ps += p; }
        l[qb] = l[qb] * alpha + ps;
#pragma unroll
        for (int db = 0; db < NDB; ++db)
#pragma unroll
          for (int r = 0; r < 4; ++r) O[qb][db][r] *= alpha;
      }
#pragma unroll
      for (int ks = 0; ks < 2; ++ks) {
        bf16x8 pf[2];
#pragma unroll
        for (int qb = 0; qb < 2; ++qb) {
          uint4 u;
          u.x = pack2(S[qb][2 * ks][0], S[qb][2 * ks][1]); u.y = pack2(S[qb][2 * ks][2], S[qb][2 * ks][3]);
          u.z = pack2(S[qb][2 * ks + 1][0], S[qb][2 * ks + 1][1]); u.w = pack2(S[qb][2 * ks + 1][2], S[qb][2 * ks + 1][3]);
          pf[qb] = __builtin_bit_cast(bf16x8, u);
        }
#pragma unroll
        for (int db = 0; db < NDB; ++db) {
          const char* vrow = Vs + (16 * db + l16) * 144 + (32 * ks + 4 * g) * 2;
          uint2 v0 = *(const uint2*)(vrow);
          uint2 v1 = *(const uint2*)(vrow + 32);
          uint4 u; u.x = v0.x; u.y = v0.y; u.z = v1.x; u.w = v1.y;
          bf16x8 vf = __builtin_bit_cast(bf16x8, u);
#pragma unroll
          for (int qb = 0; qb < 2; ++qb) {
            f32x4 o = (f32x4){O[qb][db][0], O[qb][db][1], O[qb][db][2], O[qb][db][3]};
            o = MFMA16(vf, pf[qb], o);
            O[qb][db][0] = o[0]; O[qb][db][1] = o[1]; O[qb][db][2] = o[2]; O[qb][db][3] = o[3];
          }
        }
      }
    }
    if (more) ATT_SWRITE(buf ^ 1);
    __syncthreads();
  }
#pragma unroll
  for (int qb = 0; qb < 2; ++qb) {
    float lt = l[qb];
    lt += __shfl_xor(lt, 16); lt += __shfl_xor(lt, 32);
    if (MODE == AM_WG) lt += ex2(sink_l2 - m[qb]);
    const float inv = 1.0f / lt;
#pragma unroll
    for (int db = 0; db < NDB; ++db)
#pragma unroll
      for (int r = 0; r < 4; ++r) O[qb][db][r] *= inv;
  }
}

template <int NDB>
DI void attn_store(bf16_t* dst, int ld, const float (&O)[2][NDB][4]) {
  const int lane = threadIdx.x & 63, wave = threadIdx.x >> 6, l16 = lane & 15, g = lane >> 4;
#pragma unroll
  for (int qb = 0; qb < 2; ++qb)
#pragma unroll
    for (int db = 0; db < NDB; ++db) {
      uint2 v; v.x = pack2(O[qb][db][0], O[qb][db][1]); v.y = pack2(O[qb][db][2], O[qb][db][3]);
      *(uint2*)(dst + (size_t)(32 * wave + 16 * qb + l16) * ld + 16 * db + 4 * g) = v;
    }
}

DI void seq_of_row(int row0, int& L, int& seq_row0, int& b_glob) {
  if (row0 < T_P) { L = LP; int b = row0 >> 14; seq_row0 = b << 14; b_glob = b; }
  else { L = LS; int b = (row0 - T_P) >> 11; seq_row0 = T_P + (b << 11); b_glob = 2 + b; }
}

DI void diff_item(char* smem, const Params& p, int item, bool dry = false) {
  bf16_t* QA = (bf16_t*)(p.ws + WS_R0);
  const bf16_t* KA = (const bf16_t*)((const char*)p.out + 192 * MiB);
  const bf16_t* VAt = (const bf16_t*)(p.ws + WS_R2);
  const float* misc_lut = (const float*)(p.ws + WS_MISC + MS_LUT);
  const float lam = *(const float*)(p.ws + WS_MISC + MS_LAM);
  int h, row0;
  if (item < 512) { h = item & 3; row0 = (item >> 2) * 256; }
  else { int i2 = item - 512; h = i2 & 3; row0 = T_P + (i2 >> 2) * 256; }
  int L, srow0, bg; seq_of_row(row0, L, srow0, bg);
  const int qpos0 = row0 - srow0;
  const bf16_t* Vt = VAt + chm_index(512, srow0, h * 128);
  float O[2][8][4];
  unsigned* o0s = (unsigned*)(smem + 57344) + threadIdx.x;
  const int tid = threadIdx.x;
#pragma unroll 1
  for (int mp = 0; mp < 2; ++mp) {
    __syncthreads();
    for (int i = tid; i < 257; i += NTHR) ((float*)(smem + ATT_LUT_OFS))[i] = misc_lut[(h * 2 + mp) * 257 + i];
    __syncthreads();
    attn_core<128, AM_DIFF>(smem, QA + (size_t)row0 * 512 + h * 128 + mp * 64, 512, KA + (size_t)srow0 * 512 + h * 128 + mp * 64, 512,
                            Vt, L, qpos0, 0, L, 0, 0.f, O);
    if (mp == 0) {
#pragma unroll
      for (int qb = 0; qb < 2; ++qb)
#pragma unroll
        for (int db = 0; db < 8; ++db) { o0s[((qb * 8 + db) * 2) * NTHR] = pack2(O[qb][db][0], O[qb][db][1]); o0s[((qb * 8 + db) * 2 + 1) * NTHR] = pack2(O[qb][db][2], O[qb][db][3]); }
    }
  }
  const int lane = tid & 63, l16 = lane & 15, g = lane >> 4;
  const float* sg = p.in[13];
#pragma unroll
  for (int qb = 0; qb < 2; ++qb) {
    float ss = 0.f;
#pragma unroll
    for (int db = 0; db < 8; ++db) {
      const unsigned w0 = o0s[((qb * 8 + db) * 2) * NTHR], w1 = o0s[((qb * 8 + db) * 2 + 1) * NTHR];
      float a0 = bf2f((unsigned short)(w0 & 0xffff)), a1 = bf2f((unsigned short)(w0 >> 16));
      float a2 = bf2f((unsigned short)(w1 & 0xffff)), a3 = bf2f((unsigned short)(w1 >> 16));
      O[qb][db][0] = a0 - lam * O[qb][db][0]; O[qb][db][1] = a1 - lam * O[qb][db][1];
      O[qb][db][2] = a2 - lam * O[qb][db][2]; O[qb][db][3] = a3 - lam * O[qb][db][3];
#pragma unroll
      for (int r = 0; r < 4; ++r) ss += O[qb][db][r] * O[qb][db][r];
    }
    ss += __shfl_xor(ss, 16); ss += __shfl_xor(ss, 32);
    const float sc = rsqrtf(ss * (1.0f / 128.0f) + EPS) * 0.8f;
#pragma unroll
    for (int db = 0; db < 8; ++db)
#pragma unroll
      for (int r = 0; r < 4; ++r) O[qb][db][r] *= sc * sg[16 * db + 4 * g + r];
  }
  if (dry) attn_store<8>((bf16_t*)(p.ws + WS_R3), 512, O); else attn_store<8>(QA + (size_t)row0 * 512 + h * 128, 512, O);
}

DI void wg_item(char* smem, const Params& p, int item, bool dry = false) {
  bf16_t* QD = (bf16_t*)(p.ws + WS_R3);
  const bf16_t* KD = (const bf16_t*)(p.ws + WS_KD);
  const bf16_t* VDt = (const bf16_t*)(p.ws + WS_VDT);
  const float* misc_lut = (const float*)(p.ws + WS_MISC + MS_LUT);
  const int hq = item & 7; const int row0 = (item >> 3) * 256;
  int L, srow0, bg; seq_of_row(row0, L, srow0, bg);
  const int qpos0 = row0 - srow0;
  const int kvh = hq >> 2;
  __syncthreads();
  for (int i = threadIdx.x; i < 257; i += NTHR) ((float*)(smem + ATT_LUT_OFS))[i] = misc_lut[hq * 257 + i];
  __syncthreads();
  float O[2][4][4];
  const int kbeg = max(0, qpos0 - 128), kend = min(L, qpos0 + 256 + 128);
  attn_core<64, AM_WG>(smem, QD + (size_t)row0 * 512 + hq * 64, 512, KD + (size_t)srow0 * 128 + kvh * 64, 128,
                       VDt + chm_index(128, srow0, kvh * 64), L, qpos0, kbeg, kend, 0, p.in[30][hq] * LOG2E, O);
  if (dry) attn_store<4>((bf16_t*)(p.ws + 484 * MiB), 512, O); else attn_store<4>(QD + (size_t)row0 * 512 + hq * 64, 512, O);
}

DI void na_item(char* smem, const Params& p, int item, bool dry = false) {
  bf16_t* QC = (bf16_t*)(p.ws + WS_R0);
  const bf16_t* KC = (const bf16_t*)(p.ws + WS_R1);
  const bf16_t* VCt = (const bf16_t*)(p.ws + WS_R2);
  const int h = item & 7; const int row0 = (item >> 3) * 256;
  int L, srow0, bg; seq_of_row(row0, L, srow0, bg);
  const int qpos0 = row0 - srow0;
  const int nrows = L >> 6;
  __syncthreads();
  for (int i = threadIdx.x; i < 465; i += NTHR) ((float*)(smem + ATT_LUT_OFS))[i] = p.in[27][h * 465 + i] * LOG2E;
  __syncthreads();
  const int qr0 = qpos0 >> 6;
  const int rs0 = min(max(qr0 - 4, 0), nrows - 8), rs3 = min(max(qr0 + 3 - 4, 0), nrows - 8);
  float O[2][4][4];
  attn_core<64, AM_NA>(smem, QC + (size_t)row0 * 512 + h * 64, 512, KC + (size_t)srow0 * 512 + h * 64, 512,
                       VCt + chm_index(512, srow0, h * 64), L, qpos0, rs0 * 64, (rs3 + 8) * 64, nrows, 0.f, O);
  if (dry) attn_store<4>((bf16_t*)(p.ws + 484 * MiB), 512, O); else attn_store<4>(QC + (size_t)row0 * 512 + h * 64, 512, O);
}

DI void mem_attn_tile(char* smem, const Params& p, int layer, int row0) {
  bf16_t* QM = (bf16_t*)(p.ws + WS_QM);
  const bf16_t* MK = (const bf16_t*)(p.ws + WS_MISC + MS_MK) + (size_t)layer * 18 * 256 * 256;
  const bf16_t* MVt = (const bf16_t*)(p.ws + WS_MISC + MS_MVT) + (size_t)layer * 18 * 256 * 256;
  int L, srow0, bg; seq_of_row(row0, L, srow0, bg);
#pragma unroll 1
  for (int h = 0; h < 4; ++h) {
    float O[2][4][4];
    attn_core<64, AM_MEM>(smem, QM + (size_t)row0 * 256 + h * 64, 256, MK + (size_t)bg * 256 * 256 + h * 64, 256,
                          MVt + ((size_t)(bg * 256 + h * 64) << 8), 256, 0, 0, 256, 0, 0.f, O);
    attn_store<4>(QM + (size_t)row0 * 256 + h * 64, 256, O);
  }
}

DI int PADI(int i) { return i + (i >> 5); }
DI float2 cmul(float2 a, float2 b) { return make_float2(a.x * b.x - a.y * b.y, a.x * b.y + a.y * b.x); }
DI float2 cmulc(float2 a, float2 b) { return make_float2(a.x * b.x + a.y * b.y, a.y * b.x - a.x * b.y); }
DI constexpr float C16(int m) { return m == 0 ? 1.f : m == 1 ? 0.92387953251128674f : m == 2 ? 0.70710678118654752f : m == 3 ? 0.38268343236508977f : m == 4 ? 0.f : m == 5 ? -0.38268343236508977f : m == 6 ? -0.70710678118654752f : -0.92387953251128674f; }
DI constexpr float S16(int m) { return m == 0 ? 0.f : m == 1 ? 0.38268343236508977f : m == 2 ? 0.70710678118654752f : m == 3 ? 0.92387953251128674f : m == 4 ? 1.f : m == 5 ? 0.92387953251128674f : m == 6 ? 0.70710678118654752f : 0.38268343236508977f; }

template <int LOGR, int LOGS, bool INV>
DI void fft_pass(float2* buf, int total) {
  constexpr int R = 1 << LOGR;
  constexpr int S = 1 << LOGS;
  const int tid0 = opaque((int)threadIdx.x);
#pragma unroll 1
  for (int u = tid0; u < (total >> LOGR); u += NTHR) {
    const int j = u & (S - 1);
    const int base = ((u >> LOGS) << (LOGS + LOGR)) + j;
    float2* bp = buf + PADI(base);
    float2 x[R];
#pragma unroll
    for (int k = 0; k < R; ++k) x[k] = bp[k * S + ((k * S) >> 5)];
    float2 pw[LOGR];
    {
      const float rev = -(float)j * (1.0f / (float)(R * S));
      pw[0] = make_float2(cos_rev(rev), sin_rev(rev));
#pragma unroll
      for (int i = 1; i < LOGR; ++i) pw[i] = cmul(pw[i - 1], pw[i - 1]);
    }
    if (!INV) {
#pragma unroll
      for (int i = 0; i < LOGR; ++i) {
        const int h = R >> (i + 1);
#pragma unroll
        for (int k = 0; k < R; ++k) {
          if ((k & h) == 0) {
            const int mm = (k & (h - 1)) * 8 / h;
            float2 a = x[k], b = x[k + h];
            x[k] = make_float2(a.x + b.x, a.y + b.y);
            float2 d = make_float2(a.x - b.x, a.y - b.y);
            if (mm != 0) d = cmul(d, make_float2(C16(mm), -S16(mm)));
            x[k + h] = cmul(d, pw[i]);
          }
        }
      }
    } else {
#pragma unroll
      for (int i = LOGR - 1; i >= 0; --i) {
        const int h = R >> (i + 1);
#pragma unroll
        for (int k = 0; k < R; ++k) {
          if ((k & h) == 0) {
            const int mm = (k & (h - 1)) * 8 / h;
            float2 a = x[k];
            float2 d = cmulc(x[k + h], pw[i]);
            if (mm != 0) d = cmulc(d, make_float2(C16(mm), -S16(mm)));
            x[k] = make_float2(a.x + d.x, a.y + d.y);
            x[k + h] = make_float2(a.x - d.x, a.y - d.y);
          }
        }
      }
    }
#pragma unroll
    for (int k = 0; k < R; ++k) bp[k * S + ((k * S) >> 5)] = x[k];
  }
  __syncthreads();
}

template <int LOGN>
DI void fft_fwd(float2* buf, int total) {
  if (LOGN == 14) { fft_pass<4, 10, false>(buf, total); fft_pass<4, 6, false>(buf, total); fft_pass<4, 2, false>(buf, total); fft_pass<2, 0, false>(buf, total); }
  else { fft_pass<4, 7, false>(buf, total); fft_pass<4, 3, false>(buf, total); fft_pass<3, 0, false>(buf, total); }
}
template <int LOGN>
DI void fft_inv(float2* buf, int total) {
  if (LOGN == 14) { fft_pass<2, 0, true>(buf, total); fft_pass<4, 2, true>(buf, total); fft_pass<4, 6, true>(buf, total); fft_pass<4, 10, true>(buf, total); }
  else { fft_pass<3, 0, true>(buf, total); fft_pass<4, 3, true>(buf, total); fft_pass<4, 7, true>(buf, total); }
}

template <int LOGN, int NB, int NSUB>
DI void hyena_item(char* smem, const Params& p, int c, int row_base  ) {
  constexpr int L = 1 << LOGN;
  constexpr int SPT = L / NTHR;
  constexpr int EPT = NB * L / NTHR;
  const int tid = opaque((int)threadIdx.x);
  float2* buf = (float2*)smem;
  float* sm_w3 = (float*)(smem + 135168);
  float* sm_red = sm_w3 + 128;
  char* scr = p.ws + WS_XB + (size_t)blockIdx.x * HY_SCR_PER_BLOCK;
  float* scrF = (float*)scr;
  float* scrB = scrF + L;
  float2* scrY = (float2*)(scr + 128 * 1024);
  float2* scrZ = (float2*)(scr + 256 * 1024);
  float2* scrS = (float2*)(scr + 384 * 1024);
  const bf16_t* UH = (const bf16_t*)p.out;
  bf16_t* OBt = (bf16_t*)(p.ws + WS_R3);
  const float* h2 = (const float*)(p.ws + WS_MISC + (LOGN == 14 ? MS_H2P : MS_H2S));
  const float* w3 = p.in[21];
  const float* cw = p.in[14]; const float* cb = p.in[15]; const float* skp = p.in[22];
  const float delta = fabsf(-3.0701134573253945f + (float)c * ((-15.350567286626973f + 3.0701134573253945f) / 511.0f));
  const float invLm1 = 1.0f / (float)(L - 1);

  float wv[3][4];
#pragma unroll
  for (int q = 0; q < 3; ++q) { const int ch = q * 512 + c; wv[q][0] = cw[ch]; wv[q][1] = cw[1536 + ch]; wv[q][2] = cw[2 * 1536 + ch]; wv[q][3] = cb[ch]; }
  auto loadu3 = [&](int b, int ch, int n, float (&r)[3]) {
    const bf16_t* u = UH + chm_index(1536, row_base + b * L, ch) + n;
    r[1] = bf2f(u[0]);
    r[0] = (n > 0) ? bf2f(u[-1]) : 0.f;
    r[2] = (n < L - 1) ? bf2f(u[1]) : 0.f;
  };
  auto convw = [&](int q, const float (&r)[3]) -> float { return r[0] * wv[q][0] + r[1] * wv[q][1] + r[2] * wv[q][2] + wv[q][3]; };

#pragma unroll 1
  for (int o = 0; o < 2; ++o) {
    __syncthreads();
    if (tid < 128) sm_w3[tid] = w3[(size_t)(tid & 63) * 2048 + (o * 2 + (tid >> 6)) * 512 + c];
    __syncthreads();
    float asum = 0.f;
#pragma unroll 1
    for (int rep = 0; rep < ((PROBE & 64) ? 2 : 1); ++rep) {
      asum = 0.f;
      constexpr int CHK = SPT < 16 ? SPT : 16;
#pragma unroll 1
      for (int i0 = 0; i0 < SPT; i0 += CHK) {
        float facc[CHK], bacc[CHK];
#pragma unroll
        for (int i = 0; i < CHK; ++i) { facc[i] = 0.f; bacc[i] = 0.f; }
#pragma unroll 1
        for (int j = 0; j < 64; ++j) {
          const float wf = sm_w3[j], wb = sm_w3[64 + j];
          const float* hp = h2 + (size_t)j * L + tid + NTHR * i0;
#pragma unroll
          for (int i = 0; i < CHK; ++i) { const float hv = hp[NTHR * i]; facc[i] += hv * wf; bacc[i] += hv * wb; }
        }
#pragma unroll
        for (int i = 0; i < CHK; ++i) {
          const int t = tid + NTHR * (i0 + i);
          const float dec = ex2(-(float)t * invLm1 * delta * LOG2E);
          const float f = facc[i] * dec, bk = bacc[i] * dec;
          scrF[t] = f; scrB[t] = bk;
          asum += fabsf(f) + (t >= 1 ? fabsf(bk) : 0.f);
        }
      }
    }
#pragma unroll
    for (int s = 32; s >= 1; s >>= 1) asum += __shfl_xor(asum, s);
    if ((tid & 63) == 0) sm_red[tid >> 6] = asum;
    block_sync_global();
    float nrm = 0.f;
#pragma unroll
    for (int w = 0; w < 8; ++w) nrm += sm_red[w];
    const float inv_nrm = 1.0f / nrm;
    const float sk = skp[o * 512 + c];

#pragma unroll 1
    for (int par = 0; par < 2; ++par) {
#pragma unroll 8
      for (int i = 0; i < SPT; ++i) {
        const int n = tid + NTHR * i;
        const float f = scrF[n];
        const float br = (n == 0) ? 0.f : scrB[L - n];
        float2 v;
        if (par == 0) v = make_float2((f + br) * inv_nrm, 0.f);
        else { const float gm = (f - br) * inv_nrm; const float rev = -(float)n / (float)(2 * L); v = make_float2(gm * cos_rev(rev), gm * sin_rev(rev)); }
        buf[PADI(n)] = v;
      }
      __syncthreads();
      fft_fwd<LOGN>(buf, L);
#pragma unroll 8
      for (int i = 0; i < SPT; ++i) scrS[tid + NTHR * i] = buf[PADI(tid + NTHR * i)];
      __syncthreads();
#pragma unroll 1
      for (int sub = 0; sub < NSUB; ++sub) {
        constexpr int BT = 4;
#pragma unroll 1
        for (int i0 = 0; i0 < EPT; i0 += BT) {
          float2 zz[BT];
          if (o == 0 && par == 0) {
            float ra[BT][3], rb[BT][3];
#pragma unroll
            for (int k = 0; k < BT; ++k) {
              const int e = tid + NTHR * (i0 + k); const int f = e >> LOGN, n = e & (L - 1); const int pp = sub * NB + f;
              loadu3(2 * pp, c, n, ra[k]); loadu3(2 * pp + 1, c, n, rb[k]);
            }
#pragma unroll
            for (int k = 0; k < BT; ++k) {
              const int e = tid + NTHR * (i0 + k); const int f = e >> LOGN, n = e & (L - 1); const int pp = sub * NB + f;
              zz[k] = make_float2(convw(0, ra[k]), convw(0, rb[k]));
              scrZ[(size_t)pp * L + n] = zz[k];
            }
          } else {
#pragma unroll
            for (int k = 0; k < BT; ++k) {
              const int e = tid + NTHR * (i0 + k); const int f = e >> LOGN, n = e & (L - 1); const int pp = sub * NB + f;
              zz[k] = scrZ[(size_t)pp * L + n];
            }
          }
#pragma unroll
          for (int k = 0; k < BT; ++k) {
            const int e = tid + NTHR * (i0 + k); const int n = e & (L - 1);
            float2 z = zz[k];
            if (par == 1) { const float rev = -(float)n / (float)(2 * L); z = cmul(z, make_float2(cos_rev(rev), sin_rev(rev))); }
            buf[PADI(e)] = z;
          }
        }
        __syncthreads();
        if (PROBE & 32) {
          fft_fwd<LOGN>(buf, NB * L); fft_inv<LOGN>(buf, NB * L);
          _Pragma("unroll 1") for (int i = 0; i < EPT; ++i) { const int e = tid + NTHR * i; float2 v = buf[PADI(e)]; buf[PADI(e)] = make_float2(v.x * (1.0f / L), v.y * (1.0f / L)); }
          __syncthreads();
        }
        fft_fwd<LOGN>(buf, NB * L);
#pragma unroll 1
        for (int i0 = 0; i0 < EPT; i0 += BT) {
          float2 ss[BT];
#pragma unroll
          for (int k = 0; k < BT; ++k) ss[k] = scrS[(tid + NTHR * (i0 + k)) & (L - 1)];
#pragma unroll
          for (int k = 0; k < BT; ++k) { const int e = tid + NTHR * (i0 + k); buf[PADI(e)] = cmul(buf[PADI(e)], ss[k]); }
        }
        __syncthreads();
        fft_inv<LOGN>(buf, NB * L);
        if (par == 0) {
#pragma unroll 8
          for (int i = 0; i < EPT; ++i) {
            const int e = tid + NTHR * i; const int f = e >> LOGN, n = e & (L - 1);
            scrY[(size_t)(sub * NB + f) * L + n] = buf[PADI(e)];
          }
        } else {
          const int gsel = (o == 0 ? 1 : 2);
#pragma unroll 1
          for (int i0 = 0; i0 < EPT; i0 += BT) {
            float2 ye[BT], zz[BT]; float ga[BT][3], gb[BT][3];
#pragma unroll
            for (int k = 0; k < BT; ++k) {
              const int e = tid + NTHR * (i0 + k); const int f = e >> LOGN, n = e & (L - 1); const int pp = sub * NB + f;
              ye[k] = scrY[(size_t)pp * L + n]; zz[k] = scrZ[(size_t)pp * L + n];
              loadu3(2 * pp, gsel * 512 + c, n, ga[k]); loadu3(2 * pp + 1, gsel * 512 + c, n, gb[k]);
            }
#pragma unroll
            for (int k = 0; k < BT; ++k) {
              const int e = tid + NTHR * (i0 + k); const int f = e >> LOGN, n = e & (L - 1); const int pp = sub * NB + f;
              float2 y = buf[PADI(e)];
              const float rev = -(float)n / (float)(2 * L);
              y = cmulc(y, make_float2(cos_rev(rev), sin_rev(rev)));
              const float sc = 0.5f / (float)L;
              const float c0 = (ye[k].x + y.x) * sc + sk * zz[k].x;
              const float c1 = (ye[k].y + y.y) * sc + sk * zz[k].y;
              const float z0 = convw(gsel, ga[k]) * c0;
              const float z1 = convw(gsel, gb[k]) * c1;
              if (o == 0) scrZ[(size_t)pp * L + n] = make_float2(z0, z1);
              else {
                OBt[chm_index(512, row_base + (2 * pp) * L, c) + n] = f2bf(z0);
                OBt[chm_index(512, row_base + (2 * pp + 1) * L, c) + n] = f2bf(z1);
              }
            }
          }
        }
        __syncthreads();
      }
    }
  }
}

struct WMat { const float* src; int K; int N; const float* gain; bf16_t* dst; };
DI WMat get_wmat(const Params& p, int id) {
  bf16_t* W = (bf16_t*)(p.ws + WS_W);
  WMat m;
  switch (id) {
    case 0: m = {p.in[9], 1024, 3072, p.in[5], W + W_INE}; break;
    case 1: m = {p.in[23], 1024, 1024, nullptr, W + W_OUTE}; break;
    case 2: m = {p.in[24], 1024, 2304, p.in[5] + 1024, W + W_INO}; break;
    case 3: m = {p.in[31], 1024, 1024, nullptr, W + W_OUTO}; break;
    case 4: m = {p.in[32], 1024, 256, p.in[6], W + W_Q}; break;
    case 5: m = {p.in[32] + 1024 * 256, 1024, 256, p.in[6] + 1024, W + W_Q + 256 * 1024}; break;
    case 6: m = {p.in[33], 1024, 512, p.in[7], W + W_KV}; break;
    case 7: m = {p.in[33] + 1024 * 512, 1024, 512, p.in[7] + 1024, W + W_KV + 512 * 1024}; break;
    case 8: m = {p.in[34], 256, 1024, nullptr, W + W_O}; break;
    case 9: m = {p.in[34] + 256 * 1024, 256, 1024, nullptr, W + W_O + 1024 * 256}; break;
    case 10: m = {p.in[37], 1024, 4096, p.in[8], W + W_1}; break;
    case 11: m = {p.in[37] + (size_t)1024 * 4096, 1024, 4096, p.in[8] + 1024, W + W_1 + (size_t)4096 * 1024}; break;
    case 12: m = {p.in[38], 4096, 1024, nullptr, W + W_2}; break;
    default: m = {p.in[38] + (size_t)4096 * 1024, 4096, 1024, nullptr, W + W_2 + (size_t)4096 * 1024}; break;
  }
  return m;
}

DI void prep_wtile(char* smem, const WMat& m, int tile) {
  float* t = (float*)smem;
  const int ntn = m.N >> 6;
  const int k0 = (tile / ntn) << 6, n0 = (tile % ntn) << 6;
  const int tid = threadIdx.x;
  __syncthreads();
  {
    const int kk = tid >> 4, n4 = (tid & 15) * 4;
#pragma unroll
    for (int i = 0; i < 2; ++i) {
      const int k = kk + 32 * i;
      float4 v = *(const float4*)(m.src + (size_t)(k0 + k) * m.N + n0 + n4);
      const float gk = m.gain ? m.gain[k0 + k] : 1.0f;
      t[k * 65 + n4] = v.x * gk; t[k * 65 + n4 + 1] = v.y * gk; t[k * 65 + n4 + 2] = v.z * gk; t[k * 65 + n4 + 3] = v.w * gk;
    }
  }
  __syncthreads();
  {
    const int n = tid >> 3, kc = tid & 7;
    uint4 u;
    u.x = pack2(t[(8 * kc) * 65 + n], t[(8 * kc + 1) * 65 + n]); u.y = pack2(t[(8 * kc + 2) * 65 + n], t[(8 * kc + 3) * 65 + n]);
    u.z = pack2(t[(8 * kc + 4) * 65 + n], t[(8 * kc + 5) * 65 + n]); u.w = pack2(t[(8 * kc + 6) * 65 + n], t[(8 * kc + 7) * 65 + n]);
    *(uint4*)(m.dst + (size_t)(n0 + n) * m.K + k0 + 8 * kc) = u;
  }
}

DI void prep_row(const float* src, bf16_t* dst, float* ssq) {
  const int lane = threadIdx.x & 63;
  float ss = 0.f;
#pragma unroll
  for (int i = 0; i < 4; ++i) {
    float4 v = *(const float4*)(src + (i * 64 + lane) * 4);
    ss += v.x * v.x + v.y * v.y + v.z * v.z + v.w * v.w;
    uint2 u; u.x = pack2(v.x, v.y); u.y = pack2(v.z, v.w);
    *(uint2*)(dst + (i * 64 + lane) * 4) = u;
  }
#pragma unroll
  for (int s = 32; s >= 1; s >>= 1) ss += __shfl_xor(ss, s);
  if (lane == 0) *ssq = ss;
}

DI void prep_h2(const Params& p, int L, int t, float* dst) {
  const int j = threadIdx.x & 63;
  const float* w1 = p.in[16]; const float* b1 = p.in[17]; const float* fr = p.in[18]; const float* w2 = p.in[19]; const float* b2 = p.in[20];
  const float t01 = (float)t / (float)(L - 1);
  const float tl = (float)t / (float)L;
  float a = t01 * w1[j] + b1[j];
#pragma unroll
  for (int k = 0; k < 8; ++k) {
    const float fk = 1e-4f + (float)k * ((7.0f - 1e-4f) / 7.0f);
    const float rev = tl * fk;
    a += cos_rev(rev) * w1[(1 + k) * 64 + j] - sin_rev(rev) * w1[(9 + k) * 64 + j];
  }
  const float h1 = sin_rev(fr[j] * a * 0.15915494309189535f);
  float a2 = b2[j];
  for (int i = 0; i < 64; ++i) a2 += __shfl(h1, i) * w2[i * 64 + j];
  dst[(size_t)j * L + t] = sin_rev(fr[64 + j] * a2 * 0.15915494309189535f);
}

constexpr int PREP_NW = 768 + 256 + 576 + 256 + 64 + 64 + 128 + 128 + 64 + 64 + 1024 + 1024 + 1024 + 1024;
constexpr int PREP_T_ROWS = PREP_NW;
constexpr int PREP_T_MEM = PREP_T_ROWS + 8192;
constexpr int PREP_T_H2 = PREP_T_MEM + 576;
constexpr int PREP_T_MISC = PREP_T_H2 + 2304;
constexpr int PREP_TOTAL = PREP_T_MISC + 1;

DI void phase_prep(char* smem, const Params& p) {
  const int tid = threadIdx.x, wave = tid >> 6;
#pragma unroll 1
  for (int task = blockIdx.x; task < PREP_TOTAL; task += gridDim.x) {
    if (task < PREP_NW) {
      int t = task, id = 0;
      for (; id < 14; ++id) { WMat m = get_wmat(p, id); int n = (m.K >> 6) * (m.N >> 6); if (t < n) break; t -= n; }
      WMat m = get_wmat(p, id);
      prep_wtile(smem, m, t);
    } else if (task < PREP_T_MEM) {
      const int row = (task - PREP_T_ROWS) * 8 + wave;
      const float* src = (row < T_P) ? p.in[0] + (size_t)row * DM : p.in[1] + (size_t)(row - T_P) * DM;
      float* RS = (float*)(p.ws + WS_MISC + MS_RS);
      prep_row(src, (bf16_t*)(p.ws + WS_XB) + (size_t)row * DM, RS + row);
      if ((tid & 63) < 5) RS[(size_t)(1 + (tid & 63)) * T_ALL + row] = 0.f;
    } else if (task < PREP_T_H2) {
      const int row = (task - PREP_T_MEM) * 8 + wave;
      const float* src = (row < 512) ? p.in[2] + (size_t)row * DM : p.in[3] + (size_t)(row - 512) * DM;
      prep_row(src, (bf16_t*)(p.ws + WS_R1) + (size_t)row * DM, (float*)(p.ws + WS_MISC + MS_RSM) + row);
    } else if (task < PREP_T_MISC) {
      const int t = (task - PREP_T_H2) * 8 + wave;
      if (t < LP) prep_h2(p, LP, t, (float*)(p.ws + WS_MISC + MS_H2P));
      else prep_h2(p, LS, t - LP, (float*)(p.ws + WS_MISC + MS_H2S));
    } else {
      float* lut = (float*)(p.ws + WS_MISC + MS_LUT);
      for (int i = tid; i < 8 * 257; i += NTHR) {
        const int hh = i / 257, rel = (i % 257) - 128;
        const int n = rel < 0 ? -rel : rel;
        int bkt;
        if (n < 8) bkt = n; else { bkt = 2 + (31 - __clz(n * n)); if (bkt > 15) bkt = 15; }
        if (rel > 0) bkt += 16;
        lut[i] = p.in[4][bkt * 8 + hh] * LOG2E;
      }
      if (tid < 64) {
        const float* lf = p.in[12];
        float a = lf[tid] * lf[64 + tid], b = lf[128 + tid] * lf[192 + tid];
#pragma unroll
        for (int s = 32; s >= 1; s >>= 1) { a += __shfl_xor(a, s); b += __shfl_xor(b, s); }
        if (tid == 0) *(float*)(p.ws + WS_MISC + MS_LAM) = expf(a) - expf(b) + 0.2f;
      }
    }
  }
}

DI Seg seg_inproj(const Params& p, int layer, int col0, const float* rs) {
  Seg s{}; s.rs = rs; s.scale = 1.0f;
  if (layer == 0) {
    if (col0 < 512) { s.type = SEG_NORM; s.dst = (bf16_t*)(p.ws + WS_R0); s.ld = 512; s.col = col0; s.gain = p.in[10]; s.scale = QSCALE; }
    else if (col0 < 1024) { s.type = SEG_NORM; s.dst = (bf16_t*)((char*)p.out + 192 * MiB); s.ld = 512; s.col = col0 - 512; s.gain = p.in[11]; }
    else if (col0 < 1536) { s.type = SEG_CHM; s.dst = (bf16_t*)(p.ws + WS_R2); s.CH = 512; s.col = col0 - 1024; }
    else { s.type = SEG_CHM; s.dst = (bf16_t*)p.out; s.CH = 1536; s.col = col0 - 1536; }
  } else {
    if (col0 < 512) { s.type = SEG_NORM; s.dst = (bf16_t*)(p.ws + WS_R0); s.ld = 512; s.col = col0; s.gain = p.in[25]; s.scale = QSCALE; }
    else if (col0 < 1024) { s.type = SEG_NORM; s.dst = (bf16_t*)(p.ws + WS_R1); s.ld = 512; s.col = col0 - 512; s.gain = p.in[26]; }
    else if (col0 < 1536) { s.type = SEG_CHM; s.dst = (bf16_t*)(p.ws + WS_R2); s.CH = 512; s.col = col0 - 1024; }
    else if (col0 < 2048) { s.type = SEG_NORM; s.dst = (bf16_t*)(p.ws + WS_R3); s.ld = 512; s.col = col0 - 1536; s.gain = p.in[28]; s.scale = QSCALE; }
    else if (col0 < 2176) { s.type = SEG_NORM; s.dst = (bf16_t*)(p.ws + WS_KD); s.ld = 128; s.col = col0 - 2048; s.gain = p.in[29]; }
    else { s.type = SEG_CHM; s.dst = (bf16_t*)(p.ws + WS_VDT); s.CH = 128; s.col = col0 - 2176; }
  }
  return s;
}

DI void phase_inproj(char* smem, const Params& p, int layer) {
  const int NTn = layer == 0 ? 12 : 9;
  const int n_main = 256 * NTn;
  const int n_total = n_main + (layer == 0 ? 72 : 0);
  const bf16_t* W = (const bf16_t*)(p.ws + WS_W);
  const int wc = (threadIdx.x >> 6) & 3;
#pragma unroll 1
  for (int tile = blockIdx.x; tile < n_total; tile += gridDim.x) {
    if (tile < n_main) {
      const int mt = tile / NTn, nt = tile % NTn;
      GemmArgs ga{(const bf16_t*)(p.ws + WS_XB), nullptr, 1 << 30, DM, W + (layer == 0 ? W_INE : W_INO), DM, DM};
      Seg s = seg_inproj(p, layer, nt * 256 + 64 * wc, (const float*)(p.ws + WS_MISC + MS_RS) + (size_t)(layer * 3) * T_ALL);
      gemm_tile(smem, ga, mt * 256, nt * 256, s);
    } else {
      const int t2 = tile - n_main; const int l = t2 / 36, r = t2 % 36; const int mt = r >> 1, nt = r & 1;
      GemmArgs ga{(const bf16_t*)(p.ws + WS_R1), nullptr, 1 << 30, DM, W + W_KV + (size_t)l * 512 * 1024, DM, DM};
      Seg s{}; s.rs = (const float*)(p.ws + WS_MISC + MS_RSM); s.scale = 1.0f;
      const int col0 = nt * 256 + 64 * wc;
      if (col0 < 256) { s.type = SEG_NORM; s.dst = (bf16_t*)(p.ws + WS_MISC + MS_MK) + (size_t)l * 18 * 256 * 256; s.ld = 256; s.col = col0; s.gain = p.in[36] + l * 64; }
      else { s.type = SEG_CHMEM; s.dst = (bf16_t*)(p.ws + WS_MISC + MS_MVT) + (size_t)l * 18 * 256 * 256; s.col = col0 - 256; }
      gemm_tile(smem, ga, mt * 256, nt * 256, s);
    }
  }
}

DI void phase_mixer0(char* smem, const Params& p) {
#pragma unroll 1
  for (int item = blockIdx.x; item < 2048; item += gridDim.x) {
    const int kind = item >> 9, idx = item & 511;
#ifndef SUBP
#define SUBP -1
#endif
    if (kind == 0 || kind == 2) {
      if (PROBE & 4) diff_item(smem, p, (kind == 2 ? 512 : 0) + idx, true);
      diff_item(smem, p, (kind == 2 ? 512 : 0) + idx);
    } else if (kind == 1) {
      if (PROBE & 8) hyena_item<14, 1, 1>(smem, p, idx, 0);
      hyena_item<14, 1, 1>(smem, p, idx, 0);
    } else {
      if (PROBE & 8) hyena_item<11, 4, 2>(smem, p, idx, T_P);
      hyena_item<11, 4, 2>(smem, p, idx, T_P);
    }
  }
}
DI void phase_mixer1(char* smem, const Params& p) {
#pragma unroll 1
  for (int item = blockIdx.x; item < 4096; item += gridDim.x) {
    if (PROBE & 16) { if (item < 2048) na_item(smem, p, item, true); else wg_item(smem, p, item - 2048, true); }
    if (item < 2048) na_item(smem, p, item); else wg_item(smem, p, item - 2048);
  }
}

DI void phase_post(char* smem, const Params& p, int layer) {
  const bf16_t* W = (const bf16_t*)(p.ws + WS_W);
  float* RS = (float*)(p.ws + WS_MISC + MS_RS);
  bf16_t* XB = (bf16_t*)(p.ws + WS_XB);
  bf16_t* H = (bf16_t*)(p.ws + (layer == 0 ? WS_H_L0 : WS_H_L1));
  bf16_t* QM = (bf16_t*)(p.ws + WS_QM);
  const int wn = (threadIdx.x >> 6) & 1;
#pragma unroll 1
  for (int mt = blockIdx.x; mt < 256; mt += gridDim.x) {
    const int m0 = mt * 256;
    if (layer == 0) {
      const bf16_t* OBt = (const bf16_t*)(p.ws + WS_R3);
      bf16_t* OB = (bf16_t*)(p.ws + WS_R1);
      const int tid = threadIdx.x;
#pragma unroll 1
      for (int chunk = 0; chunk < 4; ++chunk) {
        __syncthreads();
        {
          const int c = tid >> 2, part = tid & 3;
          const uint4* src = (const uint4*)(OBt + chm_index(512, m0, chunk * 128 + c) + part * 64);
#pragma unroll
          for (int i = 0; i < 8; ++i) *(uint4*)(smem + c * 528 + part * 128 + i * 16) = src[i];
        }
        __syncthreads();
#pragma unroll 2
        for (int it = 0; it < 8; ++it) {
          const int item = it * NTHR + tid; const int t = item & 255, c8 = item >> 8;
          unsigned short v[8];
#pragma unroll
          for (int j = 0; j < 8; ++j) v[j] = *(const unsigned short*)(smem + (c8 * 8 + j) * 528 + t * 2);
          uint4 u; u.x = v[0] | ((unsigned)v[1] << 16); u.y = v[2] | ((unsigned)v[3] << 16); u.z = v[4] | ((unsigned)v[5] << 16); u.w = v[6] | ((unsigned)v[7] << 16);
          *(uint4*)(OB + (size_t)(m0 + t) * 512 + chunk * 128 + c8 * 8) = u;
        }
      }
      __syncthreads();
    }
#ifndef CHAINP
#define CHAINP -1
#endif
    if (CHAINP < 0 || CHAINP == 1) {
      GemmArgs ga{(const bf16_t*)(p.ws + WS_R0), (const bf16_t*)(p.ws + (layer == 0 ? WS_R1 : WS_R3)), 512, 512, W + (layer == 0 ? W_OUTE : W_OUTO), DM, DM};
      Seg s{}; s.type = SEG_RESID; s.xin0 = layer == 0 ? p.in[0] : nullptr; s.xin1 = layer == 0 ? p.in[1] : nullptr;
      s.xout = p.out; s.xb = XB; s.rs_out = RS + (size_t)(layer * 3 + 1) * T_ALL;
      _Pragma("unroll 1") for (int nt = 0; nt < 4; ++nt) { s.col = nt * 256; gemm_tile(smem, ga, m0, nt * 256, s); }
    }
    block_sync_global();
    if (CHAINP < 0 || CHAINP == 2) {
      GemmArgs ga{XB, nullptr, 1 << 30, DM, W + W_Q + (size_t)layer * 256 * 1024, DM, DM};
      Seg s{}; s.type = SEG_NORM; s.rs = RS + (size_t)(layer * 3 + 1) * T_ALL; s.dst = QM; s.ld = 256; s.gain = p.in[35] + layer * 64; s.scale = QSCALE;
      s.col = 64 * ((threadIdx.x >> 6) & 3);
      gemm_tile(smem, ga, m0, 0, s);
    }
    block_sync_global();
    if (CHAINP < 0 || CHAINP == 3) mem_attn_tile(smem, p, layer, m0);
    block_sync_global();
    if (CHAINP < 0 || CHAINP == 4) {
      GemmArgs ga{QM, nullptr, 1 << 30, 256, W + W_O + (size_t)layer * 1024 * 256, 256, 256};
      Seg s{}; s.type = SEG_RESID; s.xout = p.out; s.xb = XB; s.rs_out = RS + (size_t)(layer * 3 + 2) * T_ALL;
      _Pragma("unroll 1") for (int nt = 0; nt < 4; ++nt) { s.col = nt * 256; gemm_tile(smem, ga, m0, nt * 256, s); }
    }
    block_sync_global();
    if (CHAINP < 0 || CHAINP == 5) _Pragma("unroll 1") for (int hc = 0; hc < 4; ++hc) {
      {
        GemmArgs ga{XB, nullptr, 1 << 30, DM, W + W_1 + (size_t)layer * 4096 * 1024 + (size_t)hc * 1024 * 1024, DM, DM};
        Seg s{}; s.type = SEG_MLP1; s.rs = RS + (size_t)(layer * 3 + 2) * T_ALL; s.dst = H; s.ld = 1024;
        _Pragma("unroll 1") for (int nt = 0; nt < 4; ++nt) { s.col = nt * 256; gemm_tile(smem, ga, m0, nt * 256, s); }
      }
      block_sync_global();
      {
        GemmArgs ga{H, nullptr, 1 << 30, 1024, W + W_2 + (size_t)layer * 4096 * 1024 + (size_t)hc * 1024, 4096, 1024};
        Seg s{}; s.type = SEG_RESID; s.xout = p.out;
        if (hc == 3 && layer == 0) { s.xb = XB; s.rs_out = RS + (size_t)3 * T_ALL; }
        _Pragma("unroll 1") for (int nt = 0; nt < 4; ++nt) { s.col = nt * 256; gemm_tile(smem, ga, m0, nt * 256, s); }
      }
      block_sync_global();
    }
  }
  (void)wn;
}

__global__ void __launch_bounds__(NTHR) fwd_kernel(Params p, int ph_lo, int ph_hi) {
  extern __shared__ __attribute__((aligned(16))) char smem[];
#define RUN_PHASE(i_, call_) if (ph_lo <= (i_) && (i_) <= ph_hi) { if ((i_) > ph_lo) { __threadfence(); cg::this_grid().sync(); } call_; }
  RUN_PHASE(0, phase_prep(smem, p))
  if (PROBE & 1) { __syncthreads(); phase_prep(smem, p); }
  RUN_PHASE(1, phase_inproj(smem, p, 0))
  if (PROBE & 2) { __syncthreads(); phase_inproj(smem, p, 0); }
  RUN_PHASE(2, phase_mixer0(smem, p))
  RUN_PHASE(3, phase_post(smem, p, 0))
  RUN_PHASE(4, phase_inproj(smem, p, 1))
  if (PROBE & 2) { __syncthreads(); phase_inproj(smem, p, 1); }
  RUN_PHASE(5, phase_mixer1(smem, p))
  RUN_PHASE(6, phase_post(smem, p, 1))
}

#ifndef ONE_LAUNCH
#define ONE_LAUNCH 1
#endif

extern "C" void kernel_launch(void* const* d_in, const int* in_sizes, int n_in, void* d_out, int out_size, void* d_ws, size_t ws_size,
                              hipStream_t stream) {
  static int grid = 0;
  if (grid == 0) {
    if (n_in != 39 || ws_size < WS_NEED || out_size != T_ALL * DM) { fprintf(stderr, "kernel_launch: unexpected shapes n_in %d ws %zu out %d\n", n_in, ws_size, out_size); grid = -1; return; }
    if (hipFuncSetAttribute((const void*)fwd_kernel, hipFuncAttributeMaxDynamicSharedMemorySize, SMEM_BYTES) != hipSuccess) { fprintf(stderr, "hipFuncSetAttribute failed\n"); grid = -1; return; }
    int dev = 0, cus = 0, per_cu = 0;
    hipGetDevice(&dev);
    hipDeviceGetAttribute(&cus, hipDeviceAttributeMultiprocessorCount, dev);
    hipOccupancyMaxActiveBlocksPerMultiprocessor(&per_cu, (const void*)fwd_kernel, NTHR, SMEM_BYTES);
    if (per_cu < 1 || cus < 1) { fprintf(stderr, "occupancy query: %d blocks/CU, %d CUs\n", per_cu, cus); grid = -1; return; }
    grid = cus;
  }
  if (grid < 0) return;
  Params p{};
  for (int i = 0; i < 39; ++i) p.in[i] = (const float*)d_in[i];
  p.out = (float*)d_out; p.ws = (char*)d_ws;
#if ONE_LAUNCH
  int lo = 0, hi = 6;
  void* args[] = {&p, &lo, &hi};
  hipError_t e = hipLaunchCooperativeKernel((const void*)fwd_kernel, dim3(grid), dim3(NTHR), args, SMEM_BYTES, stream);
  if (e != hipSuccess) fprintf(stderr, "cooperative launch failed: %s\n", hipGetErrorString(e));
#else
  for (int ph = 0; ph <= 6; ++ph) hipLaunchKernelGGL(fwd_kernel, dim3(grid), dim3(NTHR), SMEM_BYTES, stream, p, ph, ph);
#endif
}
```

```cpp
#include <hip/hip_runtime.h>
#include <hip/hip_cooperative_groups.h>
#include <cstdio>
namespace cg = cooperative_groups;

#define DI __device__ __forceinline__
#define PROBE 0
typedef unsigned short bf16_t;
using bf16x8 = __attribute__((ext_vector_type(8))) short;
using s16x4 = __attribute__((ext_vector_type(4))) short;
using f32x4 = __attribute__((ext_vector_type(4))) float;
#define MFMA16(a, b, c) __builtin_amdgcn_mfma_f32_16x16x32_bf16((a), (b), (c), 0, 0, 0)

constexpr int NTHR = 512;
constexpr int T_ALL = 65536;
constexpr int T_P = 32768;
constexpr int LP = 16384, LS = 2048;
constexpr int DM = 1024;
constexpr float EPS = 1e-6f;
constexpr float LOG2E = 1.4426950408889634f;
constexpr float QSCALE = 0.125f * 1.4426950408889634f;
constexpr int SMEM_BYTES = 144 * 1024;
constexpr size_t MiB = (size_t)1 << 20;

constexpr size_t WS_XB = 0;
constexpr size_t WS_W = 128 * MiB;
constexpr size_t W_INE = 0;
constexpr size_t W_OUTE = W_INE + (size_t)3072 * 1024;
constexpr size_t W_INO = W_OUTE + (size_t)1024 * 1024;
constexpr size_t W_OUTO = W_INO + (size_t)2304 * 1024;
constexpr size_t W_Q = W_OUTO + (size_t)1024 * 1024;
constexpr size_t W_KV = W_Q + (size_t)2 * 256 * 1024;
constexpr size_t W_O = W_KV + (size_t)2 * 512 * 1024;
constexpr size_t W_1 = W_O + (size_t)2 * 1024 * 256;
constexpr size_t W_2 = W_1 + (size_t)2 * 4096 * 1024;
constexpr size_t W_END = W_2 + (size_t)2 * 4096 * 1024;
static_assert(W_END * 2 <= 51 * MiB, "weights");
constexpr size_t WS_MISC = 179 * MiB;
constexpr size_t MS_RS = 0;
constexpr size_t MS_RSM = MS_RS + (size_t)6 * T_ALL * 4;
constexpr size_t MS_MK = MS_RSM + 32768;
constexpr size_t MS_MVT = MS_MK + (size_t)2 * 18 * 256 * 256 * 2;
constexpr size_t MS_H2P = MS_MVT + (size_t)2 * 18 * 256 * 256 * 2;
constexpr size_t MS_H2S = MS_H2P + (size_t)LP * 64 * 4;
constexpr size_t MS_LUT = MS_H2S + (size_t)LS * 64 * 4;
constexpr size_t MS_LAM = MS_LUT + 16384;
constexpr size_t MS_END = MS_LAM + 256;
static_assert(MS_END <= 16 * MiB, "misc");
constexpr size_t WS_R0 = 195 * MiB;
constexpr size_t WS_R1 = 259 * MiB;
constexpr size_t WS_R2 = 323 * MiB;
constexpr size_t WS_R3 = 387 * MiB;
constexpr size_t WS_KD = 451 * MiB;
constexpr size_t WS_VDT = 467 * MiB;
constexpr size_t WS_QM = 451 * MiB;
constexpr size_t WS_H_L0 = 323 * MiB;
constexpr size_t WS_H_L1 = 259 * MiB;
constexpr size_t WS_NEED = 512 * MiB;
constexpr size_t HY_SCR_PER_BLOCK = 512 * 1024;

struct Params {
  const float* in[39];
  float* out;
  char* ws;
};

DI unsigned short f2bf(float x) { unsigned u = __float_as_uint(x); u += 0x7fffu + ((u >> 16) & 1u); return (unsigned short)(u >> 16); }
typedef __bf16 bf16v2_t __attribute__((ext_vector_type(2)));
typedef float f32v2_t __attribute__((ext_vector_type(2)));
DI unsigned pack2(float a, float b) { f32v2_t f = {a, b}; bf16v2_t h = __builtin_convertvector(f, bf16v2_t); return __builtin_bit_cast(unsigned, h); }
DI float bf2f(unsigned short h) { return __uint_as_float(((unsigned)h) << 16); }
DI float ex2(float x) { return __builtin_amdgcn_exp2f(x); }
DI float sin_rev(float r) { return __builtin_amdgcn_sinf(r); }
DI float cos_rev(float r) { return __builtin_amdgcn_cosf(r); }
DI int opaque(int x) { asm volatile("" : "+v"(x)); return x; }
DI float dpp_f(float v, int ctrl_sel) {
  int x = __float_as_int(v), r;
  if (ctrl_sel == 0) r = __builtin_amdgcn_update_dpp(x, x, 0xB1, 0xF, 0xF, false);
  else if (ctrl_sel == 1) r = __builtin_amdgcn_update_dpp(x, x, 0x4E, 0xF, 0xF, false);
  else if (ctrl_sel == 2) r = __builtin_amdgcn_update_dpp(x, x, 0x141, 0xF, 0xF, false);
  else r = __builtin_amdgcn_update_dpp(x, x, 0x140, 0xF, 0xF, false);
  return __int_as_float(r);
}
DI float row16_sum(float v) { v += dpp_f(v, 0); v += dpp_f(v, 1); v += dpp_f(v, 2); v += dpp_f(v, 3); return v; }
DI void block_sync_global() { __syncthreads(); }

DI size_t chm_index(int CH, int row, int ch) {
  if (row < T_P) { int b = row >> 14, t = row & (LP - 1); return ((size_t)(b * CH + ch) << 14) + t; }
  int r = row - T_P; int b = r >> 11, t = r & (LS - 1);
  return (size_t)T_P * CH + ((size_t)(b * CH + ch) << 11) + t;
}

struct GemmArgs {
  const bf16_t* A0; const bf16_t* A1; int ksplit; int lda;
  const bf16_t* Wt; int ldw; int K;
};
enum { SEG_NORM = 0, SEG_CHM = 1, SEG_CHMEM = 2, SEG_RESID = 3, SEG_MLP1 = 4 };
struct Seg {
  int type;
  bf16_t* dst; int ld; int col;
  const float* gain; float scale;
  int CH;
  const float* rs;
  const float* xin0; const float* xin1; float* xout; bf16_t* xb; float* rs_out;
};
constexpr int G_TILE_B = 256 * 64 * 2, G_STAGE_B = 2 * G_TILE_B;
DI int g_lds_byte(int r, int c) { int st = (r >> 4) * 2 + (c >> 5), ob = (r & 15) * 64 + (c & 31) * 2; return st * 1024 + (ob ^ (((ob >> 9) & 1) << 5)); }
DI void g_stage_rc(int b, int& R, int& C) { int st = b >> 10, sb = b & 1023, swz = sb ^ (((sb >> 9) & 1) << 5); R = (st >> 1) * 16 + swz / 64; C = (st & 1) * 32 + (swz % 64) / 2; }
#define WAIT_V0() asm volatile("s_waitcnt vmcnt(0)" ::: "memory")

DI void gemm_tile(char* smem_generic, const GemmArgs& ga, int m0, int n0, const Seg& sg) {
  extern __shared__ __attribute__((aligned(16))) char shm[];
  (void)smem_generic;
  const int tid = opaque((int)threadIdx.x), lane = tid & 63, wid = tid >> 6;
  const int l16 = lane & 15, g = lane >> 4;
  const int wr = wid >> 2, wc = wid & 3;
  int sR[4], sC[4];
#pragma unroll
  for (int i = 0; i < 4; ++i) g_stage_rc(wid * 1024 + i * 8192 + lane * 16, sR[i], sC[i]);
  const int KT = ga.K >> 6;
#define G_STAGE(buf_, kt_) do { const int k0_ = (kt_) << 6; \
    const bf16_t* Ab_ = (k0_ < ga.ksplit) ? ga.A0 + k0_ : ga.A1 + (k0_ - ga.ksplit); \
    _Pragma("unroll") for (int i = 0; i < 4; ++i) { \
      __builtin_amdgcn_global_load_lds((const unsigned*)(Ab_ + (size_t)(m0 + sR[i]) * ga.lda + sC[i]), (__attribute__((address_space(3))) unsigned*)(shm + (buf_) * G_STAGE_B + wid * 1024 + i * 8192), 16, 0, 0); \
      __builtin_amdgcn_global_load_lds((const unsigned*)(ga.Wt + (size_t)(n0 + sR[i]) * ga.ldw + k0_ + sC[i]), (__attribute__((address_space(3))) unsigned*)(shm + (buf_) * G_STAGE_B + G_TILE_B + wid * 1024 + i * 8192), 16, 0, 0); } } while (0)
  f32x4 acc[8][4];
#pragma unroll
  for (int i = 0; i < 8; ++i)
#pragma unroll
    for (int j = 0; j < 4; ++j) acc[i][j] = (f32x4){0.f, 0.f, 0.f, 0.f};
  float* rs_lds = (float*)(shm + 143360);
  G_STAGE(0, 0);
  if (sg.rs && tid < 256) rs_lds[tid] = rsqrtf(sg.rs[m0 + tid] * (1.0f / 1024.0f) + EPS);
  WAIT_V0(); __syncthreads();
#pragma unroll 1
  for (int t = 0; t < KT; ++t) {
    const int cur = t & 1;
    if (t + 1 < KT) G_STAGE(cur ^ 1, t + 1);
    const char* SAp = shm + cur * G_STAGE_B; const char* SBp = SAp + G_TILE_B;
#pragma unroll
    for (int ks = 0; ks < 2; ++ks) {
      bf16x8 At[8], Bf[4];
#pragma unroll
      for (int m = 0; m < 8; ++m) At[m] = *(const bf16x8*)(SAp + g_lds_byte(wr * 128 + m * 16 + l16, ks * 32 + g * 8));
#pragma unroll
      for (int n = 0; n < 4; ++n) Bf[n] = *(const bf16x8*)(SBp + g_lds_byte(wc * 64 + n * 16 + l16, ks * 32 + g * 8));
#pragma unroll
      for (int m = 0; m < 8; ++m)
#pragma unroll
        for (int n = 0; n < 4; ++n) acc[m][n] = MFMA16(At[m], Bf[n], acc[m][n]);
      __builtin_amdgcn_sched_barrier(0);
    }
    WAIT_V0(); __syncthreads();
  }
  const int rbase = m0 + 128 * wr + 4 * g;
  if (sg.rs) {
#pragma unroll
    for (int m = 0; m < 8; ++m)
#pragma unroll
      for (int r = 0; r < 4; ++r) {
        const float sc = rs_lds[128 * wr + 4 * g + 16 * m + r];
#pragma unroll
        for (int n = 0; n < 4; ++n) acc[m][n][r] *= sc;
      }
  }
  if (sg.type == SEG_NORM) {
    float gn[4];
#pragma unroll
    for (int n = 0; n < 4; ++n) gn[n] = sg.gain[16 * n + l16] * sg.scale;
#pragma unroll
    for (int m = 0; m < 8; ++m) {
#pragma unroll
      for (int r = 0; r < 4; ++r) {
        float ss = 0.f;
#pragma unroll
        for (int n = 0; n < 4; ++n) ss += acc[m][n][r] * acc[m][n][r];
        ss = row16_sum(ss);
        const float sc = rsqrtf(ss * (1.0f / 64.0f) + EPS);
        bf16_t* d = sg.dst + (size_t)(rbase + 16 * m + r) * sg.ld + sg.col + l16;
#pragma unroll
        for (int n = 0; n < 4; ++n) d[16 * n] = f2bf(acc[m][n][r] * sc * gn[n]);
      }
      __builtin_amdgcn_sched_barrier(0);
    }
  } else if (sg.type == SEG_CHM || sg.type == SEG_CHMEM) {
#pragma unroll
    for (int m = 0; m < 8; ++m) {
#pragma unroll
      for (int n = 0; n < 4; ++n) {
        const int row = rbase + 16 * m; const int ch = sg.col + l16 + 16 * n;
        size_t off;
        if (sg.type == SEG_CHM) off = chm_index(sg.CH, row, ch);
        else off = ((size_t)((row >> 8) * 256 + ch) << 8) + (row & 255);
        uint2 v; v.x = pack2(acc[m][n][0], acc[m][n][1]); v.y = pack2(acc[m][n][2], acc[m][n][3]);
        *(uint2*)(sg.dst + off) = v;
      }
      __builtin_amdgcn_sched_barrier(0);
    }
  } else {
    float* Cs = (float*)shm;
    const int rr = tid >> 5, c4 = (tid & 31) * 4;
#pragma unroll 1
    for (int half = 0; half < 2; ++half) {
      if ((wc >> 1) == half) {
#pragma unroll
        for (int m = 0; m < 8; ++m)
#pragma unroll
          for (int n = 0; n < 4; ++n)
#pragma unroll
            for (int r = 0; r < 4; ++r) Cs[(128 * wr + 16 * m + 4 * g + r) * 132 + 64 * (wc & 1) + 16 * n + l16] = acc[m][n][r];
      }
      __syncthreads();
      const int cg = sg.col + 128 * half + c4;
      if (sg.type == SEG_MLP1) {
#pragma unroll 4
        for (int it = 0; it < 16; ++it) {
          const int lr = it * 16 + rr; const int row = m0 + lr;
          f32x4 v = *(const f32x4*)(Cs + lr * 132 + c4);
          v[0] = fmaxf(v[0], 0.f); v[1] = fmaxf(v[1], 0.f); v[2] = fmaxf(v[2], 0.f); v[3] = fmaxf(v[3], 0.f);
          uint2 u; u.x = pack2(v[0] * v[0], v[1] * v[1]); u.y = pack2(v[2] * v[2], v[3] * v[3]);
          *(uint2*)(sg.dst + (size_t)row * sg.ld + cg) = u;
        }
      } else {
#pragma unroll 1
        for (int it0 = 0; it0 < 16; it0 += 8) {
          f32x4 xv[8];
#pragma unroll
          for (int k = 0; k < 8; ++k) {
            const int row = m0 + (it0 + k) * 16 + rr;
            const float* xo;
            if (sg.xin0) xo = (row < T_P) ? sg.xin0 + (size_t)row * DM : sg.xin1 + (size_t)(row - T_P) * DM;
            else xo = sg.xout + (size_t)row * DM;
            xv[k] = *(const f32x4*)(xo + cg);
          }
#pragma unroll
          for (int k = 0; k < 8; ++k) {
            const int lr = (it0 + k) * 16 + rr; const int row = m0 + lr;
            f32x4 v = *(const f32x4*)(Cs + lr * 132 + c4);
            v += xv[k];
            *(f32x4*)(sg.xout + (size_t)row * DM + cg) = v;
            if (sg.xb) { uint2 u; u.x = pack2(v[0], v[1]); u.y = pack2(v[2], v[3]); *(uint2*)(sg.xb + (size_t)row * DM + cg) = u; }
            if (sg.rs_out) {
              float ss = v[0] * v[0] + v[1] * v[1] + v[2] * v[2] + v[3] * v[3];
              ss = row16_sum(ss); ss += __shfl_xor(ss, 16);
              if ((tid & 31) == 0) atomicAdd(sg.rs_out + row, ss);
            }
          }
        }
      }
      __syncthreads();
    }
  }
}

enum { AM_MEM = 0, AM_DIFF = 1, AM_WG = 2, AM_NA = 3 };
constexpr int ATT_LUT_OFS = 73728;
constexpr int ATT_O0_OFS = 77824;

template <int VD, int MODE>
DI void attn_core(char* smem, const bf16_t* Q, int ldq, const bf16_t* K, int ldk, const bf16_t* Vt, int ldv,
                  int qpos0, int kbeg, int kend, int nrows, float sink_l2, float (&O)[2][VD / 16][4]) {
  constexpr int NDB = VD / 16;
  constexpr int STAGE = 8192 + VD * 128;
  constexpr int NL = 1 + VD / 64;
  extern __shared__ __attribute__((aligned(16))) char shm[];
  const int tid = opaque((int)threadIdx.x), lane = tid & 63, wave = tid >> 6;
  const int l16 = lane & 15, g = lane >> 4;
  const float* lut = (const float*)(smem + ATT_LUT_OFS);
  bf16x8 qf[2][2];
#pragma unroll
  for (int qb = 0; qb < 2; ++qb)
#pragma unroll
    for (int kk = 0; kk < 2; ++kk) qf[qb][kk] = *(const bf16x8*)(Q + (size_t)(32 * wave + 16 * qb + l16) * ldq + 32 * kk + 8 * g);
  float m[2] = {-1e30f, -1e30f}, l[2] = {0.f, 0.f};
#pragma unroll
  for (int qb = 0; qb < 2; ++qb)
#pragma unroll
    for (int db = 0; db < NDB; ++db)
#pragma unroll
      for (int r = 0; r < 4; ++r) O[qb][db][r] = 0.f;
  const int wq0 = qpos0 + 32 * wave;
  const int srow = 8 * wave + (lane >> 3);
  const int schunk = (lane & 7) ^ (lane >> 3);
#define ATT_ISSUE(k0_, st_) do { \
    __builtin_amdgcn_global_load_lds((const unsigned*)(K + (size_t)((k0_) + srow) * ldk + 8 * schunk), (__attribute__((address_space(3))) unsigned*)(shm + (st_) * STAGE + wave * 1024), 16, 0, 0); \
    __builtin_amdgcn_global_load_lds((const unsigned*)(Vt + (size_t)(srow) * ldv + (k0_) + 8 * schunk), (__attribute__((address_space(3))) unsigned*)(shm + (st_) * STAGE + 8192 + wave * 1024), 16, 0, 0); \
    if (VD == 128) __builtin_amdgcn_global_load_lds((const unsigned*)(Vt + (size_t)(srow + 64) * ldv + (k0_) + 8 * schunk), (__attribute__((address_space(3))) unsigned*)(shm + (st_) * STAGE + 8192 + 8192 + wave * 1024), 16, 0, 0); } while (0)
  const int ntile = (kend - kbeg) >> 6;
  ATT_ISSUE(kbeg, 0);
  if (ntile > 1) { ATT_ISSUE(kbeg + 64, 1); asm volatile("s_waitcnt vmcnt(%0)" :: "n"(NL) : "memory"); }
  else asm volatile("s_waitcnt vmcnt(0)" ::: "memory");
  __builtin_amdgcn_s_barrier();
  int it = 0, st = 0;
  for (int k0 = kbeg; k0 < kend; k0 += 64, ++it) {
    { const int st2 = (st >= 1) ? st - 1 : 2; if (it + 2 < ntile) ATT_ISSUE(k0 + 128, st2); }
    const char* Ks = shm + st * STAGE; const char* Vs = Ks + 8192;
    bool active = true;
    if (MODE == AM_WG) active = !(k0 + 63 < wq0 - 128 || k0 > wq0 + 31 + 128);
    int na_rs = 0; const int qr = wq0 >> 6, kr = k0 >> 6;
    if (MODE == AM_NA) { na_rs = min(max(qr - 4, 0), nrows - 8); active = (kr >= na_rs && kr < na_rs + 8); }
    if (active) {
      f32x4 S[2][4];
#pragma unroll
      for (int kb = 0; kb < 4; ++kb) {
        bf16x8 kf0 = *(const bf16x8*)(Ks + (16 * kb + l16) * 128 + ((g ^ (l16 & 7)) << 4));
        bf16x8 kf1 = *(const bf16x8*)(Ks + (16 * kb + l16) * 128 + (((4 + g) ^ (l16 & 7)) << 4));
#pragma unroll
        for (int qb = 0; qb < 2; ++qb) {
          f32x4 z = (f32x4){0.f, 0.f, 0.f, 0.f};
          z = MFMA16(kf0, qf[qb][0], z);
          S[qb][kb] = MFMA16(kf1, qf[qb][1], z);
        }
      }
      float coff = 0.f;
      bool lut_tile = false;
      if (MODE == AM_DIFF) {
        if (k0 + 63 - wq0 <= -128) coff = lut[0];
        else if (k0 - (wq0 + 31) >= 128) coff = lut[256];
        else lut_tile = true;
      }
#pragma unroll
      for (int qb = 0; qb < 2; ++qb) {
        const int q = wq0 + 16 * qb + l16;
        if ((MODE == AM_DIFF && lut_tile) || MODE == AM_WG) {
#pragma unroll
          for (int kb = 0; kb < 4; ++kb)
#pragma unroll
            for (int r = 0; r < 4; ++r) {
              const int rel = k0 + 16 * kb + 4 * g + r - q;
              const int rc = min(max(rel, -128), 128);
              float s = S[qb][kb][r] + lut[rc + 128];
              if (MODE == AM_WG && (rel > 128 || rel < -128)) s = -1e30f;
              S[qb][kb][r] = s;
            }
        } else if (MODE == AM_NA) {
          const int qc = q & 63;
          const int cs = min(max(qc - 8, 0), 48);
          const int dr = kr - qr + 7;
#pragma unroll
          for (int kb = 0; kb < 4; ++kb)
#pragma unroll
            for (int r = 0; r < 4; ++r) {
              const int kc = 16 * kb + 4 * g + r;
              const bool ok = (kc >= cs) && (kc < cs + 16);
              const int dc = min(max(kc - qc + 15, 0), 30);
              float s = S[qb][kb][r] + lut[dr * 31 + dc];
              S[qb][kb][r] = ok ? s : -1e30f;
            }
        }
      }
      float mx[2];
      bool need = false;
#pragma unroll
      for (int qb = 0; qb < 2; ++qb) {
        float v = -1e30f;
#pragma unroll
        for (int kb = 0; kb < 4; ++kb) v = fmaxf(v, fmaxf(fmaxf(S[qb][kb][0], S[qb][kb][1]), fmaxf(S[qb][kb][2], S[qb][kb][3])));
        v = fmaxf(v, __shfl_xor(v, 16)); v = fmaxf(v, __shfl_xor(v, 32));
        v += coff;
        mx[qb] = v;
        need = need || (v > m[qb] + 8.0f);
      }
      if (__any(need)) {
#pragma unroll
        for (int qb = 0; qb < 2; ++qb) {
          const float mn = fmaxf(m[qb], mx[qb]);
          const float alpha = ex2(m[qb] - mn);
          m[qb] = mn;
          l[qb] *= alpha;
#pragma unroll
          for (int db = 0; db < NDB; ++db)
#pragma unroll
            for (int r = 0; r < 4; ++r) O[qb][db][r] *= alpha;
        }
      }
#pragma unroll
      for (int qb = 0; qb < 2; ++qb) {
        const float mo = m[qb] - coff;
        float ps = 0.f;
#pragma unroll
        for (int kb = 0; kb < 4; ++kb)
#pragma unroll
          for (int r = 0; r < 4; ++r) { float p = ex2(S[qb][kb][r] - mo); S[qb][kb][r] = p; ps += p; }
        l[qb] += ps;
      }
#pragma unroll
      for (int ks = 0; ks < 2; ++ks) {
        bf16x8 pf[2];
#pragma unroll
        for (int qb = 0; qb < 2; ++qb) {
          uint4 u;
          u.x = pack2(S[qb][2 * ks][0], S[qb][2 * ks][1]); u.y = pack2(S[qb][2 * ks][2], S[qb][2 * ks][3]);
          u.z = pack2(S[qb][2 * ks + 1][0], S[qb][2 * ks + 1][1]); u.w = pack2(S[qb][2 * ks + 1][2], S[qb][2 * ks + 1][3]);
          pf[qb] = __builtin_bit_cast(bf16x8, u);
        }
#pragma unroll
        for (int db = 0; db < NDB; ++db) {
          const char* vrow = Vs + (16 * db + l16) * 128 + 8 * (g & 1);
          uint2 v0 = *(const uint2*)(vrow + (((4 * ks + (g >> 1)) ^ (l16 & 7)) << 4));
          uint2 v1 = *(const uint2*)(vrow + (((4 * ks + 2 + (g >> 1)) ^ (l16 & 7)) << 4));
          uint4 u; u.x = v0.x; u.y = v0.y; u.z = v1.x; u.w = v1.y;
          bf16x8 vf = __builtin_bit_cast(bf16x8, u);
#pragma unroll
          for (int qb = 0; qb < 2; ++qb) {
            f32x4 o = (f32x4){O[qb][db][0], O[qb][db][1], O[qb][db][2], O[qb][db][3]};
            o = MFMA16(vf, pf[qb], o);
            O[qb][db][0] = o[0]; O[qb][db][1] = o[1]; O[qb][db][2] = o[2]; O[qb][db][3] = o[3];
          }
        }
      }
    }
    if (it + 2 < ntile) asm volatile("s_waitcnt vmcnt(%0)" :: "n"(NL) : "memory");
    else asm volatile("s_waitcnt vmcnt(0)" ::: "memory");
    asm volatile("s_waitcnt lgkmcnt(0)" ::: "memory");
    __builtin_amdgcn_s_barrier();
    st = (st == 2) ? 0 : st + 1;
  }
#pragma unroll
  for (int qb = 0; qb < 2; ++qb) {
    float lt = l[qb];
    lt += __shfl_xor(lt, 16); lt += __shfl_xor(lt, 32);
    if (MODE == AM_WG) lt += ex2(sink_l2 - m[qb]);
    const float inv = 1.0f / lt;
#pragma unroll
    for (int db = 0; db < NDB; ++db)
#pragma unroll
      for (int r = 0; r < 4; ++r) O[qb][db][r] *= inv;
  }
}

template <int NDB>
DI void attn_store(bf16_t* dst, int ld, const float (&O)[2][NDB][4]) {
  const int lane = threadIdx.x & 63, wave = threadIdx.x >> 6, l16 = lane & 15, g = lane >> 4;
#pragma unroll
  for (int qb = 0; qb < 2; ++qb)
#pragma unroll
    for (int db = 0; db < NDB; ++db) {
      uint2 v; v.x = pack2(O[qb][db][0], O[qb][db][1]); v.y = pack2(O[qb][db][2], O[qb][db][3]);
      *(uint2*)(dst + (size_t)(32 * wave + 16 * qb + l16) * ld + 16 * db + 4 * g) = v;
    }
}

DI void seq_of_row(int row0, int& L, int& seq_row0, int& b_glob) {
  if (row0 < T_P) { L = LP; int b = row0 >> 14; seq_row0 = b << 14; b_glob = b; }
  else { L = LS; int b = (row0 - T_P) >> 11; seq_row0 = T_P + (b << 11); b_glob = 2 + b; }
}

DI void diff_item(char* smem, const Params& p, int item, bool dry = false) {
  bf16_t* QA = (bf16_t*)(p.ws + WS_R0);
  const bf16_t* KA = (const bf16_t*)((const char*)p.out + 192 * MiB);
  const bf16_t* VAt = (const bf16_t*)(p.ws + WS_R2);
  const float* misc_lut = (const float*)(p.ws + WS_MISC + MS_LUT);
  const float lam = *(const float*)(p.ws + WS_MISC + MS_LAM);
  int h, row0;
  if (item < 512) { h = item & 3; row0 = (item >> 2) * 256; }
  else { int i2 = item - 512; h = i2 & 3; row0 = T_P + (i2 >> 2) * 256; }
  int L, srow0, bg; seq_of_row(row0, L, srow0, bg);
  const int qpos0 = row0 - srow0;
  const bf16_t* Vt = VAt + chm_index(512, srow0, h * 128);
  float O[2][8][4];
  unsigned* o0s = (unsigned*)(smem + ATT_O0_OFS) + threadIdx.x;
  const int tid = threadIdx.x;
#pragma unroll 1
  for (int mp = 0; mp < 2; ++mp) {
    __syncthreads();
    for (int i = tid; i < 257; i += NTHR) ((float*)(smem + ATT_LUT_OFS))[i] = misc_lut[(h * 2 + mp) * 257 + i];
    __syncthreads();
    attn_core<128, AM_DIFF>(smem, QA + (size_t)row0 * 512 + h * 128 + mp * 64, 512, KA + (size_t)srow0 * 512 + h * 128 + mp * 64, 512,
                            Vt, L, qpos0, 0, L, 0, 0.f, O);
    if (mp == 0) {
#pragma unroll
      for (int qb = 0; qb < 2; ++qb)
#pragma unroll
        for (int db = 0; db < 8; ++db) { o0s[((qb * 8 + db) * 2) * NTHR] = pack2(O[qb][db][0], O[qb][db][1]); o0s[((qb * 8 + db) * 2 + 1) * NTHR] = pack2(O[qb][db][2], O[qb][db][3]); }
    }
  }
  const int tid2 = opaque((int)threadIdx.x);
  const int lane = tid2 & 63, l16 = lane & 15, g = lane >> 4;
  const float* sg = p.in[13];
#pragma unroll
  for (int qb = 0; qb < 2; ++qb) {
    float ss = 0.f;
#pragma unroll
    for (int db = 0; db < 8; ++db) {
      const unsigned w0 = o0s[((qb * 8 + db) * 2) * NTHR], w1 = o0s[((qb * 8 + db) * 2 + 1) * NTHR];
      float a0 = bf2f((unsigned short)(w0 & 0xffff)), a1 = bf2f((unsigned short)(w0 >> 16));
      float a2 = bf2f((unsigned short)(w1 & 0xffff)), a3 = bf2f((unsigned short)(w1 >> 16));
      O[qb][db][0] = a0 - lam * O[qb][db][0]; O[qb][db][1] = a1 - lam * O[qb][db][1];
      O[qb][db][2] = a2 - lam * O[qb][db][2]; O[qb][db][3] = a3 - lam * O[qb][db][3];
#pragma unroll
      for (int r = 0; r < 4; ++r) ss += O[qb][db][r] * O[qb][db][r];
    }
    ss += __shfl_xor(ss, 16); ss += __shfl_xor(ss, 32);
    const float sc = rsqrtf(ss * (1.0f / 128.0f) + EPS) * 0.8f;
#pragma unroll
    for (int db = 0; db < 8; ++db)
#pragma unroll
      for (int r = 0; r < 4; ++r) O[qb][db][r] *= sc * sg[16 * db + 4 * g + r];
  }
  if (dry) attn_store<8>((bf16_t*)(p.ws + 484 * MiB), 512, O); else attn_store<8>(QA + (size_t)row0 * 512 + h * 128, 512, O);
}

DI void wg_item(char* smem, const Params& p, int item, bool dry = false) {
  bf16_t* QD = (bf16_t*)(p.ws + WS_R3);
  const bf16_t* KD = (const bf16_t*)(p.ws + WS_KD);
  const bf16_t* VDt = (const bf16_t*)(p.ws + WS_VDT);
  const float* misc_lut = (const float*)(p.ws + WS_MISC + MS_LUT);
  const int hq = item & 7; const int row0 = (item >> 3) * 256;
  int L, srow0, bg; seq_of_row(row0, L, srow0, bg);
  const int qpos0 = row0 - srow0;
  const int kvh = hq >> 2;
  __syncthreads();
  for (int i = threadIdx.x; i < 257; i += NTHR) ((float*)(smem + ATT_LUT_OFS))[i] = misc_lut[hq * 257 + i];
  __syncthreads();
  float O[2][4][4];
  const int kbeg = max(0, qpos0 - 128), kend = min(L, qpos0 + 256 + 128);
  attn_core<64, AM_WG>(smem, QD + (size_t)row0 * 512 + hq * 64, 512, KD + (size_t)srow0 * 128 + kvh * 64, 128,
                       VDt + chm_index(128, srow0, kvh * 64), L, qpos0, kbeg, kend, 0, p.in[30][hq] * LOG2E, O);
  if (dry) attn_store<4>((bf16_t*)(p.ws + 484 * MiB), 512, O); else attn_store<4>(QD + (size_t)row0 * 512 + hq * 64, 512, O);
}

DI void na_item(char* smem, const Params& p, int item, bool dry = false) {
  bf16_t* QC = (bf16_t*)(p.ws + WS_R0);
  const bf16_t* KC = (const bf16_t*)(p.ws + WS_R1);
  const bf16_t* VCt = (const bf16_t*)(p.ws + WS_R2);
  const int h = item & 7; const int row0 = (item >> 3) * 256;
  int L, srow0, bg; seq_of_row(row0, L, srow0, bg);
  const int qpos0 = row0 - srow0;
  const int nrows = L >> 6;
  __syncthreads();
  for (int i = threadIdx.x; i < 465; i += NTHR) ((float*)(smem + ATT_LUT_OFS))[i] = p.in[27][h * 465 + i] * LOG2E;
  __syncthreads();
  const int qr0 = qpos0 >> 6;
  const int rs0 = min(max(qr0 - 4, 0), nrows - 8), rs3 = min(max(qr0 + 3 - 4, 0), nrows - 8);
  float O[2][4][4];
  attn_core<64, AM_NA>(smem, QC + (size_t)row0 * 512 + h * 64, 512, KC + (size_t)srow0 * 512 + h * 64, 512,
                       VCt + chm_index(512, srow0, h * 64), L, qpos0, rs0 * 64, (rs3 + 8) * 64, nrows, 0.f, O);
  if (dry) attn_store<4>((bf16_t*)(p.ws + 484 * MiB), 512, O); else attn_store<4>(QC + (size_t)row0 * 512 + h * 64, 512, O);
}

DI void mem_attn_tile(char* smem, const Params& p, int layer, int row0) {
  bf16_t* QM = (bf16_t*)(p.ws + WS_QM);
  const bf16_t* MK = (const bf16_t*)(p.ws + WS_MISC + MS_MK) + (size_t)layer * 18 * 256 * 256;
  const bf16_t* MVt = (const bf16_t*)(p.ws + WS_MISC + MS_MVT) + (size_t)layer * 18 * 256 * 256;
  int L, srow0, bg; seq_of_row(row0, L, srow0, bg);
#pragma unroll 1
  for (int h = 0; h < 4; ++h) {
    float O[2][4][4];
    attn_core<64, AM_MEM>(smem, QM + (size_t)row0 * 256 + h * 64, 256, MK + (size_t)bg * 256 * 256 + h * 64, 256,
                          MVt + ((size_t)(bg * 256 + h * 64) << 8), 256, 0, 0, 256, 0, 0.f, O);
    attn_store<4>(QM + (size_t)row0 * 256 + h * 64, 256, O);
  }
}

DI int PADI(int i) { return i + (i >> 5); }
DI float2 cmul(float2 a, float2 b) { return make_float2(a.x * b.x - a.y * b.y, a.x * b.y + a.y * b.x); }
DI float2 cmulc(float2 a, float2 b) { return make_float2(a.x * b.x + a.y * b.y, a.y * b.x - a.x * b.y); }
DI constexpr float C16(int m) { return m == 0 ? 1.f : m == 1 ? 0.92387953251128674f : m == 2 ? 0.70710678118654752f : m == 3 ? 0.38268343236508977f : m == 4 ? 0.f : m == 5 ? -0.38268343236508977f : m == 6 ? -0.70710678118654752f : -0.92387953251128674f; }
DI constexpr float S16(int m) { return m == 0 ? 0.f : m == 1 ? 0.38268343236508977f : m == 2 ? 0.70710678118654752f : m == 3 ? 0.92387953251128674f : m == 4 ? 1.f : m == 5 ? 0.92387953251128674f : m == 6 ? 0.70710678118654752f : 0.38268343236508977f; }

template <int LOGR, int LOGS, bool INV>
DI void fft_pass(float2* buf, int total) {
  constexpr int R = 1 << LOGR;
  constexpr int S = 1 << LOGS;
  const int tid0 = opaque((int)threadIdx.x);
#pragma unroll 1
  for (int u = tid0; u < (total >> LOGR); u += NTHR) {
    const int j = u & (S - 1);
    const int base = ((u >> LOGS) << (LOGS + LOGR)) + j;
    float2* bp = buf + PADI(base);
    float2 x[R];
#pragma unroll
    for (int k = 0; k < R; ++k) x[k] = bp[k * S + ((k * S) >> 5)];
    float2 pw[LOGR];
    {
      const float rev = -(float)j * (1.0f / (float)(R * S));
      pw[0] = make_float2(cos_rev(rev), sin_rev(rev));
#pragma unroll
      for (int i = 1; i < LOGR; ++i) pw[i] = cmul(pw[i - 1], pw[i - 1]);
    }
    if (!INV) {
#pragma unroll
      for (int i = 0; i < LOGR; ++i) {
        const int h = R >> (i + 1);
#pragma unroll
        for (int k = 0; k < R; ++k) {
          if ((k & h) == 0) {
            const int mm = (k & (h - 1)) * 8 / h;
            float2 a = x[k], b = x[k + h];
            x[k] = make_float2(a.x + b.x, a.y + b.y);
            float2 d = make_float2(a.x - b.x, a.y - b.y);
            if (mm != 0) d = cmul(d, make_float2(C16(mm), -S16(mm)));
            x[k + h] = cmul(d, pw[i]);
          }
        }
      }
    } else {
#pragma unroll
      for (int i = LOGR - 1; i >= 0; --i) {
        const int h = R >> (i + 1);
#pragma unroll
        for (int k = 0; k < R; ++k) {
          if ((k & h) == 0) {
            const int mm = (k & (h - 1)) * 8 / h;
            float2 a = x[k];
            float2 d = cmulc(x[k + h], pw[i]);
            if (mm != 0) d = cmulc(d, make_float2(C16(mm), -S16(mm)));
            x[k] = make_float2(a.x + d.x, a.y + d.y);
            x[k + h] = make_float2(a.x - d.x, a.y - d.y);
          }
        }
      }
    }
#pragma unroll
    for (int k = 0; k < R; ++k) bp[k * S + ((k * S) >> 5)] = x[k];
  }
  __syncthreads();
}

template <int LOGN>
DI void fft_fwd(float2* buf, int total) {
  if (LOGN == 14) { fft_pass<4, 10, false>(buf, total); fft_pass<4, 6, false>(buf, total); fft_pass<4, 2, false>(buf, total); fft_pass<2, 0, false>(buf, total); }
  else { fft_pass<4, 7, false>(buf, total); fft_pass<4, 3, false>(buf, total); fft_pass<3, 0, false>(buf, total); }
}
template <int LOGN>
DI void fft_inv(float2* buf, int total) {
  if (LOGN == 14) { fft_pass<2, 0, true>(buf, total); fft_pass<4, 2, true>(buf, total); fft_pass<4, 6, true>(buf, total); fft_pass<4, 10, true>(buf, total); }
  else { fft_pass<3, 0, true>(buf, total); fft_pass<4, 3, true>(buf, total); fft_pass<4, 7, true>(buf, total); }
}

template <int LOGN, int NB, int NSUB>
DI void hyena_item(char* smem, const Params& p, int c, int row_base  ) {
  constexpr int L = 1 << LOGN;
  constexpr int SPT = L / NTHR;
  constexpr int EPT = NB * L / NTHR;
  const int tid = opaque((int)threadIdx.x);
  float2* buf = (float2*)smem;
  float* sm_w3 = (float*)(smem + 135168);
  float* sm_red = sm_w3 + 256;
  char* scr = p.ws + WS_XB + (size_t)blockIdx.x * HY_SCR_PER_BLOCK;
  float* scrF0 = (float*)scr;
  float* scrB0 = scrF0 + L;
  float* scrF1 = (float*)(p.ws + 451 * MiB + (size_t)blockIdx.x * 128 * 1024);
  float* scrB1 = scrF1 + L;
  float2* scrY = (float2*)(scr + 128 * 1024);
  float2* scrZ = (float2*)(scr + 256 * 1024);
  float2* scrS = (float2*)(scr + 384 * 1024);
  const bf16_t* UH = (const bf16_t*)p.out;
  bf16_t* OBt = (bf16_t*)(p.ws + WS_R3);
  const bf16_t* h2b = (const bf16_t*)(p.ws + WS_MISC + (LOGN == 14 ? MS_H2P : MS_H2S));
  const float* w3 = p.in[21];
  const float* cw = p.in[14]; const float* cb = p.in[15]; const float* skp = p.in[22];
  const float delta = fabsf(-3.0701134573253945f + (float)c * ((-15.350567286626973f + 3.0701134573253945f) / 511.0f));
  const float invLm1 = 1.0f / (float)(L - 1);

  float wv[3][4];
#pragma unroll
  for (int q = 0; q < 3; ++q) { const int ch = q * 512 + c; wv[q][0] = cw[ch]; wv[q][1] = cw[1536 + ch]; wv[q][2] = cw[2 * 1536 + ch]; wv[q][3] = cb[ch]; }
  auto loadu3 = [&](int b, int ch, int n, float (&r)[3]) {
    const bf16_t* u = UH + chm_index(1536, row_base + b * L, ch) + n;
    r[1] = bf2f(u[0]);
    r[0] = (n > 0) ? bf2f(u[-1]) : 0.f;
    r[2] = (n < L - 1) ? bf2f(u[1]) : 0.f;
  };
  auto convw = [&](int q, const float (&r)[3]) -> float { return r[0] * wv[q][0] + r[1] * wv[q][1] + r[2] * wv[q][2] + wv[q][3]; };

  {
    __syncthreads();
    if (tid < 256) sm_w3[tid] = w3[(size_t)(tid & 63) * 2048 + (tid >> 6) * 512 + c];
    __syncthreads();
    float asum0 = 0.f, asum1 = 0.f;
    constexpr int NP = L / (2 * NTHR);
    constexpr int CHK = NP < 8 ? NP : 8;
#pragma unroll 1
    for (int rep = 0; rep < ((PROBE & 64) ? 2 : 1); ++rep) {
      asum0 = 0.f; asum1 = 0.f;
#pragma unroll 1
      for (int i0 = 0; i0 < NP; i0 += CHK) {
        float acc[CHK][4][2];
#pragma unroll
        for (int i = 0; i < CHK; ++i)
#pragma unroll
          for (int q = 0; q < 4; ++q) { acc[i][q][0] = 0.f; acc[i][q][1] = 0.f; }
#pragma unroll 1
        for (int j = 0; j < 64; ++j) {
          const float w0 = sm_w3[j], w1 = sm_w3[64 + j], w2 = sm_w3[128 + j], w3v = sm_w3[192 + j];
          const unsigned* hp = (const unsigned*)(h2b + (size_t)j * L) + tid + NTHR * i0;
#pragma unroll
          for (int i = 0; i < CHK; ++i) {
            const unsigned hv = hp[NTHR * i];
            const float h0 = __uint_as_float(hv << 16), h1 = __uint_as_float(hv & 0xffff0000u);
            acc[i][0][0] += h0 * w0; acc[i][0][1] += h1 * w0; acc[i][1][0] += h0 * w1; acc[i][1][1] += h1 * w1;
            acc[i][2][0] += h0 * w2; acc[i][2][1] += h1 * w2; acc[i][3][0] += h0 * w3v; acc[i][3][1] += h1 * w3v;
          }
        }
#pragma unroll
        for (int i = 0; i < CHK; ++i) {
          const int t0 = 2 * (tid + NTHR * (i0 + i));
          const float d0 = ex2(-(float)t0 * invLm1 * delta * LOG2E), d1 = ex2(-(float)(t0 + 1) * invLm1 * delta * LOG2E);
          const float f00 = acc[i][0][0] * d0, f01 = acc[i][0][1] * d1, b00 = acc[i][1][0] * d0, b01 = acc[i][1][1] * d1;
          const float f10 = acc[i][2][0] * d0, f11 = acc[i][2][1] * d1, b10 = acc[i][3][0] * d0, b11 = acc[i][3][1] * d1;
          *(float2*)(scrF0 + t0) = make_float2(f00, f01); *(float2*)(scrB0 + t0) = make_float2(b00, b01);
          *(float2*)(scrF1 + t0) = make_float2(f10, f11); *(float2*)(scrB1 + t0) = make_float2(b10, b11);
          asum0 += fabsf(f00) + fabsf(f01) + (t0 >= 1 ? fabsf(b00) : 0.f) + fabsf(b01);
          asum1 += fabsf(f10) + fabsf(f11) + (t0 >= 1 ? fabsf(b10) : 0.f) + fabsf(b11);
        }
      }
    }
#pragma unroll
    for (int s = 32; s >= 1; s >>= 1) { asum0 += __shfl_xor(asum0, s); asum1 += __shfl_xor(asum1, s); }
    if ((tid & 63) == 0) { sm_red[tid >> 6] = asum0; sm_red[8 + (tid >> 6)] = asum1; }
    block_sync_global();
  }
#pragma unroll 1
  for (int o = 0; o < 2; ++o) {
    float nrm = 0.f;
#pragma unroll
    for (int w = 0; w < 8; ++w) nrm += sm_red[8 * o + w];
    const float inv_nrm = 1.0f / nrm;
    const float* scrF = o ? scrF1 : scrF0;
    const float* scrB = o ? scrB1 : scrB0;
    const float sk = skp[o * 512 + c];

#pragma unroll 1
    for (int par = 0; par < 2; ++par) {
#pragma unroll 8
      for (int i = 0; i < SPT; ++i) {
        const int n = tid + NTHR * i;
        const float f = scrF[n];
        const float br = (n == 0) ? 0.f : scrB[L - n];
        float2 v;
        if (par == 0) v = make_float2((f + br) * inv_nrm, 0.f);
        else { const float gm = (f - br) * inv_nrm; const float rev = -(float)n / (float)(2 * L); v = make_float2(gm * cos_rev(rev), gm * sin_rev(rev)); }
        buf[PADI(n)] = v;
      }
      __syncthreads();
      fft_fwd<LOGN>(buf, L);
#pragma unroll 8
      for (int i = 0; i < SPT; ++i) scrS[tid + NTHR * i] = buf[PADI(tid + NTHR * i)];
      __syncthreads();
#pragma unroll 1
      for (int sub = 0; sub < NSUB; ++sub) {
        constexpr int BT = 4;
#pragma unroll 1
        for (int i0 = 0; i0 < EPT; i0 += BT) {
          float2 zz[BT];
          if (o == 0 && par == 0) {
            float ra[BT][3], rb[BT][3];
#pragma unroll
            for (int k = 0; k < BT; ++k) {
              const int e = tid + NTHR * (i0 + k); const int f = e >> LOGN, n = e & (L - 1); const int pp = sub * NB + f;
              loadu3(2 * pp, c, n, ra[k]); loadu3(2 * pp + 1, c, n, rb[k]);
            }
#pragma unroll
            for (int k = 0; k < BT; ++k) {
              const int e = tid + NTHR * (i0 + k); const int f = e >> LOGN, n = e & (L - 1); const int pp = sub * NB + f;
              zz[k] = make_float2(convw(0, ra[k]), convw(0, rb[k]));
              scrZ[(size_t)pp * L + n] = zz[k];
            }
          } else {
#pragma unroll
            for (int k = 0; k < BT; ++k) {
              const int e = tid + NTHR * (i0 + k); const int f = e >> LOGN, n = e & (L - 1); const int pp = sub * NB + f;
              zz[k] = scrZ[(size_t)pp * L + n];
            }
          }
#pragma unroll
          for (int k = 0; k < BT; ++k) {
            const int e = tid + NTHR * (i0 + k); const int n = e & (L - 1);
            float2 z = zz[k];
            if (par == 1) { const float rev = -(float)n / (float)(2 * L); z = cmul(z, make_float2(cos_rev(rev), sin_rev(rev))); }
            buf[PADI(e)] = z;
          }
        }
        __syncthreads();
        if (PROBE & 32) {
          fft_fwd<LOGN>(buf, NB * L); fft_inv<LOGN>(buf, NB * L);
          _Pragma("unroll 1") for (int i = 0; i < EPT; ++i) { const int e = tid + NTHR * i; float2 v = buf[PADI(e)]; buf[PADI(e)] = make_float2(v.x * (1.0f / L), v.y * (1.0f / L)); }
          __syncthreads();
        }
        fft_fwd<LOGN>(buf, NB * L);
#pragma unroll 1
        for (int i0 = 0; i0 < EPT; i0 += BT) {
          float2 ss[BT];
#pragma unroll
          for (int k = 0; k < BT; ++k) ss[k] = scrS[(tid + NTHR * (i0 + k)) & (L - 1)];
#pragma unroll
          for (int k = 0; k < BT; ++k) { const int e = tid + NTHR * (i0 + k); buf[PADI(e)] = cmul(buf[PADI(e)], ss[k]); }
        }
        __syncthreads();
        fft_inv<LOGN>(buf, NB * L);
        if (par == 0) {
#pragma unroll 8
          for (int i = 0; i < EPT; ++i) {
            const int e = tid + NTHR * i; const int f = e >> LOGN, n = e & (L - 1);
            scrY[(size_t)(sub * NB + f) * L + n] = buf[PADI(e)];
          }
        } else {
          const int gsel = (o == 0 ? 1 : 2);
#pragma unroll 1
          for (int i0 = 0; i0 < EPT; i0 += BT) {
            float2 ye[BT], zz[BT]; float ga[BT][3], gb[BT][3];
#pragma unroll
            for (int k = 0; k < BT; ++k) {
              const int e = tid + NTHR * (i0 + k); const int f = e >> LOGN, n = e & (L - 1); const int pp = sub * NB + f;
              ye[k] = scrY[(size_t)pp * L + n]; zz[k] = scrZ[(size_t)pp * L + n];
              loadu3(2 * pp, gsel * 512 + c, n, ga[k]); loadu3(2 * pp + 1, gsel * 512 + c, n, gb[k]);
            }
#pragma unroll
            for (int k = 0; k < BT; ++k) {
              const int e = tid + NTHR * (i0 + k); const int f = e >> LOGN, n = e & (L - 1); const int pp = sub * NB + f;
              float2 y = buf[PADI(e)];
              const float rev = -(float)n / (float)(2 * L);
              y = cmulc(y, make_float2(cos_rev(rev), sin_rev(rev)));
              const float sc = 0.5f / (float)L;
              const float c0 = (ye[k].x + y.x) * sc + sk * zz[k].x;
              const float c1 = (ye[k].y + y.y) * sc + sk * zz[k].y;
              const float z0 = convw(gsel, ga[k]) * c0;
              const float z1 = convw(gsel, gb[k]) * c1;
              if (o == 0) scrZ[(size_t)pp * L + n] = make_float2(z0, z1);
              else {
                OBt[chm_index(512, row_base + (2 * pp) * L, c) + n] = f2bf(z0);
                OBt[chm_index(512, row_base + (2 * pp + 1) * L, c) + n] = f2bf(z1);
              }
            }
          }
        }
        __syncthreads();
      }
    }
  }
}

struct WMat { const float* src; int K; int N; const float* gain; bf16_t* dst; };
DI WMat get_wmat(const Params& p, int id) {
  bf16_t* W = (bf16_t*)(p.ws + WS_W);
  WMat m;
  switch (id) {
    case 0: m = {p.in[9], 1024, 3072, p.in[5], W + W_INE}; break;
    case 1: m = {p.in[23], 1024, 1024, nullptr, W + W_OUTE}; break;
    case 2: m = {p.in[24], 1024, 2304, p.in[5] + 1024, W + W_INO}; break;
    case 3: m = {p.in[31], 1024, 1024, nullptr, W + W_OUTO}; break;
    case 4: m = {p.in[32], 1024, 256, p.in[6], W + W_Q}; break;
    case 5: m = {p.in[32] + 1024 * 256, 1024, 256, p.in[6] + 1024, W + W_Q + 256 * 1024}; break;
    case 6: m = {p.in[33], 1024, 512, p.in[7], W + W_KV}; break;
    case 7: m = {p.in[33] + 1024 * 512, 1024, 512, p.in[7] + 1024, W + W_KV + 512 * 1024}; break;
    case 8: m = {p.in[34], 256, 1024, nullptr, W + W_O}; break;
    case 9: m = {p.in[34] + 256 * 1024, 256, 1024, nullptr, W + W_O + 1024 * 256}; break;
    case 10: m = {p.in[37], 1024, 4096, p.in[8], W + W_1}; break;
    case 11: m = {p.in[37] + (size_t)1024 * 4096, 1024, 4096, p.in[8] + 1024, W + W_1 + (size_t)4096 * 1024}; break;
    case 12: m = {p.in[38], 4096, 1024, nullptr, W + W_2}; break;
    default: m = {p.in[38] + (size_t)4096 * 1024, 4096, 1024, nullptr, W + W_2 + (size_t)4096 * 1024}; break;
  }
  return m;
}

DI void prep_wtile(char* smem, const WMat& m, int tile) {
  float* t = (float*)smem;
  const int ntn = m.N >> 6;
  const int k0 = (tile / ntn) << 6, n0 = (tile % ntn) << 6;
  const int tid = threadIdx.x;
  __syncthreads();
  {
    const int kk = tid >> 4, n4 = (tid & 15) * 4;
#pragma unroll
    for (int i = 0; i < 2; ++i) {
      const int k = kk + 32 * i;
      float4 v = *(const float4*)(m.src + (size_t)(k0 + k) * m.N + n0 + n4);
      const float gk = m.gain ? m.gain[k0 + k] : 1.0f;
      t[k * 65 + n4] = v.x * gk; t[k * 65 + n4 + 1] = v.y * gk; t[k * 65 + n4 + 2] = v.z * gk; t[k * 65 + n4 + 3] = v.w * gk;
    }
  }
  __syncthreads();
  {
    const int n = tid >> 3, kc = tid & 7;
    uint4 u;
    u.x = pack2(t[(8 * kc) * 65 + n], t[(8 * kc + 1) * 65 + n]); u.y = pack2(t[(8 * kc + 2) * 65 + n], t[(8 * kc + 3) * 65 + n]);
    u.z = pack2(t[(8 * kc + 4) * 65 + n], t[(8 * kc + 5) * 65 + n]); u.w = pack2(t[(8 * kc + 6) * 65 + n], t[(8 * kc + 7) * 65 + n]);
    *(uint4*)(m.dst + (size_t)(n0 + n) * m.K + k0 + 8 * kc) = u;
  }
}

DI void prep_row(const float* src, bf16_t* dst, float* ssq) {
  const int lane = threadIdx.x & 63;
  float ss = 0.f;
#pragma unroll
  for (int i = 0; i < 4; ++i) {
    float4 v = *(const float4*)(src + (i * 64 + lane) * 4);
    ss += v.x * v.x + v.y * v.y + v.z * v.z + v.w * v.w;
    uint2 u; u.x = pack2(v.x, v.y); u.y = pack2(v.z, v.w);
    *(uint2*)(dst + (i * 64 + lane) * 4) = u;
  }
#pragma unroll
  for (int s = 32; s >= 1; s >>= 1) ss += __shfl_xor(ss, s);
  if (lane == 0) *ssq = ss;
}

DI void prep_h2(const Params& p, int L, int t, bf16_t* dst) {
  const int j = threadIdx.x & 63;
  const float* w1 = p.in[16]; const float* b1 = p.in[17]; const float* fr = p.in[18]; const float* w2 = p.in[19]; const float* b2 = p.in[20];
  const float t01 = (float)t / (float)(L - 1);
  const float tl = (float)t / (float)L;
  float a = t01 * w1[j] + b1[j];
#pragma unroll
  for (int k = 0; k < 8; ++k) {
    const float fk = 1e-4f + (float)k * ((7.0f - 1e-4f) / 7.0f);
    const float rev = tl * fk;
    a += cos_rev(rev) * w1[(1 + k) * 64 + j] - sin_rev(rev) * w1[(9 + k) * 64 + j];
  }
  const float h1 = sin_rev(fr[j] * a * 0.15915494309189535f);
  float a2 = b2[j];
  for (int i = 0; i < 64; ++i) a2 += __shfl(h1, i) * w2[i * 64 + j];
  dst[(size_t)j * L + t] = f2bf(sin_rev(fr[64 + j] * a2 * 0.15915494309189535f));
}

constexpr int PREP_NW = 768 + 256 + 576 + 256 + 64 + 64 + 128 + 128 + 64 + 64 + 1024 + 1024 + 1024 + 1024;
constexpr int PREP_T_ROWS = PREP_NW;
constexpr int PREP_T_MEM = PREP_T_ROWS + 8192;
constexpr int PREP_T_H2 = PREP_T_MEM + 576;
constexpr int PREP_T_MISC = PREP_T_H2 + 2304;
constexpr int PREP_TOTAL = PREP_T_MISC + 1;

DI void phase_prep(char* smem, const Params& p) {
  const int tid = threadIdx.x, wave = tid >> 6;
#pragma unroll 1
  for (int task = blockIdx.x; task < PREP_TOTAL; task += gridDim.x) {
    if (task < PREP_NW) {
      int t = task, id = 0;
      for (; id < 14; ++id) { WMat m = get_wmat(p, id); int n = (m.K >> 6) * (m.N >> 6); if (t < n) break; t -= n; }
      WMat m = get_wmat(p, id);
      prep_wtile(smem, m, t);
    } else if (task < PREP_T_MEM) {
      const int row = (task - PREP_T_ROWS) * 8 + wave;
      const float* src = (row < T_P) ? p.in[0] + (size_t)row * DM : p.in[1] + (size_t)(row - T_P) * DM;
      float* RS = (float*)(p.ws + WS_MISC + MS_RS);
      prep_row(src, (bf16_t*)(p.ws + WS_XB) + (size_t)row * DM, RS + row);
      if ((tid & 63) < 5) RS[(size_t)(1 + (tid & 63)) * T_ALL + row] = 0.f;
    } else if (task < PREP_T_H2) {
      const int row = (task - PREP_T_MEM) * 8 + wave;
      const float* src = (row < 512) ? p.in[2] + (size_t)row * DM : p.in[3] + (size_t)(row - 512) * DM;
      prep_row(src, (bf16_t*)(p.ws + WS_R1) + (size_t)row * DM, (float*)(p.ws + WS_MISC + MS_RSM) + row);
    } else if (task < PREP_T_MISC) {
      const int t = (task - PREP_T_H2) * 8 + wave;
      if (t < LP) prep_h2(p, LP, t, (bf16_t*)(p.ws + WS_MISC + MS_H2P));
      else prep_h2(p, LS, t - LP, (bf16_t*)(p.ws + WS_MISC + MS_H2S));
    } else {
      float* lut = (float*)(p.ws + WS_MISC + MS_LUT);
      for (int i = tid; i < 8 * 257; i += NTHR) {
        const int hh = i / 257, rel = (i % 257) - 128;
        const int n = rel < 0 ? -rel : rel;
        int bkt;
        if (n < 8) bkt = n; else { bkt = 2 + (31 - __clz(n * n)); if (bkt > 15) bkt = 15; }
        if (rel > 0) bkt += 16;
        lut[i] = p.in[4][bkt * 8 + hh] * LOG2E;
      }
      if (tid < 64) {
        const float* lf = p.in[12];
        float a = lf[tid] * lf[64 + tid], b = lf[128 + tid] * lf[192 + tid];
#pragma unroll
        for (int s = 32; s >= 1; s >>= 1) { a += __shfl_xor(a, s); b += __shfl_xor(b, s); }
        if (tid == 0) *(float*)(p.ws + WS_MISC + MS_LAM) = expf(a) - expf(b) + 0.2f;
      }
    }
  }
}

DI Seg seg_inproj(const Params& p, int layer, int col0, const float* rs) {
  Seg s{}; s.rs = rs; s.scale = 1.0f;
  if (layer == 0) {
    if (col0 < 512) { s.type = SEG_NORM; s.dst = (bf16_t*)(p.ws + WS_R0); s.ld = 512; s.col = col0; s.gain = p.in[10]; s.scale = QSCALE; }
    else if (col0 < 1024) { s.type = SEG_NORM; s.dst = (bf16_t*)((char*)p.out + 192 * MiB); s.ld = 512; s.col = col0 - 512; s.gain = p.in[11]; }
    else if (col0 < 1536) { s.type = SEG_CHM; s.dst = (bf16_t*)(p.ws + WS_R2); s.CH = 512; s.col = col0 - 1024; }
    else { s.type = SEG_CHM; s.dst = (bf16_t*)p.out; s.CH = 1536; s.col = col0 - 1536; }
  } else {
    if (col0 < 512) { s.type = SEG_NORM; s.dst = (bf16_t*)(p.ws + WS_R0); s.ld = 512; s.col = col0; s.gain = p.in[25]; s.scale = QSCALE; }
    else if (col0 < 1024) { s.type = SEG_NORM; s.dst = (bf16_t*)(p.ws + WS_R1); s.ld = 512; s.col = col0 - 512; s.gain = p.in[26]; }
    else if (col0 < 1536) { s.type = SEG_CHM; s.dst = (bf16_t*)(p.ws + WS_R2); s.CH = 512; s.col = col0 - 1024; }
    else if (col0 < 2048) { s.type = SEG_NORM; s.dst = (bf16_t*)(p.ws + WS_R3); s.ld = 512; s.col = col0 - 1536; s.gain = p.in[28]; s.scale = QSCALE; }
    else if (col0 < 2176) { s.type = SEG_NORM; s.dst = (bf16_t*)(p.ws + WS_KD); s.ld = 128; s.col = col0 - 2048; s.gain = p.in[29]; }
    else { s.type = SEG_CHM; s.dst = (bf16_t*)(p.ws + WS_VDT); s.CH = 128; s.col = col0 - 2176; }
  }
  return s;
}

DI void phase_inproj(char* smem, const Params& p, int layer) {
  const int NTn = layer == 0 ? 12 : 9;
  const int n_main = 256 * NTn;
  const int n_total = n_main + (layer == 0 ? 72 : 0);
  const bf16_t* W = (const bf16_t*)(p.ws + WS_W);
  const int wc = (threadIdx.x >> 6) & 3;
#pragma unroll 1
  for (int tile = blockIdx.x; tile < n_total; tile += gridDim.x) {
    if (tile < n_main) {
      const int mt = tile / NTn, nt = tile % NTn;
      GemmArgs ga{(const bf16_t*)(p.ws + WS_XB), nullptr, 1 << 30, DM, W + (layer == 0 ? W_INE : W_INO), DM, DM};
      Seg s = seg_inproj(p, layer, nt * 256 + 64 * wc, (const float*)(p.ws + WS_MISC + MS_RS) + (size_t)(layer * 3) * T_ALL);
      gemm_tile(smem, ga, mt * 256, nt * 256, s);
    } else {
      const int t2 = tile - n_main; const int l = t2 / 36, r = t2 % 36; const int mt = r >> 1, nt = r & 1;
      GemmArgs ga{(const bf16_t*)(p.ws + WS_R1), nullptr, 1 << 30, DM, W + W_KV + (size_t)l * 512 * 1024, DM, DM};
      Seg s{}; s.rs = (const float*)(p.ws + WS_MISC + MS_RSM); s.scale = 1.0f;
      const int col0 = nt * 256 + 64 * wc;
      if (col0 < 256) { s.type = SEG_NORM; s.dst = (bf16_t*)(p.ws + WS_MISC + MS_MK) + (size_t)l * 18 * 256 * 256; s.ld = 256; s.col = col0; s.gain = p.in[36] + l * 64; }
      else { s.type = SEG_CHMEM; s.dst = (bf16_t*)(p.ws + WS_MISC + MS_MVT) + (size_t)l * 18 * 256 * 256; s.col = col0 - 256; }
      gemm_tile(smem, ga, mt * 256, nt * 256, s);
    }
  }
}

DI void phase_mixer0(char* smem, const Params& p) {
#pragma unroll 1
  for (int item = blockIdx.x; item < 2048; item += gridDim.x) {
    const int kind = item >> 9, idx = item & 511;
#ifndef SUBP
#define SUBP -1
#endif
    if (kind == 0 || kind == 2) {
      if (PROBE & 4) diff_item(smem, p, (kind == 2 ? 512 : 0) + idx, true);
      diff_item(smem, p, (kind == 2 ? 512 : 0) + idx);
    } else if (kind == 1) {
      if (PROBE & 8) hyena_item<14, 1, 1>(smem, p, idx, 0);
      hyena_item<14, 1, 1>(smem, p, idx, 0);
    } else {
      if (PROBE & 8) hyena_item<11, 4, 2>(smem, p, idx, T_P);
      hyena_item<11, 4, 2>(smem, p, idx, T_P);
    }
  }
}
DI void phase_mixer1(char* smem, const Params& p) {
#pragma unroll 1
  for (int item = blockIdx.x; item < 4096; item += gridDim.x) {
    if (PROBE & 16) { if (item < 2048) na_item(smem, p, item, true); else wg_item(smem, p, item - 2048, true); }
    if (item < 2048) na_item(smem, p, item); else wg_item(smem, p, item - 2048);
  }
}

DI void phase_post(char* smem, const Params& p, int layer) {
  const bf16_t* W = (const bf16_t*)(p.ws + WS_W);
  float* RS = (float*)(p.ws + WS_MISC + MS_RS);
  bf16_t* XB = (bf16_t*)(p.ws + WS_XB);
  bf16_t* H = (bf16_t*)(p.ws + (layer == 0 ? WS_H_L0 : WS_H_L1));
  bf16_t* QM = (bf16_t*)(p.ws + WS_QM);
  const int wn = (threadIdx.x >> 6) & 1;
#pragma unroll 1
  for (int mt = blockIdx.x; mt < 256; mt += gridDim.x) {
    const int m0 = mt * 256;
    if (layer == 0) {
      const bf16_t* OBt = (const bf16_t*)(p.ws + WS_R3);
      bf16_t* OB = (bf16_t*)(p.ws + WS_R1);
      const int tid = threadIdx.x;
#pragma unroll 1
      for (int chunk = 0; chunk < 4; ++chunk) {
        __syncthreads();
        {
          const int c = tid >> 2, part = tid & 3;
          const uint4* src = (const uint4*)(OBt + chm_index(512, m0, chunk * 128 + c) + part * 64);
#pragma unroll
          for (int i = 0; i < 8; ++i) *(uint4*)(smem + c * 528 + part * 128 + i * 16) = src[i];
        }
        __syncthreads();
#pragma unroll 2
        for (int it = 0; it < 8; ++it) {
          const int item = it * NTHR + tid; const int t = item & 255, c8 = item >> 8;
          unsigned short v[8];
#pragma unroll
          for (int j = 0; j < 8; ++j) v[j] = *(const unsigned short*)(smem + (c8 * 8 + j) * 528 + t * 2);
          uint4 u; u.x = v[0] | ((unsigned)v[1] << 16); u.y = v[2] | ((unsigned)v[3] << 16); u.z = v[4] | ((unsigned)v[5] << 16); u.w = v[6] | ((unsigned)v[7] << 16);
          *(uint4*)(OB + (size_t)(m0 + t) * 512 + chunk * 128 + c8 * 8) = u;
        }
      }
      __syncthreads();
    }
#ifndef CHAINP
#define CHAINP -1
#endif
    if (CHAINP < 0 || CHAINP == 1) {
      GemmArgs ga{(const bf16_t*)(p.ws + WS_R0), (const bf16_t*)(p.ws + (layer == 0 ? WS_R1 : WS_R3)), 512, 512, W + (layer == 0 ? W_OUTE : W_OUTO), DM, DM};
      Seg s{}; s.type = SEG_RESID; s.xin0 = layer == 0 ? p.in[0] : nullptr; s.xin1 = layer == 0 ? p.in[1] : nullptr;
      s.xout = p.out; s.xb = XB; s.rs_out = RS + (size_t)(layer * 3 + 1) * T_ALL;
      _Pragma("unroll 1") for (int nt = 0; nt < 4; ++nt) { s.col = nt * 256; gemm_tile(smem, ga, m0, nt * 256, s); }
    }
    block_sync_global();
    if (CHAINP < 0 || CHAINP == 2) {
      GemmArgs ga{XB, nullptr, 1 << 30, DM, W + W_Q + (size_t)layer * 256 * 1024, DM, DM};
      Seg s{}; s.type = SEG_NORM; s.rs = RS + (size_t)(layer * 3 + 1) * T_ALL; s.dst = QM; s.ld = 256; s.gain = p.in[35] + layer * 64; s.scale = QSCALE;
      s.col = 64 * ((threadIdx.x >> 6) & 3);
      gemm_tile(smem, ga, m0, 0, s);
    }
    block_sync_global();
    if (CHAINP < 0 || CHAINP == 3) mem_attn_tile(smem, p, layer, m0);
    block_sync_global();
    if (CHAINP < 0 || CHAINP == 4) {
      GemmArgs ga{QM, nullptr, 1 << 30, 256, W + W_O + (size_t)layer * 1024 * 256, 256, 256};
      Seg s{}; s.type = SEG_RESID; s.xout = p.out; s.xb = XB; s.rs_out = RS + (size_t)(layer * 3 + 2) * T_ALL;
      _Pragma("unroll 1") for (int nt = 0; nt < 4; ++nt) { s.col = nt * 256; gemm_tile(smem, ga, m0, nt * 256, s); }
    }
    block_sync_global();
    if (CHAINP < 0 || CHAINP == 5) _Pragma("unroll 1") for (int hc = 0; hc < 4; ++hc) {
      {
        GemmArgs ga{XB, nullptr, 1 << 30, DM, W + W_1 + (size_t)layer * 4096 * 1024 + (size_t)hc * 1024 * 1024, DM, DM};
        Seg s{}; s.type = SEG_MLP1; s.rs = RS + (size_t)(layer * 3 + 2) * T_ALL; s.dst = H; s.ld = 1024;
        _Pragma("unroll 1") for (int nt = 0; nt < 4; ++nt) { s.col = nt * 256; gemm_tile(smem, ga, m0, nt * 256, s); }
      }
      block_sync_global();
      {
        GemmArgs ga{H, nullptr, 1 << 30, 1024, W + W_2 + (size_t)layer * 4096 * 1024 + (size_t)hc * 1024, 4096, 1024};
        Seg s{}; s.type = SEG_RESID; s.xout = p.out;
        if (hc == 3 && layer == 0) { s.xb = XB; s.rs_out = RS + (size_t)3 * T_ALL; }
        _Pragma("unroll 1") for (int nt = 0; nt < 4; ++nt) { s.col = nt * 256; gemm_tile(smem, ga, m0, nt * 256, s); }
      }
      block_sync_global();
    }
  }
  (void)wn;
}

__global__ void __launch_bounds__(NTHR) fwd_kernel(Params p, int ph_lo, int ph_hi) {
  extern __shared__ __attribute__((aligned(16))) char smem[];
#define RUN_PHASE(i_, call_) if (ph_lo <= (i_) && (i_) <= ph_hi) { if ((i_) > ph_lo) { __threadfence(); cg::this_grid().sync(); } call_; }
  RUN_PHASE(0, phase_prep(smem, p))
  if (PROBE & 1) { __syncthreads(); phase_prep(smem, p); }
  RUN_PHASE(1, phase_inproj(smem, p, 0))
  if (PROBE & 2) { __syncthreads(); phase_inproj(smem, p, 0); }
  RUN_PHASE(2, phase_mixer0(smem, p))
  RUN_PHASE(3, phase_post(smem, p, 0))
  RUN_PHASE(4, phase_inproj(smem, p, 1))
  if (PROBE & 2) { __syncthreads(); phase_inproj(smem, p, 1); }
  RUN_PHASE(5, phase_mixer1(smem, p))
  RUN_PHASE(6, phase_post(smem, p, 1))
}

#ifndef ONE_LAUNCH
#define ONE_LAUNCH 1
#endif

extern "C" void kernel_launch(void* const* d_in, const int* in_sizes, int n_in, void* d_out, int out_size, void* d_ws, size_t ws_size,
                              hipStream_t stream) {
  static int grid = 0;
  if (grid == 0) {
    if (n_in != 39 || ws_size < WS_NEED || out_size != T_ALL * DM) { fprintf(stderr, "kernel_launch: unexpected shapes n_in %d ws %zu out %d\n", n_in, ws_size, out_size); grid = -1; return; }
    if (hipFuncSetAttribute((const void*)fwd_kernel, hipFuncAttributeMaxDynamicSharedMemorySize, SMEM_BYTES) != hipSuccess) { fprintf(stderr, "hipFuncSetAttribute failed\n"); grid = -1; return; }
    int dev = 0, cus = 0, per_cu = 0;
    hipGetDevice(&dev);
    hipDeviceGetAttribute(&cus, hipDeviceAttributeMultiprocessorCount, dev);
    hipOccupancyMaxActiveBlocksPerMultiprocessor(&per_cu, (const void*)fwd_kernel, NTHR, SMEM_BYTES);
    if (per_cu < 1 || cus < 1) { fprintf(stderr, "occupancy query: %d blocks/CU, %d CUs\n", per_cu, cus); grid = -1; return; }
    grid = cus;
  }
  if (grid < 0) return;
  Params p{};
  for (int i = 0; i < 39; ++i) p.in[i] = (const float*)d_in[i];
  p.out = (float*)d_out; p.ws = (char*)d_ws;
#if ONE_LAUNCH
  int lo = 0, hi = 6;
  void* args[] = {&p, &lo, &hi};
  hipError_t e = hipLaunchCooperativeKernel((const void*)fwd_kernel, dim3(grid), dim3(NTHR), args, SMEM_BYTES, stream);
  if (e != hipSuccess) fprintf(stderr, "cooperative launch failed: %s\n", hipGetErrorString(e));
#else
  for (int ph = 0; ph <= 6; ++ph) hipLaunchKernelGGL(fwd_kernel, dim3(grid), dim3(NTHR), SMEM_BYTES, stream, p, ph, ph);
#endif
}
```

```cpp
#include <hip/hip_runtime.h>
#include <hip/hip_cooperative_groups.h>
#include <cstdio>
namespace cg = cooperative_groups;

#define DI __device__ __forceinline__
#define PROBE 0
typedef unsigned short bf16_t;
using bf16x8 = __attribute__((ext_vector_type(8))) short;
using s16x4 = __attribute__((ext_vector_type(4))) short;
using f32x4 = __attribute__((ext_vector_type(4))) float;
#define MFMA16(a, b, c) __builtin_amdgcn_mfma_f32_16x16x32_bf16((a), (b), (c), 0, 0, 0)

constexpr int NTHR = 512;
constexpr int T_ALL = 65536;
constexpr int T_P = 32768;
constexpr int LP = 16384, LS = 2048;
constexpr int DM = 1024;
constexpr float EPS = 1e-6f;
constexpr float LOG2E = 1.4426950408889634f;
constexpr float QSCALE = 0.125f * 1.4426950408889634f;
constexpr int SMEM_BYTES = 144 * 1024;
constexpr size_t MiB = (size_t)1 << 20;

constexpr size_t WS_XB = 0;
constexpr size_t WS_W = 128 * MiB;
constexpr size_t W_INE = 0;
constexpr size_t W_OUTE = W_INE + (size_t)3072 * 1024;
constexpr size_t W_INO = W_OUTE + (size_t)1024 * 1024;
constexpr size_t W_OUTO = W_INO + (size_t)2304 * 1024;
constexpr size_t W_Q = W_OUTO + (size_t)1024 * 1024;
constexpr size_t W_KV = W_Q + (size_t)2 * 256 * 1024;
constexpr size_t W_O = W_KV + (size_t)2 * 512 * 1024;
constexpr size_t W_1 = W_O + (size_t)2 * 1024 * 256;
constexpr size_t W_2 = W_1 + (size_t)2 * 4096 * 1024;
constexpr size_t W_END = W_2 + (size_t)2 * 4096 * 1024;
static_assert(W_END * 2 <= 51 * MiB, "weights");
constexpr size_t WS_MISC = 179 * MiB;
constexpr size_t MS_RS = 0;
constexpr size_t MS_RSM = MS_RS + (size_t)6 * T_ALL * 4;
constexpr size_t MS_MK = MS_RSM + 32768;
constexpr size_t MS_MVT = MS_MK + (size_t)2 * 18 * 256 * 256 * 2;
constexpr size_t MS_H2P = MS_MVT + (size_t)2 * 18 * 256 * 256 * 2;
constexpr size_t MS_H2S = MS_H2P + (size_t)LP * 64 * 4;
constexpr size_t MS_LUT = MS_H2S + (size_t)LS * 64 * 4;
constexpr size_t MS_LAM = MS_LUT + 16384;
constexpr size_t MS_END = MS_LAM + 256;
static_assert(MS_END <= 16 * MiB, "misc");
constexpr size_t WS_R0 = 195 * MiB;
constexpr size_t WS_R1 = 259 * MiB;
constexpr size_t WS_R2 = 323 * MiB;
constexpr size_t WS_R3 = 387 * MiB;
constexpr size_t WS_KD = 451 * MiB;
constexpr size_t WS_VDT = 467 * MiB;
constexpr size_t WS_QM = 451 * MiB;
constexpr size_t WS_H_L0 = 323 * MiB;
constexpr size_t WS_H_L1 = 259 * MiB;
constexpr size_t WS_NEED = 512 * MiB;
constexpr size_t HY_SCR_PER_BLOCK = 512 * 1024;

struct Params {
  const float* in[39];
  float* out;
  char* ws;
};

DI unsigned short f2bf(float x) { unsigned u = __float_as_uint(x); u += 0x7fffu + ((u >> 16) & 1u); return (unsigned short)(u >> 16); }
typedef __bf16 bf16v2_t __attribute__((ext_vector_type(2)));
typedef float f32v2_t __attribute__((ext_vector_type(2)));
DI unsigned pack2(float a, float b) { f32v2_t f = {a, b}; bf16v2_t h = __builtin_convertvector(f, bf16v2_t); return __builtin_bit_cast(unsigned, h); }
DI float bf2f(unsigned short h) { return __uint_as_float(((unsigned)h) << 16); }
DI float ex2(float x) { return __builtin_amdgcn_exp2f(x); }
DI float sin_rev(float r) { return __builtin_amdgcn_sinf(r); }
DI float cos_rev(float r) { return __builtin_amdgcn_cosf(r); }
DI int opaque(int x) { asm volatile("" : "+v"(x)); return x; }
DI float dpp_f(float v, int ctrl_sel) {
  int x = __float_as_int(v), r;
  if (ctrl_sel == 0) r = __builtin_amdgcn_update_dpp(x, x, 0xB1, 0xF, 0xF, false);
  else if (ctrl_sel == 1) r = __builtin_amdgcn_update_dpp(x, x, 0x4E, 0xF, 0xF, false);
  else if (ctrl_sel == 2) r = __builtin_amdgcn_update_dpp(x, x, 0x141, 0xF, 0xF, false);
  else r = __builtin_amdgcn_update_dpp(x, x, 0x140, 0xF, 0xF, false);
  return __int_as_float(r);
}
DI float row16_sum(float v) { v += dpp_f(v, 0); v += dpp_f(v, 1); v += dpp_f(v, 2); v += dpp_f(v, 3); return v; }
DI void block_sync_global() { __syncthreads(); }

DI size_t chm_index(int CH, int row, int ch) {
  if (row < T_P) { int b = row >> 14, t = row & (LP - 1); return ((size_t)(b * CH + ch) << 14) + t; }
  int r = row - T_P; int b = r >> 11, t = r & (LS - 1);
  return (size_t)T_P * CH + ((size_t)(b * CH + ch) << 11) + t;
}

struct GemmArgs {
  const bf16_t* A0; const bf16_t* A1; int ksplit; int lda;
  const bf16_t* Wt; int ldw; int K;
};
enum { SEG_NORM = 0, SEG_CHM = 1, SEG_CHMEM = 2, SEG_RESID = 3, SEG_MLP1 = 4 };
struct Seg {
  int type;
  bf16_t* dst; int ld; int col;
  const float* gain; float scale;
  int CH;
  const float* rs;
  const float* xin0; const float* xin1; float* xout; bf16_t* xb; float* rs_out;
};
constexpr int G_TILE_B = 256 * 64 * 2, G_STAGE_B = 2 * G_TILE_B;
DI int g_lds_byte(int r, int c) { int st = (r >> 4) * 2 + (c >> 5), ob = (r & 15) * 64 + (c & 31) * 2; return st * 1024 + (ob ^ (((ob >> 9) & 1) << 5)); }
DI void g_stage_rc(int b, int& R, int& C) { int st = b >> 10, sb = b & 1023, swz = sb ^ (((sb >> 9) & 1) << 5); R = (st >> 1) * 16 + swz / 64; C = (st & 1) * 32 + (swz % 64) / 2; }
#define WAIT_V0() asm volatile("s_waitcnt vmcnt(0)" ::: "memory")

DI void gemm_tile(char* smem_generic, const GemmArgs& ga, int m0, int n0, const Seg& sg) {
  extern __shared__ __attribute__((aligned(16))) char shm[];
  (void)smem_generic;
  const int tid = opaque((int)threadIdx.x), lane = tid & 63, wid = tid >> 6;
  const int l16 = lane & 15, g = lane >> 4;
  const int wr = wid >> 2, wc = wid & 3;
  int sR[4], sC[4];
#pragma unroll
  for (int i = 0; i < 4; ++i) g_stage_rc(wid * 1024 + i * 8192 + lane * 16, sR[i], sC[i]);
  const int KT = ga.K >> 6;
#define G_STAGE(buf_, kt_) do { const int k0_ = (kt_) << 6; \
    const bf16_t* Ab_ = (k0_ < ga.ksplit) ? ga.A0 + k0_ : ga.A1 + (k0_ - ga.ksplit); \
    _Pragma("unroll") for (int i = 0; i < 4; ++i) { \
      __builtin_amdgcn_global_load_lds((const unsigned*)(Ab_ + (size_t)(m0 + sR[i]) * ga.lda + sC[i]), (__attribute__((address_space(3))) unsigned*)(shm + (buf_) * G_STAGE_B + wid * 1024 + i * 8192), 16, 0, 0); \
      __builtin_amdgcn_global_load_lds((const unsigned*)(ga.Wt + (size_t)(n0 + sR[i]) * ga.ldw + k0_ + sC[i]), (__attribute__((address_space(3))) unsigned*)(shm + (buf_) * G_STAGE_B + G_TILE_B + wid * 1024 + i * 8192), 16, 0, 0); } } while (0)
  f32x4 acc[8][4];
#pragma unroll
  for (int i = 0; i < 8; ++i)
#pragma unroll
    for (int j = 0; j < 4; ++j) acc[i][j] = (f32x4){0.f, 0.f, 0.f, 0.f};
  float* rs_lds = (float*)(shm + 143360);
  G_STAGE(0, 0);
  if (sg.rs && tid < 256) rs_lds[tid] = rsqrtf(sg.rs[m0 + tid] * (1.0f / 1024.0f) + EPS);
  WAIT_V0(); __syncthreads();
#pragma unroll 1
  for (int t = 0; t < KT; ++t) {
    const int cur = t & 1;
    if (t + 1 < KT) G_STAGE(cur ^ 1, t + 1);
    const char* SAp = shm + cur * G_STAGE_B; const char* SBp = SAp + G_TILE_B;
#pragma unroll
    for (int ks = 0; ks < 2; ++ks) {
      bf16x8 At[8], Bf[4];
#pragma unroll
      for (int m = 0; m < 8; ++m) At[m] = *(const bf16x8*)(SAp + g_lds_byte(wr * 128 + m * 16 + l16, ks * 32 + g * 8));
#pragma unroll
      for (int n = 0; n < 4; ++n) Bf[n] = *(const bf16x8*)(SBp + g_lds_byte(wc * 64 + n * 16 + l16, ks * 32 + g * 8));
#pragma unroll
      for (int m = 0; m < 8; ++m)
#pragma unroll
        for (int n = 0; n < 4; ++n) acc[m][n] = MFMA16(At[m], Bf[n], acc[m][n]);
      __builtin_amdgcn_sched_barrier(0);
    }
    WAIT_V0(); __syncthreads();
  }
  const int rbase = m0 + 128 * wr + 4 * g;
  if (sg.rs) {
#pragma unroll
    for (int m = 0; m < 8; ++m)
#pragma unroll
      for (int r = 0; r < 4; ++r) {
        const float sc = rs_lds[128 * wr + 4 * g + 16 * m + r];
#pragma unroll
        for (int n = 0; n < 4; ++n) acc[m][n][r] *= sc;
      }
  }
  if (sg.type == SEG_NORM) {
    float gn[4];
#pragma unroll
    for (int n = 0; n < 4; ++n) gn[n] = sg.gain[16 * n + l16] * sg.scale;
#pragma unroll
    for (int m = 0; m < 8; ++m) {
#pragma unroll
      for (int r = 0; r < 4; ++r) {
        float ss = 0.f;
#pragma unroll
        for (int n = 0; n < 4; ++n) ss += acc[m][n][r] * acc[m][n][r];
        ss = row16_sum(ss);
        const float sc = rsqrtf(ss * (1.0f / 64.0f) + EPS);
        bf16_t* d = sg.dst + (size_t)(rbase + 16 * m + r) * sg.ld + sg.col + l16;
#pragma unroll
        for (int n = 0; n < 4; ++n) d[16 * n] = f2bf(acc[m][n][r] * sc * gn[n]);
      }
      __builtin_amdgcn_sched_barrier(0);
    }
  } else if (sg.type == SEG_CHM || sg.type == SEG_CHMEM) {
#pragma unroll
    for (int m = 0; m < 8; ++m) {
#pragma unroll
      for (int n = 0; n < 4; ++n) {
        const int row = rbase + 16 * m; const int ch = sg.col + l16 + 16 * n;
        size_t off;
        if (sg.type == SEG_CHM) off = chm_index(sg.CH, row, ch);
        else off = ((size_t)((row >> 8) * 256 + ch) << 8) + (row & 255);
        uint2 v; v.x = pack2(acc[m][n][0], acc[m][n][1]); v.y = pack2(acc[m][n][2], acc[m][n][3]);
        *(uint2*)(sg.dst + off) = v;
      }
      __builtin_amdgcn_sched_barrier(0);
    }
  } else {
    float* Cs = (float*)shm;
    const int rr = tid >> 5, c4 = (tid & 31) * 4;
#pragma unroll 1
    for (int half = 0; half < 2; ++half) {
      if ((wc >> 1) == half) {
#pragma unroll
        for (int m = 0; m < 8; ++m)
#pragma unroll
          for (int n = 0; n < 4; ++n)
#pragma unroll
            for (int r = 0; r < 4; ++r) Cs[(128 * wr + 16 * m + 4 * g + r) * 132 + 64 * (wc & 1) + 16 * n + l16] = acc[m][n][r];
      }
      __syncthreads();
      const int cg = sg.col + 128 * half + c4;
      if (sg.type == SEG_MLP1) {
#pragma unroll 4
        for (int it = 0; it < 16; ++it) {
          const int lr = it * 16 + rr; const int row = m0 + lr;
          f32x4 v = *(const f32x4*)(Cs + lr * 132 + c4);
          v[0] = fmaxf(v[0], 0.f); v[1] = fmaxf(v[1], 0.f); v[2] = fmaxf(v[2], 0.f); v[3] = fmaxf(v[3], 0.f);
          uint2 u; u.x = pack2(v[0] * v[0], v[1] * v[1]); u.y = pack2(v[2] * v[2], v[3] * v[3]);
          *(uint2*)(sg.dst + (size_t)row * sg.ld + cg) = u;
        }
      } else {
#pragma unroll 1
        for (int it0 = 0; it0 < 16; it0 += 8) {
          f32x4 xv[8];
#pragma unroll
          for (int k = 0; k < 8; ++k) {
            const int row = m0 + (it0 + k) * 16 + rr;
            const float* xo;
            if (sg.xin0) xo = (row < T_P) ? sg.xin0 + (size_t)row * DM : sg.xin1 + (size_t)(row - T_P) * DM;
            else xo = sg.xout + (size_t)row * DM;
            xv[k] = *(const f32x4*)(xo + cg);
          }
#pragma unroll
          for (int k = 0; k < 8; ++k) {
            const int lr = (it0 + k) * 16 + rr; const int row = m0 + lr;
            f32x4 v = *(const f32x4*)(Cs + lr * 132 + c4);
            v += xv[k];
            *(f32x4*)(sg.xout + (size_t)row * DM + cg) = v;
            if (sg.xb) { uint2 u; u.x = pack2(v[0], v[1]); u.y = pack2(v[2], v[3]); *(uint2*)(sg.xb + (size_t)row * DM + cg) = u; }
            if (sg.rs_out) {
              float ss = v[0] * v[0] + v[1] * v[1] + v[2] * v[2] + v[3] * v[3];
              ss = row16_sum(ss); ss += __shfl_xor(ss, 16);
              if ((tid & 31) == 0) atomicAdd(sg.rs_out + row, ss);
            }
          }
        }
      }
      __syncthreads();
    }
  }
}

#define LAS3 __attribute__((address_space(3)))
constexpr int S8_HTB = 128 * 64 * 2;
DI int s8_perm32(int rho) { const int n = rho >> 4, i = rho & 15; return 8 * (i >> 2) + 4 * n + (i & 3); }
struct SUnit { int m0, n0; };

template <bool NAT>
DI void s8_mma(f32x4 (&acc)[4][2], const bf16x8 (&At)[4][2], const bf16x8 (&Bt)[2][2]) {
  __builtin_amdgcn_s_setprio(1);
#pragma unroll
  for (int m = 0; m < 4; ++m)
#pragma unroll
    for (int n = 0; n < 2; ++n)
#pragma unroll
      for (int k = 0; k < 2; ++k) acc[m][n] = NAT ? MFMA16(At[m][k], Bt[n][k], acc[m][n]) : MFMA16(Bt[n][k], At[m][k], acc[m][n]);
  __builtin_amdgcn_s_setprio(0);
}

template <bool NAT>
DI void s8_epilogue(const f32x4 (&acc)[2][2][4][2], const Seg& sg, int m0, int wr, int fr, int fq) {
  if (!NAT && sg.type == SEG_NORM) {
    float gn[2][8];
#pragma unroll
    for (int bj = 0; bj < 2; ++bj)
#pragma unroll
      for (int k = 0; k < 8; ++k) gn[bj][k] = sg.gain[32 * bj + 8 * fq + k] * sg.scale;
#pragma unroll
    for (int ai = 0; ai < 2; ++ai)
#pragma unroll
      for (int m = 0; m < 4; ++m) {
        const int row = m0 + 128 * ai + 64 * wr + 16 * m + fr;
        float ss = 0.f;
#pragma unroll
        for (int bj = 0; bj < 2; ++bj)
#pragma unroll
          for (int n = 0; n < 2; ++n)
#pragma unroll
            for (int j = 0; j < 4; ++j) ss += acc[ai][bj][m][n][j] * acc[ai][bj][m][n][j];
        ss += __shfl_xor(ss, 16); ss += __shfl_xor(ss, 32);
        const float sc = rsqrtf(ss * (1.0f / 64.0f) + EPS);
#pragma unroll
        for (int bj = 0; bj < 2; ++bj) {
          uint4 u;
          u.x = pack2(acc[ai][bj][m][0][0] * sc * gn[bj][0], acc[ai][bj][m][0][1] * sc * gn[bj][1]);
          u.y = pack2(acc[ai][bj][m][0][2] * sc * gn[bj][2], acc[ai][bj][m][0][3] * sc * gn[bj][3]);
          u.z = pack2(acc[ai][bj][m][1][0] * sc * gn[bj][4], acc[ai][bj][m][1][1] * sc * gn[bj][5]);
          u.w = pack2(acc[ai][bj][m][1][2] * sc * gn[bj][6], acc[ai][bj][m][1][3] * sc * gn[bj][7]);
          *(uint4*)(sg.dst + (size_t)row * sg.ld + sg.col + 32 * bj + 8 * fq) = u;
        }
        __builtin_amdgcn_sched_barrier(0);
      }
  } else if (NAT) {
#pragma unroll
    for (int ai = 0; ai < 2; ++ai)
#pragma unroll
      for (int m = 0; m < 4; ++m) {
        const int row = m0 + 128 * ai + 64 * wr + 16 * m + 4 * fq;
        const f32x4 rv = *(const f32x4*)(sg.rs + row);
        f32x4 sc;
#pragma unroll
        for (int j = 0; j < 4; ++j) sc[j] = rsqrtf(rv[j] * (1.0f / 1024.0f) + EPS);
#pragma unroll
        for (int bj = 0; bj < 2; ++bj)
#pragma unroll
          for (int n = 0; n < 2; ++n) {
            const int ch = sg.col + 32 * bj + 8 * (fr >> 2) + 4 * n + (fr & 3);
            size_t off;
            if (sg.type == SEG_CHM) off = chm_index(sg.CH, row, ch);
            else off = ((size_t)((row >> 8) * 256 + ch) << 8) + (row & 255);
            const f32x4 v = acc[ai][bj][m][n] * sc;
            uint2 u; u.x = pack2(v[0], v[1]); u.y = pack2(v[2], v[3]);
            *(uint2*)(sg.dst + off) = u;
          }
        __builtin_amdgcn_sched_barrier(0);
      }
  } else if (sg.type == SEG_CHM) {
#pragma unroll
    for (int ai = 0; ai < 2; ++ai)
#pragma unroll
      for (int m = 0; m < 4; ++m) {
        const int row = m0 + 128 * ai + 64 * wr + 16 * m + fr;
        const float sc = rsqrtf(sg.rs[row] * (1.0f / 1024.0f) + EPS);
#pragma unroll
        for (int bj = 0; bj < 2; ++bj)
#pragma unroll
          for (int n = 0; n < 2; ++n)
#pragma unroll
            for (int j = 0; j < 4; ++j) sg.dst[chm_index(sg.CH, row, sg.col + 32 * bj + 8 * fq + 4 * n + j)] = f2bf(acc[ai][bj][m][n][j] * sc);
        __builtin_amdgcn_sched_barrier(0);
      }
  } else if (sg.type == SEG_MLP1) {
#pragma unroll
    for (int ai = 0; ai < 2; ++ai) {
      float sc[4];
#pragma unroll
      for (int m = 0; m < 4; ++m) sc[m] = rsqrtf(sg.rs[m0 + 128 * ai + 64 * wr + 16 * m + fr] * (1.0f / 1024.0f) + EPS);
#pragma unroll
      for (int m = 0; m < 4; ++m) {
        const int row = m0 + 128 * ai + 64 * wr + 16 * m + fr;
#pragma unroll
        for (int bj = 0; bj < 2; ++bj) {
          f32x4 a = acc[ai][bj][m][0] * sc[m], b = acc[ai][bj][m][1] * sc[m];
#pragma unroll
          for (int j = 0; j < 4; ++j) { a[j] = fmaxf(a[j], 0.f); a[j] *= a[j]; b[j] = fmaxf(b[j], 0.f); b[j] *= b[j]; }
          uint4 u; u.x = pack2(a[0], a[1]); u.y = pack2(a[2], a[3]); u.z = pack2(b[0], b[1]); u.w = pack2(b[2], b[3]);
          *(uint4*)(sg.dst + (size_t)row * sg.ld + sg.col + 32 * bj + 8 * fq) = u;
        }
        __builtin_amdgcn_sched_barrier(0);
      }
    }
  } else {
#pragma unroll
    for (int ai = 0; ai < 2; ++ai)
#pragma unroll
      for (int mp = 0; mp < 2; ++mp) {
        f32x4 xv[2][2][2];
#pragma unroll
        for (int mm = 0; mm < 2; ++mm) {
          const int row = m0 + 128 * ai + 64 * wr + 16 * (2 * mp + mm) + fr;
          const float* xo;
          if (sg.xin0) xo = (row < T_P) ? sg.xin0 + (size_t)row * DM : sg.xin1 + (size_t)(row - T_P) * DM;
          else xo = sg.xout + (size_t)row * DM;
#pragma unroll
          for (int bj = 0; bj < 2; ++bj) { xv[mm][bj][0] = *(const f32x4*)(xo + sg.col + 32 * bj + 8 * fq); xv[mm][bj][1] = *(const f32x4*)(xo + sg.col + 32 * bj + 8 * fq + 4); }
        }
#pragma unroll
        for (int mm = 0; mm < 2; ++mm) {
          const int m = 2 * mp + mm;
          const int row = m0 + 128 * ai + 64 * wr + 16 * m + fr;
          float ss = 0.f;
#pragma unroll
          for (int bj = 0; bj < 2; ++bj) {
            const f32x4 a = acc[ai][bj][m][0] + xv[mm][bj][0], b = acc[ai][bj][m][1] + xv[mm][bj][1];
            float* op = sg.xout + (size_t)row * DM + sg.col + 32 * bj + 8 * fq;
            *(f32x4*)op = a; *(f32x4*)(op + 4) = b;
            if (sg.xb) { uint4 u; u.x = pack2(a[0], a[1]); u.y = pack2(a[2], a[3]); u.z = pack2(b[0], b[1]); u.w = pack2(b[2], b[3]); *(uint4*)(sg.xb + (size_t)row * DM + sg.col + 32 * bj + 8 * fq) = u; }
#pragma unroll
            for (int j = 0; j < 4; ++j) ss += a[j] * a[j] + b[j] * b[j];
          }
          if (sg.rs_out) {
            ss += __shfl_xor(ss, 16); ss += __shfl_xor(ss, 32);
            if (fq == 0) atomicAdd(sg.rs_out + row, ss);
          }
          __builtin_amdgcn_sched_barrier(0);
        }
        __builtin_amdgcn_sched_barrier(0);
      }
  }
}

template <bool NAT, class Sched, class SegFn>
DI void gemm_stream(const GemmArgs& ga, const Sched& S, const SegFn& segfn) {
  extern __shared__ __attribute__((aligned(16))) char shm[];
  LAS3 unsigned char* lds = (LAS3 unsigned char*)shm;
  const int tid = opaque((int)threadIdx.x), wid = __builtin_amdgcn_readfirstlane(tid >> 6), lane = tid & 63, wr = wid >> 2, wc = wid & 3, fr = lane & 15, fq = lane >> 4;
  const int nt = ga.K >> 6, kst = ga.ksplit >> 6;
  unsigned voffA[2], voffB[2];
#pragma unroll
  for (int i = 0; i < 2; ++i) {
    int R, C; g_stage_rc(tid * 16 + i * 8192, R, C);
    const int Rb = ((R & ~31) << 1) + s8_perm32(R & 31);
    voffA[i] = (unsigned)(R * ga.lda + C) * 2u; voffB[i] = (unsigned)(Rb * ga.ldw + C) * 2u;
  }
  const size_t hstepA = (size_t)128 * ga.lda * 2, hstepB = (size_t)32 * ga.ldw * 2;
  const unsigned ldsw = (unsigned)wid * 1024u;
  const int aoff = g_lds_byte(wr * 64 + fr, fq * 8), boff = g_lds_byte(wc * 32 + fr, fq * 8);
#define S8_SA(b, h) (((b) * 2 + (h)) * S8_HTB)
#define S8_SB(b, h) ((4 + (b) * 2 + (h)) * S8_HTB)
#define S8_STAGE(bufoff, gbase, voff) do { _Pragma("unroll") for (int _i = 0; _i < 2; ++_i) \
    __builtin_amdgcn_global_load_lds((const unsigned*)((const char*)(gbase) + (voff)[_i]), (LAS3 unsigned*)(lds + (bufoff) + ldsw + _i * 8192), 16, 0, 0); } while (0)
#define S8_LDA(dst, b, h) do { _Pragma("unroll") for (int m = 0; m < 4; ++m) _Pragma("unroll") for (int k = 0; k < 2; ++k) dst[m][k] = *(const LAS3 bf16x8*)(lds + S8_SA(b, h) + aoff + m * 2048 + k * 1024); } while (0)
#define S8_LDB(dst, b, h) do { _Pragma("unroll") for (int n = 0; n < 2; ++n) _Pragma("unroll") for (int k = 0; k < 2; ++k) dst[n][k] = *(const LAS3 bf16x8*)(lds + S8_SB(b, h) + boff + n * 2048 + k * 1024); } while (0)
#define S8_MMA(ai, bj, At, Bt) s8_mma<NAT>(acc[ai][bj], At, Bt)
#define S8_WAIT_V(n) asm volatile("s_waitcnt vmcnt(" #n ")" ::: "memory")
#define S8_WAIT_L(n) asm volatile("s_waitcnt lgkmcnt(" #n ")" ::: "memory")
#define S8_BAR __builtin_amdgcn_s_barrier()
#define S8_SCHED __builtin_amdgcn_sched_barrier(0)
  auto aptr = [&](const SUnit& u, int t) -> const char* {
    return (const char*)((t < kst ? ga.A0 + (size_t)t * 64 : ga.A1 + (size_t)(t - kst) * 64) + (size_t)u.m0 * ga.lda);
  };
  auto bptr = [&](const SUnit& u, int t) -> const char* { return (const char*)(ga.Wt + (size_t)u.n0 * ga.ldw + (size_t)t * 64); };
  SUnit cur, nxt; int ui = 0;
  if (!S.next(0, cur)) return;
  f32x4 acc[2][2][4][2];
#pragma unroll
  for (int a = 0; a < 2; ++a)
#pragma unroll
    for (int b = 0; b < 2; ++b)
#pragma unroll
      for (int m = 0; m < 4; ++m)
#pragma unroll
        for (int n = 0; n < 2; ++n) acc[a][b][m][n] = (f32x4){0.f, 0.f, 0.f, 0.f};
  bf16x8 At[4][2], B0[2][2], B1[2][2];
  Seg seg = segfn(cur, wc);
  { const char* cA = aptr(cur, 0); const char* cB = bptr(cur, 0); const char* cA1 = aptr(cur, 1); const char* cB1 = bptr(cur, 1);
    S8_STAGE(S8_SB(0, 0), cB, voffB); S8_STAGE(S8_SA(0, 0), cA, voffA); S8_STAGE(S8_SB(0, 1), cB + hstepB, voffB); S8_STAGE(S8_SA(0, 1), cA + hstepA, voffA);
    if (wr == 1) S8_BAR;
    S8_WAIT_V(4); S8_BAR;
    S8_STAGE(S8_SB(1, 0), cB1, voffB); S8_STAGE(S8_SA(1, 0), cA1, voffA); S8_STAGE(S8_SB(1, 1), cB1 + hstepB, voffB);
    S8_WAIT_V(6); S8_BAR; }
  for (;;) {
    const bool has_next = S.next(ui + 1, nxt);
    const SUnit nu = has_next ? nxt : cur;
#pragma unroll 1
    for (int t = 0; t < nt; t += 2) {
      const bool last = (t == nt - 2);
      const char* a1 = aptr(cur, t + 1);
      const char* a2 = last ? aptr(nu, 0) : aptr(cur, t + 2); const char* b2 = last ? bptr(nu, 0) : bptr(cur, t + 2);
      const char* a3 = last ? aptr(nu, 1) : aptr(cur, t + 3); const char* b3 = last ? bptr(nu, 1) : bptr(cur, t + 3);
      S8_LDB(B0, 0, 0); S8_SCHED; S8_LDA(At, 0, 0); S8_STAGE(S8_SA(1, 1), a1 + hstepA, voffA);
      S8_WAIT_L(8); S8_BAR; S8_WAIT_L(0); S8_MMA(0, 0, At, B0); S8_BAR; S8_SCHED;
      S8_LDB(B1, 0, 1); S8_STAGE(S8_SB(0, 0), b2, voffB);
      S8_BAR; S8_WAIT_L(0); S8_MMA(0, 1, At, B1); S8_BAR;
      S8_LDA(At, 0, 1); S8_STAGE(S8_SA(0, 0), a2, voffA);
      S8_BAR; S8_WAIT_L(0); S8_MMA(1, 0, At, B0); S8_BAR; S8_SCHED;
      S8_STAGE(S8_SB(0, 1), b2 + hstepB, voffB);
      S8_WAIT_V(6); S8_BAR; S8_MMA(1, 1, At, B1); S8_BAR;
      S8_LDB(B0, 1, 0); S8_SCHED; S8_LDA(At, 1, 0); S8_STAGE(S8_SA(0, 1), a2 + hstepA, voffA);
      S8_WAIT_L(8); S8_BAR; S8_WAIT_L(0); S8_MMA(0, 0, At, B0); S8_BAR; S8_SCHED;
      S8_LDB(B1, 1, 1); S8_STAGE(S8_SB(1, 0), b3, voffB);
      S8_BAR; S8_WAIT_L(0); S8_MMA(0, 1, At, B1); S8_BAR;
      S8_LDA(At, 1, 1); S8_STAGE(S8_SA(1, 0), a3, voffA);
      S8_BAR; S8_WAIT_L(0); S8_MMA(1, 0, At, B0); S8_BAR; S8_SCHED;
      S8_STAGE(S8_SB(1, 1), b3 + hstepB, voffB);
      S8_WAIT_V(6); S8_BAR; S8_MMA(1, 1, At, B1); S8_BAR;
    }
#ifndef S8_NOEPI
    { const int lane2 = opaque((int)__builtin_amdgcn_mbcnt_hi(~0u, __builtin_amdgcn_mbcnt_lo(~0u, 0u))); s8_epilogue<NAT>(acc, seg, cur.m0, wr, lane2 & 15, lane2 >> 4); }
#else
    if (seg.type == 77) *(f32x4*)(seg.xout + fr) = acc[0][0][0][0] + acc[1][1][3][1] + acc[0][1][2][0] + acc[1][0][1][1];
#endif
    if (!has_next) break;
#pragma unroll
    for (int a = 0; a < 2; ++a)
#pragma unroll
      for (int b = 0; b < 2; ++b)
#pragma unroll
        for (int m = 0; m < 4; ++m)
#pragma unroll
          for (int n = 0; n < 2; ++n) acc[a][b][m][n] = (f32x4){0.f, 0.f, 0.f, 0.f};
    cur = nxt; ++ui;
    seg = segfn(cur, wc);
  }
  S8_WAIT_V(0);
  if (wr == 0) S8_BAR;
  S8_BAR;
}

enum { AM_MEM = 0, AM_DIFF = 1, AM_WG = 2, AM_NA = 3 };
constexpr int ATT_LUT_OFS = 73728;
constexpr int ATT_O0_OFS = 77824;

template <int VD, int MODE>
DI void attn_core(char* smem, const bf16_t* Q, int ldq, const bf16_t* K, int ldk, const bf16_t* Vt, int ldv,
                  int qpos0, int kbeg, int kend, int nrows, float sink_l2, float (&O)[2][VD / 16][4]) {
  constexpr int NDB = VD / 16;
  constexpr int STAGE = 8192 + VD * 128;
  constexpr int NL = 1 + VD / 64;
  extern __shared__ __attribute__((aligned(16))) char shm[];
  const int tid = opaque((int)threadIdx.x), lane = tid & 63, wave = tid >> 6;
  const int l16 = lane & 15, g = lane >> 4;
  const float* lut = (const float*)(smem + ATT_LUT_OFS);
  bf16x8 qf[2][2];
#pragma unroll
  for (int qb = 0; qb < 2; ++qb)
#pragma unroll
    for (int kk = 0; kk < 2; ++kk) qf[qb][kk] = *(const bf16x8*)(Q + (size_t)(32 * wave + 16 * qb + l16) * ldq + 32 * kk + 8 * g);
  float m[2] = {-1e30f, -1e30f}, l[2] = {0.f, 0.f};
#pragma unroll
  for (int qb = 0; qb < 2; ++qb)
#pragma unroll
    for (int db = 0; db < NDB; ++db)
#pragma unroll
      for (int r = 0; r < 4; ++r) O[qb][db][r] = 0.f;
  const int wq0 = qpos0 + 32 * wave;
  const int srow = 8 * wave + (lane >> 3);
  const int schunk = (lane & 7) ^ (lane >> 3);
#define ATT_ISSUE(k0_, st_) do { \
    __builtin_amdgcn_global_load_lds((const unsigned*)(K + (size_t)((k0_) + srow) * ldk + 8 * schunk), (__attribute__((address_space(3))) unsigned*)(shm + (st_) * STAGE + wave * 1024), 16, 0, 0); \
    __builtin_amdgcn_global_load_lds((const unsigned*)(Vt + (size_t)(srow) * ldv + (k0_) + 8 * schunk), (__attribute__((address_space(3))) unsigned*)(shm + (st_) * STAGE + 8192 + wave * 1024), 16, 0, 0); \
    if (VD == 128) __builtin_amdgcn_global_load_lds((const unsigned*)(Vt + (size_t)(srow + 64) * ldv + (k0_) + 8 * schunk), (__attribute__((address_space(3))) unsigned*)(shm + (st_) * STAGE + 8192 + 8192 + wave * 1024), 16, 0, 0); } while (0)
  const int ntile = (kend - kbeg) >> 6;
  ATT_ISSUE(kbeg, 0);
  if (ntile > 1) { ATT_ISSUE(kbeg + 64, 1); asm volatile("s_waitcnt vmcnt(%0)" :: "n"(NL) : "memory"); }
  else asm volatile("s_waitcnt vmcnt(0)" ::: "memory");
  __builtin_amdgcn_s_barrier();
  int it = 0, st = 0;
  for (int k0 = kbeg; k0 < kend; k0 += 64, ++it) {
    { const int st2 = (st >= 1) ? st - 1 : 2; if (it + 2 < ntile) ATT_ISSUE(k0 + 128, st2); }
    const char* Ks = shm + st * STAGE; const char* Vs = Ks + 8192;
    bool active = true;
    if (MODE == AM_WG) active = !(k0 + 63 < wq0 - 128 || k0 > wq0 + 31 + 128);
    int na_rs = 0; const int qr = wq0 >> 6, kr = k0 >> 6;
    if (MODE == AM_NA) { na_rs = min(max(qr - 4, 0), nrows - 8); active = (kr >= na_rs && kr < na_rs + 8); }
    if (active) {
      f32x4 S[2][4];
#pragma unroll
      for (int kb = 0; kb < 4; ++kb) {
        bf16x8 kf0 = *(const bf16x8*)(Ks + (16 * kb + l16) * 128 + ((g ^ (l16 & 7)) << 4));
        bf16x8 kf1 = *(const bf16x8*)(Ks + (16 * kb + l16) * 128 + (((4 + g) ^ (l16 & 7)) << 4));
#pragma unroll
        for (int qb = 0; qb < 2; ++qb) {
          f32x4 z = (f32x4){0.f, 0.f, 0.f, 0.f};
          z = MFMA16(kf0, qf[qb][0], z);
          S[qb][kb] = MFMA16(kf1, qf[qb][1], z);
        }
      }
      float coff = 0.f;
      bool lut_tile = false;
      if (MODE == AM_DIFF) {
        if (k0 + 63 - wq0 <= -128) coff = lut[0];
        else if (k0 - (wq0 + 31) >= 128) coff = lut[256];
        else lut_tile = true;
      }
#pragma unroll
      for (int qb = 0; qb < 2; ++qb) {
        const int q = wq0 + 16 * qb + l16;
        if ((MODE == AM_DIFF && lut_tile) || MODE == AM_WG) {
#pragma unroll
          for (int kb = 0; kb < 4; ++kb)
#pragma unroll
            for (int r = 0; r < 4; ++r) {
              const int rel = k0 + 16 * kb + 4 * g + r - q;
              const int rc = min(max(rel, -128), 128);
              float s = S[qb][kb][r] + lut[rc + 128];
              if (MODE == AM_WG && (rel > 128 || rel < -128)) s = -1e30f;
              S[qb][kb][r] = s;
            }
        } else if (MODE == AM_NA) {
          const int qc = q & 63;
          const int cs = min(max(qc - 8, 0), 48);
          const int dr = kr - qr + 7;
#pragma unroll
          for (int kb = 0; kb < 4; ++kb)
#pragma unroll
            for (int r = 0; r < 4; ++r) {
              const int kc = 16 * kb + 4 * g + r;
              const bool ok = (kc >= cs) && (kc < cs + 16);
              const int dc = min(max(kc - qc + 15, 0), 30);
              float s = S[qb][kb][r] + lut[dr * 31 + dc];
              S[qb][kb][r] = ok ? s : -1e30f;
            }
        }
      }
      float mx[2];
      bool need = false;
#pragma unroll
      for (int qb = 0; qb < 2; ++qb) {
        float v = -1e30f;
#pragma unroll
        for (int kb = 0; kb < 4; ++kb) v = fmaxf(v, fmaxf(fmaxf(S[qb][kb][0], S[qb][kb][1]), fmaxf(S[qb][kb][2], S[qb][kb][3])));
        v = fmaxf(v, __shfl_xor(v, 16)); v = fmaxf(v, __shfl_xor(v, 32));
        v += coff;
        mx[qb] = v;
        need = need || (v > m[qb] + 8.0f);
      }
      if (__any(need)) {
#pragma unroll
        for (int qb = 0; qb < 2; ++qb) {
          const float mn = fmaxf(m[qb], mx[qb]);
          const float alpha = ex2(m[qb] - mn);
          m[qb] = mn;
          l[qb] *= alpha;
#pragma unroll
          for (int db = 0; db < NDB; ++db)
#pragma unroll
            for (int r = 0; r < 4; ++r) O[qb][db][r] *= alpha;
        }
      }
#pragma unroll
      for (int qb = 0; qb < 2; ++qb) {
        const float mo = m[qb] - coff;
        float ps = 0.f;
#pragma unroll
        for (int kb = 0; kb < 4; ++kb)
#pragma unroll
          for (int r = 0; r < 4; ++r) { float p = ex2(S[qb][kb][r] - mo); S[qb][kb][r] = p; ps += p; }
        l[qb] += ps;
      }
#pragma unroll
      for (int ks = 0; ks < 2; ++ks) {
        bf16x8 pf[2];
#pragma unroll
        for (int qb = 0; qb < 2; ++qb) {
          uint4 u;
          u.x = pack2(S[qb][2 * ks][0], S[qb][2 * ks][1]); u.y = pack2(S[qb][2 * ks][2], S[qb][2 * ks][3]);
          u.z = pack2(S[qb][2 * ks + 1][0], S[qb][2 * ks + 1][1]); u.w = pack2(S[qb][2 * ks + 1][2], S[qb][2 * ks + 1][3]);
          pf[qb] = __builtin_bit_cast(bf16x8, u);
        }
#pragma unroll
        for (int db = 0; db < NDB; ++db) {
          const char* vrow = Vs + (16 * db + l16) * 128 + 8 * (g & 1);
          uint2 v0 = *(const uint2*)(vrow + (((4 * ks + (g >> 1)) ^ (l16 & 7)) << 4));
          uint2 v1 = *(const uint2*)(vrow + (((4 * ks + 2 + (g >> 1)) ^ (l16 & 7)) << 4));
          uint4 u; u.x = v0.x; u.y = v0.y; u.z = v1.x; u.w = v1.y;
          bf16x8 vf = __builtin_bit_cast(bf16x8, u);
#pragma unroll
          for (int qb = 0; qb < 2; ++qb) {
            f32x4 o = (f32x4){O[qb][db][0], O[qb][db][1], O[qb][db][2], O[qb][db][3]};
            o = MFMA16(vf, pf[qb], o);
            O[qb][db][0] = o[0]; O[qb][db][1] = o[1]; O[qb][db][2] = o[2]; O[qb][db][3] = o[3];
          }
        }
      }
    }
    if (it + 2 < ntile) asm volatile("s_waitcnt vmcnt(%0)" :: "n"(NL) : "memory");
    else asm volatile("s_waitcnt vmcnt(0)" ::: "memory");
    asm volatile("s_waitcnt lgkmcnt(0)" ::: "memory");
    __builtin_amdgcn_s_barrier();
    st = (st == 2) ? 0 : st + 1;
  }
#pragma unroll
  for (int qb = 0; qb < 2; ++qb) {
    float lt = l[qb];
    lt += __shfl_xor(lt, 16); lt += __shfl_xor(lt, 32);
    if (MODE == AM_WG) lt += ex2(sink_l2 - m[qb]);
    const float inv = 1.0f / lt;
#pragma unroll
    for (int db = 0; db < NDB; ++db)
#pragma unroll
      for (int r = 0; r < 4; ++r) O[qb][db][r] *= inv;
  }
}

template <int NDB>
DI void attn_store(bf16_t* dst, int ld, const float (&O)[2][NDB][4]) {
  const int lane = threadIdx.x & 63, wave = threadIdx.x >> 6, l16 = lane & 15, g = lane >> 4;
#pragma unroll
  for (int qb = 0; qb < 2; ++qb)
#pragma unroll
    for (int db = 0; db < NDB; ++db) {
      uint2 v; v.x = pack2(O[qb][db][0], O[qb][db][1]); v.y = pack2(O[qb][db][2], O[qb][db][3]);
      *(uint2*)(dst + (size_t)(32 * wave + 16 * qb + l16) * ld + 16 * db + 4 * g) = v;
    }
}

DI void seq_of_row(int row0, int& L, int& seq_row0, int& b_glob) {
  if (row0 < T_P) { L = LP; int b = row0 >> 14; seq_row0 = b << 14; b_glob = b; }
  else { L = LS; int b = (row0 - T_P) >> 11; seq_row0 = T_P + (b << 11); b_glob = 2 + b; }
}

DI void diff_item(char* smem, const Params& p, int item, bool dry = false) {
  bf16_t* QA = (bf16_t*)(p.ws + WS_R0);
  const bf16_t* KA = (const bf16_t*)((const char*)p.out + 192 * MiB);
  const bf16_t* VAt = (const bf16_t*)(p.ws + WS_R2);
  const float* misc_lut = (const float*)(p.ws + WS_MISC + MS_LUT);
  const float lam = *(const float*)(p.ws + WS_MISC + MS_LAM);
  int h, row0;
  if (item < 512) { h = item & 3; row0 = (item >> 2) * 256; }
  else { int i2 = item - 512; h = i2 & 3; row0 = T_P + (i2 >> 2) * 256; }
  int L, srow0, bg; seq_of_row(row0, L, srow0, bg);
  const int qpos0 = row0 - srow0;
  const bf16_t* Vt = VAt + chm_index(512, srow0, h * 128);
  float O[2][8][4];
  unsigned* o0s = (unsigned*)(smem + ATT_O0_OFS) + threadIdx.x;
  const int tid = threadIdx.x;
#pragma unroll 1
  for (int mp = 0; mp < 2; ++mp) {
    __syncthreads();
    for (int i = tid; i < 257; i += NTHR) ((float*)(smem + ATT_LUT_OFS))[i] = misc_lut[(h * 2 + mp) * 257 + i];
    __syncthreads();
    attn_core<128, AM_DIFF>(smem, QA + (size_t)row0 * 512 + h * 128 + mp * 64, 512, KA + (size_t)srow0 * 512 + h * 128 + mp * 64, 512,
                            Vt, L, qpos0, 0, L, 0, 0.f, O);
    if (mp == 0) {
#pragma unroll
      for (int qb = 0; qb < 2; ++qb)
#pragma unroll
        for (int db = 0; db < 8; ++db) { o0s[((qb * 8 + db) * 2) * NTHR] = pack2(O[qb][db][0], O[qb][db][1]); o0s[((qb * 8 + db) * 2 + 1) * NTHR] = pack2(O[qb][db][2], O[qb][db][3]); }
    }
  }
  const int tid2 = opaque((int)threadIdx.x);
  const int lane = tid2 & 63, l16 = lane & 15, g = lane >> 4;
  const float* sg = p.in[13];
#pragma unroll
  for (int qb = 0; qb < 2; ++qb) {
    float ss = 0.f;
#pragma unroll
    for (int db = 0; db < 8; ++db) {
      const unsigned w0 = o0s[((qb * 8 + db) * 2) * NTHR], w1 = o0s[((qb * 8 + db) * 2 + 1) * NTHR];
      float a0 = bf2f((unsigned short)(w0 & 0xffff)), a1 = bf2f((unsigned short)(w0 >> 16));
      float a2 = bf2f((unsigned short)(w1 & 0xffff)), a3 = bf2f((unsigned short)(w1 >> 16));
      O[qb][db][0] = a0 - lam * O[qb][db][0]; O[qb][db][1] = a1 - lam * O[qb][db][1];
      O[qb][db][2] = a2 - lam * O[qb][db][2]; O[qb][db][3] = a3 - lam * O[qb][db][3];
#pragma unroll
      for (int r = 0; r < 4; ++r) ss += O[qb][db][r] * O[qb][db][r];
    }
    ss += __shfl_xor(ss, 16); ss += __shfl_xor(ss, 32);
    const float sc = rsqrtf(ss * (1.0f / 128.0f) + EPS) * 0.8f;
#pragma unroll
    for (int db = 0; db < 8; ++db)
#pragma unroll
      for (int r = 0; r < 4; ++r) O[qb][db][r] *= sc * sg[16 * db + 4 * g + r];
  }
  if (dry) attn_store<8>((bf16_t*)(p.ws + 484 * MiB), 512, O); else attn_store<8>(QA + (size_t)row0 * 512 + h * 128, 512, O);
}

DI void wg_item(char* smem, const Params& p, int item, bool dry = false) {
  bf16_t* QD = (bf16_t*)(p.ws + WS_R3);
  const bf16_t* KD = (const bf16_t*)(p.ws + WS_KD);
  const bf16_t* VDt = (const bf16_t*)(p.ws + WS_VDT);
  const float* misc_lut = (const float*)(p.ws + WS_MISC + MS_LUT);
  const int hq = item & 7; const int row0 = (item >> 3) * 256;
  int L, srow0, bg; seq_of_row(row0, L, srow0, bg);
  const int qpos0 = row0 - srow0;
  const int kvh = hq >> 2;
  __syncthreads();
  for (int i = threadIdx.x; i < 257; i += NTHR) ((float*)(smem + ATT_LUT_OFS))[i] = misc_lut[hq * 257 + i];
  __syncthreads();
  float O[2][4][4];
  const int kbeg = max(0, qpos0 - 128), kend = min(L, qpos0 + 256 + 128);
  attn_core<64, AM_WG>(smem, QD + (size_t)row0 * 512 + hq * 64, 512, KD + (size_t)srow0 * 128 + kvh * 64, 128,
                       VDt + chm_index(128, srow0, kvh * 64), L, qpos0, kbeg, kend, 0, p.in[30][hq] * LOG2E, O);
  if (dry) attn_store<4>((bf16_t*)(p.ws + 484 * MiB), 512, O); else attn_store<4>(QD + (size_t)row0 * 512 + hq * 64, 512, O);
}

DI void na_item(char* smem, const Params& p, int item, bool dry = false) {
  bf16_t* QC = (bf16_t*)(p.ws + WS_R0);
  const bf16_t* KC = (const bf16_t*)(p.ws + WS_R1);
  const bf16_t* VCt = (const bf16_t*)(p.ws + WS_R2);
  const int h = item & 7; const int row0 = (item >> 3) * 256;
  int L, srow0, bg; seq_of_row(row0, L, srow0, bg);
  const int qpos0 = row0 - srow0;
  const int nrows = L >> 6;
  __syncthreads();
  for (int i = threadIdx.x; i < 465; i += NTHR) ((float*)(smem + ATT_LUT_OFS))[i] = p.in[27][h * 465 + i] * LOG2E;
  __syncthreads();
  const int qr0 = qpos0 >> 6;
  const int rs0 = min(max(qr0 - 4, 0), nrows - 8), rs3 = min(max(qr0 + 3 - 4, 0), nrows - 8);
  float O[2][4][4];
  attn_core<64, AM_NA>(smem, QC + (size_t)row0 * 512 + h * 64, 512, KC + (size_t)srow0 * 512 + h * 64, 512,
                       VCt + chm_index(512, srow0, h * 64), L, qpos0, rs0 * 64, (rs3 + 8) * 64, nrows, 0.f, O);
  if (dry) attn_store<4>((bf16_t*)(p.ws + 484 * MiB), 512, O); else attn_store<4>(QC + (size_t)row0 * 512 + h * 64, 512, O);
}

DI void mem_attn_tile(char* smem, const Params& p, int layer, int row0) {
  bf16_t* QM = (bf16_t*)(p.ws + WS_QM);
  const bf16_t* MK = (const bf16_t*)(p.ws + WS_MISC + MS_MK) + (size_t)layer * 18 * 256 * 256;
  const bf16_t* MVt = (const bf16_t*)(p.ws + WS_MISC + MS_MVT) + (size_t)layer * 18 * 256 * 256;
  int L, srow0, bg; seq_of_row(row0, L, srow0, bg);
#pragma unroll 1
  for (int h = 0; h < 4; ++h) {
    float O[2][4][4];
    attn_core<64, AM_MEM>(smem, QM + (size_t)row0 * 256 + h * 64, 256, MK + (size_t)bg * 256 * 256 + h * 64, 256,
                          MVt + ((size_t)(bg * 256 + h * 64) << 8), 256, 0, 0, 256, 0, 0.f, O);
    attn_store<4>(QM + (size_t)row0 * 256 + h * 64, 256, O);
  }
}

DI int PADI(int i) { return i + (i >> 5); }
DI float2 cmul(float2 a, float2 b) { return make_float2(a.x * b.x - a.y * b.y, a.x * b.y + a.y * b.x); }
DI float2 cmulc(float2 a, float2 b) { return make_float2(a.x * b.x + a.y * b.y, a.y * b.x - a.x * b.y); }
DI constexpr float C16(int m) { return m == 0 ? 1.f : m == 1 ? 0.92387953251128674f : m == 2 ? 0.70710678118654752f : m == 3 ? 0.38268343236508977f : m == 4 ? 0.f : m == 5 ? -0.38268343236508977f : m == 6 ? -0.70710678118654752f : -0.92387953251128674f; }
DI constexpr float S16(int m) { return m == 0 ? 0.f : m == 1 ? 0.38268343236508977f : m == 2 ? 0.70710678118654752f : m == 3 ? 0.92387953251128674f : m == 4 ? 1.f : m == 5 ? 0.92387953251128674f : m == 6 ? 0.70710678118654752f : 0.38268343236508977f; }

template <int LOGR, int LOGS, bool INV>
DI void fft_pass(float2* buf, int total) {
  constexpr int R = 1 << LOGR;
  constexpr int S = 1 << LOGS;
  const int tid0 = opaque((int)threadIdx.x);
#pragma unroll 1
  for (int u = tid0; u < (total >> LOGR); u += NTHR) {
    const int j = u & (S - 1);
    const int base = ((u >> LOGS) << (LOGS + LOGR)) + j;
    float2* bp = buf + PADI(base);
    float2 x[R];
#pragma unroll
    for (int k = 0; k < R; ++k) x[k] = bp[k * S + ((k * S) >> 5)];
    float2 pw[LOGR];
    {
      const float rev = -(float)j * (1.0f / (float)(R * S));
      pw[0] = make_float2(cos_rev(rev), sin_rev(rev));
#pragma unroll
      for (int i = 1; i < LOGR; ++i) pw[i] = cmul(pw[i - 1], pw[i - 1]);
    }
    if (!INV) {
#pragma unroll
      for (int i = 0; i < LOGR; ++i) {
        const int h = R >> (i + 1);
#pragma unroll
        for (int k = 0; k < R; ++k) {
          if ((k & h) == 0) {
            const int mm = (k & (h - 1)) * 8 / h;
            float2 a = x[k], b = x[k + h];
            x[k] = make_float2(a.x + b.x, a.y + b.y);
            float2 d = make_float2(a.x - b.x, a.y - b.y);
            if (mm != 0) d = cmul(d, make_float2(C16(mm), -S16(mm)));
            x[k + h] = cmul(d, pw[i]);
          }
        }
      }
    } else {
#pragma unroll
      for (int i = LOGR - 1; i >= 0; --i) {
        const int h = R >> (i + 1);
#pragma unroll
        for (int k = 0; k < R; ++k) {
          if ((k & h) == 0) {
            const int mm = (k & (h - 1)) * 8 / h;
            float2 a = x[k];
            float2 d = cmulc(x[k + h], pw[i]);
            if (mm != 0) d = cmulc(d, make_float2(C16(mm), -S16(mm)));
            x[k] = make_float2(a.x + d.x, a.y + d.y);
            x[k + h] = make_float2(a.x - d.x, a.y - d.y);
          }
        }
      }
    }
#pragma unroll
    for (int k = 0; k < R; ++k) bp[k * S + ((k * S) >> 5)] = x[k];
  }
  __syncthreads();
}

template <int LOGN>
DI void fft_fwd(float2* buf, int total) {
  if (LOGN == 14) { fft_pass<4, 10, false>(buf, total); fft_pass<4, 6, false>(buf, total); fft_pass<4, 2, false>(buf, total); fft_pass<2, 0, false>(buf, total); }
  else { fft_pass<4, 7, false>(buf, total); fft_pass<4, 3, false>(buf, total); fft_pass<3, 0, false>(buf, total); }
}
template <int LOGN>
DI void fft_inv(float2* buf, int total) {
  if (LOGN == 14) { fft_pass<2, 0, true>(buf, total); fft_pass<4, 2, true>(buf, total); fft_pass<4, 6, true>(buf, total); fft_pass<4, 10, true>(buf, total); }
  else { fft_pass<3, 0, true>(buf, total); fft_pass<4, 3, true>(buf, total); fft_pass<4, 7, true>(buf, total); }
}

template <int LOGN, int NB, int NSUB>
DI void hyena_item(char* smem, const Params& p, int c, int row_base  ) {
  constexpr int L = 1 << LOGN;
  constexpr int SPT = L / NTHR;
  constexpr int EPT = NB * L / NTHR;
  const int tid = opaque((int)threadIdx.x);
  float2* buf = (float2*)smem;
  float* sm_w3 = (float*)(smem + 135168);
  float* sm_red = sm_w3 + 256;
  char* scr = p.ws + WS_XB + (size_t)blockIdx.x * HY_SCR_PER_BLOCK;
  float* scrF0 = (float*)scr;
  float* scrB0 = scrF0 + L;
  float* scrF1 = (float*)(p.ws + 451 * MiB + (size_t)blockIdx.x * 128 * 1024);
  float* scrB1 = scrF1 + L;
  float2* scrY = (float2*)(scr + 128 * 1024);
  float2* scrZ = (float2*)(scr + 256 * 1024);
  float2* scrS = (float2*)(scr + 384 * 1024);
  const bf16_t* UH = (const bf16_t*)p.out;
  bf16_t* OBt = (bf16_t*)(p.ws + WS_R3);
  const bf16_t* h2b = (const bf16_t*)(p.ws + WS_MISC + (LOGN == 14 ? MS_H2P : MS_H2S));
  const float* w3 = p.in[21];
  const float* cw = p.in[14]; const float* cb = p.in[15]; const float* skp = p.in[22];
  const float delta = fabsf(-3.0701134573253945f + (float)c * ((-15.350567286626973f + 3.0701134573253945f) / 511.0f));
  const float invLm1 = 1.0f / (float)(L - 1);

  float wv[3][4];
#pragma unroll
  for (int q = 0; q < 3; ++q) { const int ch = q * 512 + c; wv[q][0] = cw[ch]; wv[q][1] = cw[1536 + ch]; wv[q][2] = cw[2 * 1536 + ch]; wv[q][3] = cb[ch]; }
  auto loadu3 = [&](int b, int ch, int n, float (&r)[3]) {
    const bf16_t* u = UH + chm_index(1536, row_base + b * L, ch) + n;
    r[1] = bf2f(u[0]);
    r[0] = (n > 0) ? bf2f(u[-1]) : 0.f;
    r[2] = (n < L - 1) ? bf2f(u[1]) : 0.f;
  };
  auto convw = [&](int q, const float (&r)[3]) -> float { return r[0] * wv[q][0] + r[1] * wv[q][1] + r[2] * wv[q][2] + wv[q][3]; };

  {
    __syncthreads();
    if (tid < 256) sm_w3[tid] = w3[(size_t)(tid & 63) * 2048 + (tid >> 6) * 512 + c];
    __syncthreads();
    float asum0 = 0.f, asum1 = 0.f;
    constexpr int NP = L / (2 * NTHR);
    constexpr int CHK = NP < 8 ? NP : 8;
#pragma unroll 1
    for (int rep = 0; rep < ((PROBE & 64) ? 2 : 1); ++rep) {
      asum0 = 0.f; asum1 = 0.f;
#pragma unroll 1
      for (int i0 = 0; i0 < NP; i0 += CHK) {
        float acc[CHK][4][2];
#pragma unroll
        for (int i = 0; i < CHK; ++i)
#pragma unroll
          for (int q = 0; q < 4; ++q) { acc[i][q][0] = 0.f; acc[i][q][1] = 0.f; }
#pragma unroll 1
        for (int j = 0; j < 64; ++j) {
          const float w0 = sm_w3[j], w1 = sm_w3[64 + j], w2 = sm_w3[128 + j], w3v = sm_w3[192 + j];
          const unsigned* hp = (const unsigned*)(h2b + (size_t)j * L) + tid + NTHR * i0;
#pragma unroll
          for (int i = 0; i < CHK; ++i) {
            const unsigned hv = hp[NTHR * i];
            const float h0 = __uint_as_float(hv << 16), h1 = __uint_as_float(hv & 0xffff0000u);
            acc[i][0][0] += h0 * w0; acc[i][0][1] += h1 * w0; acc[i][1][0] += h0 * w1; acc[i][1][1] += h1 * w1;
            acc[i][2][0] += h0 * w2; acc[i][2][1] += h1 * w2; acc[i][3][0] += h0 * w3v; acc[i][3][1] += h1 * w3v;
          }
        }
#pragma unroll
        for (int i = 0; i < CHK; ++i) {
          const int t0 = 2 * (tid + NTHR * (i0 + i));
          const float d0 = ex2(-(float)t0 * invLm1 * delta * LOG2E), d1 = ex2(-(float)(t0 + 1) * invLm1 * delta * LOG2E);
          const float f00 = acc[i][0][0] * d0, f01 = acc[i][0][1] * d1, b00 = acc[i][1][0] * d0, b01 = acc[i][1][1] * d1;
          const float f10 = acc[i][2][0] * d0, f11 = acc[i][2][1] * d1, b10 = acc[i][3][0] * d0, b11 = acc[i][3][1] * d1;
          *(float2*)(scrF0 + t0) = make_float2(f00, f01); *(float2*)(scrB0 + t0) = make_float2(b00, b01);
          *(float2*)(scrF1 + t0) = make_float2(f10, f11); *(float2*)(scrB1 + t0) = make_float2(b10, b11);
          asum0 += fabsf(f00) + fabsf(f01) + (t0 >= 1 ? fabsf(b00) : 0.f) + fabsf(b01);
          asum1 += fabsf(f10) + fabsf(f11) + (t0 >= 1 ? fabsf(b10) : 0.f) + fabsf(b11);
        }
      }
    }
#pragma unroll
    for (int s = 32; s >= 1; s >>= 1) { asum0 += __shfl_xor(asum0, s); asum1 += __shfl_xor(asum1, s); }
    if ((tid & 63) == 0) { sm_red[tid >> 6] = asum0; sm_red[8 + (tid >> 6)] = asum1; }
    block_sync_global();
  }
#pragma unroll 1
  for (int o = 0; o < 2; ++o) {
    float nrm = 0.f;
#pragma unroll
    for (int w = 0; w < 8; ++w) nrm += sm_red[8 * o + w];
    const float inv_nrm = 1.0f / nrm;
    const float* scrF = o ? scrF1 : scrF0;
    const float* scrB = o ? scrB1 : scrB0;
    const float sk = skp[o * 512 + c];

#pragma unroll 1
    for (int par = 0; par < 2; ++par) {
#pragma unroll 8
      for (int i = 0; i < SPT; ++i) {
        const int n = tid + NTHR * i;
        const float f = scrF[n];
        const float br = (n == 0) ? 0.f : scrB[L - n];
        float2 v;
        if (par == 0) v = make_float2((f + br) * inv_nrm, 0.f);
        else { const float gm = (f - br) * inv_nrm; const float rev = -(float)n / (float)(2 * L); v = make_float2(gm * cos_rev(rev), gm * sin_rev(rev)); }
        buf[PADI(n)] = v;
      }
      __syncthreads();
      fft_fwd<LOGN>(buf, L);
#pragma unroll 8
      for (int i = 0; i < SPT; ++i) scrS[tid + NTHR * i] = buf[PADI(tid + NTHR * i)];
      __syncthreads();
#pragma unroll 1
      for (int sub = 0; sub < NSUB; ++sub) {
        constexpr int BT = 4;
#pragma unroll 1
        for (int i0 = 0; i0 < EPT; i0 += BT) {
          float2 zz[BT];
          if (o == 0 && par == 0) {
            float ra[BT][3], rb[BT][3];
#pragma unroll
            for (int k = 0; k < BT; ++k) {
              const int e = tid + NTHR * (i0 + k); const int f = e >> LOGN, n = e & (L - 1); const int pp = sub * NB + f;
              loadu3(2 * pp, c, n, ra[k]); loadu3(2 * pp + 1, c, n, rb[k]);
            }
#pragma unroll
            for (int k = 0; k < BT; ++k) {
              const int e = tid + NTHR * (i0 + k); const int f = e >> LOGN, n = e & (L - 1); const int pp = sub * NB + f;
              zz[k] = make_float2(convw(0, ra[k]), convw(0, rb[k]));
              scrZ[(size_t)pp * L + n] = zz[k];
            }
          } else {
#pragma unroll
            for (int k = 0; k < BT; ++k) {
              const int e = tid + NTHR * (i0 + k); const int f = e >> LOGN, n = e & (L - 1); const int pp = sub * NB + f;
              zz[k] = scrZ[(size_t)pp * L + n];
            }
          }
#pragma unroll
          for (int k = 0; k < BT; ++k) {
            const int e = tid + NTHR * (i0 + k); const int n = e & (L - 1);
            float2 z = zz[k];
            if (par == 1) { const float rev = -(float)n / (float)(2 * L); z = cmul(z, make_float2(cos_rev(rev), sin_rev(rev))); }
            buf[PADI(e)] = z;
          }
        }
        __syncthreads();
        if (PROBE & 32) {
          fft_fwd<LOGN>(buf, NB * L); fft_inv<LOGN>(buf, NB * L);
          _Pragma("unroll 1") for (int i = 0; i < EPT; ++i) { const int e = tid + NTHR * i; float2 v = buf[PADI(e)]; buf[PADI(e)] = make_float2(v.x * (1.0f / L), v.y * (1.0f / L)); }
          __syncthreads();
        }
        fft_fwd<LOGN>(buf, NB * L);
#pragma unroll 1
        for (int i0 = 0; i0 < EPT; i0 += BT) {
          float2 ss[BT];
#pragma unroll
          for (int k = 0; k < BT; ++k) ss[k] = scrS[(tid + NTHR * (i0 + k)) & (L - 1)];
#pragma unroll
          for (int k = 0; k < BT; ++k) { const int e = tid + NTHR * (i0 + k); buf[PADI(e)] = cmul(buf[PADI(e)], ss[k]); }
        }
        __syncthreads();
        fft_inv<LOGN>(buf, NB * L);
        if (par == 0) {
#pragma unroll 8
          for (int i = 0; i < EPT; ++i) {
            const int e = tid + NTHR * i; const int f = e >> LOGN, n = e & (L - 1);
            scrY[(size_t)(sub * NB + f) * L + n] = buf[PADI(e)];
          }
        } else {
          const int gsel = (o == 0 ? 1 : 2);
#pragma unroll 1
          for (int i0 = 0; i0 < EPT; i0 += BT) {
            float2 ye[BT], zz[BT]; float ga[BT][3], gb[BT][3];
#pragma unroll
            for (int k = 0; k < BT; ++k) {
              const int e = tid + NTHR * (i0 + k); const int f = e >> LOGN, n = e & (L - 1); const int pp = sub * NB + f;
              ye[k] = scrY[(size_t)pp * L + n]; zz[k] = scrZ[(size_t)pp * L + n];
              loadu3(2 * pp, gsel * 512 + c, n, ga[k]); loadu3(2 * pp + 1, gsel * 512 + c, n, gb[k]);
            }
#pragma unroll
            for (int k = 0; k < BT; ++k) {
              const int e = tid + NTHR * (i0 + k); const int f = e >> LOGN, n = e & (L - 1); const int pp = sub * NB + f;
              float2 y = buf[PADI(e)];
              const float rev = -(float)n / (float)(2 * L);
              y = cmulc(y, make_float2(cos_rev(rev), sin_rev(rev)));
              const float sc = 0.5f / (float)L;
              const float c0 = (ye[k].x + y.x) * sc + sk * zz[k].x;
              const float c1 = (ye[k].y + y.y) * sc + sk * zz[k].y;
              const float z0 = convw(gsel, ga[k]) * c0;
              const float z1 = convw(gsel, gb[k]) * c1;
              if (o == 0) scrZ[(size_t)pp * L + n] = make_float2(z0, z1);
              else {
                OBt[chm_index(512, row_base + (2 * pp) * L, c) + n] = f2bf(z0);
                OBt[chm_index(512, row_base + (2 * pp + 1) * L, c) + n] = f2bf(z1);
              }
            }
          }
        }
        __syncthreads();
      }
    }
  }
}

struct WMat { const float* src; int K; int N; const float* gain; bf16_t* dst; };
DI WMat get_wmat(const Params& p, int id) {
  bf16_t* W = (bf16_t*)(p.ws + WS_W);
  WMat m;
  switch (id) {
    case 0: m = {p.in[9], 1024, 3072, p.in[5], W + W_INE}; break;
    case 1: m = {p.in[23], 1024, 1024, nullptr, W + W_OUTE}; break;
    case 2: m = {p.in[24], 1024, 2304, p.in[5] + 1024, W + W_INO}; break;
    case 3: m = {p.in[31], 1024, 1024, nullptr, W + W_OUTO}; break;
    case 4: m = {p.in[32], 1024, 256, p.in[6], W + W_Q}; break;
    case 5: m = {p.in[32] + 1024 * 256, 1024, 256, p.in[6] + 1024, W + W_Q + 256 * 1024}; break;
    case 6: m = {p.in[33], 1024, 512, p.in[7], W + W_KV}; break;
    case 7: m = {p.in[33] + 1024 * 512, 1024, 512, p.in[7] + 1024, W + W_KV + 512 * 1024}; break;
    case 8: m = {p.in[34], 256, 1024, nullptr, W + W_O}; break;
    case 9: m = {p.in[34] + 256 * 1024, 256, 1024, nullptr, W + W_O + 1024 * 256}; break;
    case 10: m = {p.in[37], 1024, 4096, p.in[8], W + W_1}; break;
    case 11: m = {p.in[37] + (size_t)1024 * 4096, 1024, 4096, p.in[8] + 1024, W + W_1 + (size_t)4096 * 1024}; break;
    case 12: m = {p.in[38], 4096, 1024, nullptr, W + W_2}; break;
    default: m = {p.in[38] + (size_t)4096 * 1024, 4096, 1024, nullptr, W + W_2 + (size_t)4096 * 1024}; break;
  }
  return m;
}

DI void prep_wtile(char* smem, const WMat& m, int tile) {
  float* t = (float*)smem;
  const int ntn = m.N >> 6;
  const int k0 = (tile / ntn) << 6, n0 = (tile % ntn) << 6;
  const int tid = threadIdx.x;
  __syncthreads();
  {
    const int kk = tid >> 4, n4 = (tid & 15) * 4;
#pragma unroll
    for (int i = 0; i < 2; ++i) {
      const int k = kk + 32 * i;
      float4 v = *(const float4*)(m.src + (size_t)(k0 + k) * m.N + n0 + n4);
      const float gk = m.gain ? m.gain[k0 + k] : 1.0f;
      t[k * 65 + n4] = v.x * gk; t[k * 65 + n4 + 1] = v.y * gk; t[k * 65 + n4 + 2] = v.z * gk; t[k * 65 + n4 + 3] = v.w * gk;
    }
  }
  __syncthreads();
  {
    const int n = tid >> 3, kc = tid & 7;
    uint4 u;
    u.x = pack2(t[(8 * kc) * 65 + n], t[(8 * kc + 1) * 65 + n]); u.y = pack2(t[(8 * kc + 2) * 65 + n], t[(8 * kc + 3) * 65 + n]);
    u.z = pack2(t[(8 * kc + 4) * 65 + n], t[(8 * kc + 5) * 65 + n]); u.w = pack2(t[(8 * kc + 6) * 65 + n], t[(8 * kc + 7) * 65 + n]);
    *(uint4*)(m.dst + (size_t)(n0 + n) * m.K + k0 + 8 * kc) = u;
  }
}

DI void prep_row(const float* src, bf16_t* dst, float* ssq) {
  const int lane = threadIdx.x & 63;
  float ss = 0.f;
#pragma unroll
  for (int i = 0; i < 4; ++i) {
    float4 v = *(const float4*)(src + (i * 64 + lane) * 4);
    ss += v.x * v.x + v.y * v.y + v.z * v.z + v.w * v.w;
    uint2 u; u.x = pack2(v.x, v.y); u.y = pack2(v.z, v.w);
    *(uint2*)(dst + (i * 64 + lane) * 4) = u;
  }
#pragma unroll
  for (int s = 32; s >= 1; s >>= 1) ss += __shfl_xor(ss, s);
  if (lane == 0) *ssq = ss;
}

DI void prep_h2(const Params& p, int L, int t, bf16_t* dst) {
  const int j = threadIdx.x & 63;
  const float* w1 = p.in[16]; const float* b1 = p.in[17]; const float* fr = p.in[18]; const float* w2 = p.in[19]; const float* b2 = p.in[20];
  const float t01 = (float)t / (float)(L - 1);
  const float tl = (float)t / (float)L;
  float a = t01 * w1[j] + b1[j];
#pragma unroll
  for (int k = 0; k < 8; ++k) {
    const float fk = 1e-4f + (float)k * ((7.0f - 1e-4f) / 7.0f);
    const float rev = tl * fk;
    a += cos_rev(rev) * w1[(1 + k) * 64 + j] - sin_rev(rev) * w1[(9 + k) * 64 + j];
  }
  const float h1 = sin_rev(fr[j] * a * 0.15915494309189535f);
  float a2 = b2[j];
  for (int i = 0; i < 64; ++i) a2 += __shfl(h1, i) * w2[i * 64 + j];
  dst[(size_t)j * L + t] = f2bf(sin_rev(fr[64 + j] * a2 * 0.15915494309189535f));
}

constexpr int PREP_NW = 768 + 256 + 576 + 256 + 64 + 64 + 128 + 128 + 64 + 64 + 1024 + 1024 + 1024 + 1024;
constexpr int PREP_T_ROWS = PREP_NW;
constexpr int PREP_T_MEM = PREP_T_ROWS + 8192;
constexpr int PREP_T_H2 = PREP_T_MEM + 576;
constexpr int PREP_T_MISC = PREP_T_H2 + 2304;
constexpr int PREP_TOTAL = PREP_T_MISC + 1;

DI void phase_prep(char* smem, const Params& p) {
  const int tid = threadIdx.x, wave = tid >> 6;
#pragma unroll 1
  for (int task = blockIdx.x; task < PREP_TOTAL; task += gridDim.x) {
    if (task < PREP_NW) {
      int t = task, id = 0;
      for (; id < 14; ++id) { WMat m = get_wmat(p, id); int n = (m.K >> 6) * (m.N >> 6); if (t < n) break; t -= n; }
      WMat m = get_wmat(p, id);
      prep_wtile(smem, m, t);
    } else if (task < PREP_T_MEM) {
      const int row = (task - PREP_T_ROWS) * 8 + wave;
      const float* src = (row < T_P) ? p.in[0] + (size_t)row * DM : p.in[1] + (size_t)(row - T_P) * DM;
      float* RS = (float*)(p.ws + WS_MISC + MS_RS);
      prep_row(src, (bf16_t*)(p.ws + WS_XB) + (size_t)row * DM, RS + row);
      if ((tid & 63) < 5) RS[(size_t)(1 + (tid & 63)) * T_ALL + row] = 0.f;
    } else if (task < PREP_T_H2) {
      const int row = (task - PREP_T_MEM) * 8 + wave;
      const float* src = (row < 512) ? p.in[2] + (size_t)row * DM : p.in[3] + (size_t)(row - 512) * DM;
      prep_row(src, (bf16_t*)(p.ws + WS_R1) + (size_t)row * DM, (float*)(p.ws + WS_MISC + MS_RSM) + row);
    } else if (task < PREP_T_MISC) {
      const int t = (task - PREP_T_H2) * 8 + wave;
      if (t < LP) prep_h2(p, LP, t, (bf16_t*)(p.ws + WS_MISC + MS_H2P));
      else prep_h2(p, LS, t - LP, (bf16_t*)(p.ws + WS_MISC + MS_H2S));
    } else {
      float* lut = (float*)(p.ws + WS_MISC + MS_LUT);
      for (int i = tid; i < 8 * 257; i += NTHR) {
        const int hh = i / 257, rel = (i % 257) - 128;
        const int n = rel < 0 ? -rel : rel;
        int bkt;
        if (n < 8) bkt = n; else { bkt = 2 + (31 - __clz(n * n)); if (bkt > 15) bkt = 15; }
        if (rel > 0) bkt += 16;
        lut[i] = p.in[4][bkt * 8 + hh] * LOG2E;
      }
      if (tid < 64) {
        const float* lf = p.in[12];
        float a = lf[tid] * lf[64 + tid], b = lf[128 + tid] * lf[192 + tid];
#pragma unroll
        for (int s = 32; s >= 1; s >>= 1) { a += __shfl_xor(a, s); b += __shfl_xor(b, s); }
        if (tid == 0) *(float*)(p.ws + WS_MISC + MS_LAM) = expf(a) - expf(b) + 0.2f;
      }
    }
  }
}

DI Seg seg_inproj(const Params& p, int layer, int col0, const float* rs) {
  Seg s{}; s.rs = rs; s.scale = 1.0f;
  if (layer == 0) {
    if (col0 < 512) { s.type = SEG_NORM; s.dst = (bf16_t*)(p.ws + WS_R0); s.ld = 512; s.col = col0; s.gain = p.in[10]; s.scale = QSCALE; }
    else if (col0 < 1024) { s.type = SEG_NORM; s.dst = (bf16_t*)((char*)p.out + 192 * MiB); s.ld = 512; s.col = col0 - 512; s.gain = p.in[11]; }
    else if (col0 < 1536) { s.type = SEG_CHM; s.dst = (bf16_t*)(p.ws + WS_R2); s.CH = 512; s.col = col0 - 1024; }
    else { s.type = SEG_CHM; s.dst = (bf16_t*)p.out; s.CH = 1536; s.col = col0 - 1536; }
  } else {
    if (col0 < 512) { s.type = SEG_NORM; s.dst = (bf16_t*)(p.ws + WS_R0); s.ld = 512; s.col = col0; s.gain = p.in[25]; s.scale = QSCALE; }
    else if (col0 < 1024) { s.type = SEG_NORM; s.dst = (bf16_t*)(p.ws + WS_R1); s.ld = 512; s.col = col0 - 512; s.gain = p.in[26]; }
    else if (col0 < 1536) { s.type = SEG_CHM; s.dst = (bf16_t*)(p.ws + WS_R2); s.CH = 512; s.col = col0 - 1024; }
    else if (col0 < 2048) { s.type = SEG_NORM; s.dst = (bf16_t*)(p.ws + WS_R3); s.ld = 512; s.col = col0 - 1536; s.gain = p.in[28]; s.scale = QSCALE; }
    else if (col0 < 2176) { s.type = SEG_NORM; s.dst = (bf16_t*)(p.ws + WS_KD); s.ld = 128; s.col = col0 - 2048; s.gain = p.in[29]; }
    else { s.type = SEG_CHM; s.dst = (bf16_t*)(p.ws + WS_VDT); s.CH = 128; s.col = col0 - 2176; }
  }
  return s;
}

struct SchedInproj { int xcd, jx, per, rows_per, nt_lo, nt_n;
  DI bool next(int i, SUnit& u) const { const int q = jx + i * per; if (q >= rows_per * nt_n) return false; u.m0 = (xcd * rows_per + q / nt_n) * 256; u.n0 = (nt_lo + q % nt_n) * 256; return true; } };
struct SchedOne { int m0, n0; bool valid;
  DI bool next(int i, SUnit& u) const { if (i > 0 || !valid) return false; u.m0 = m0; u.n0 = n0; return true; } };
struct SchedRow { int m0, n;
  DI bool next(int i, SUnit& u) const { if (i >= n) return false; u.m0 = m0; u.n0 = i * 256; return true; } };

DI void phase_inproj(char* smem, const Params& p, int layer) {
  const bf16_t* W = (const bf16_t*)(p.ws + WS_W);
  const int nxg = (gridDim.x >= 8 && (gridDim.x & 7) == 0) ? 8 : 1;
  {
    GemmArgs ga{(const bf16_t*)(p.ws + WS_XB), nullptr, 1 << 30, DM, W + (layer == 0 ? W_INE : W_INO), DM, DM};
    const int xc = blockIdx.x % nxg, jx = blockIdx.x / nxg, per = gridDim.x / nxg, rp = 256 / nxg;
    const float* rs = (const float*)(p.ws + WS_MISC + MS_RS) + (size_t)(layer * 3) * T_ALL;
    auto sf = [&](const SUnit& u, int wc) -> Seg { return seg_inproj(p, layer, u.n0 + 64 * wc, rs); };
    if (layer == 0) {
      gemm_stream<false>(ga, SchedInproj{xc, jx, per, rp, 0, 4}, sf);
      gemm_stream<true>(ga, SchedInproj{xc, jx, per, rp, 4, 8}, sf);
    } else {
      gemm_stream<false>(ga, SchedInproj{xc, jx, per, rp, 0, 4}, sf);
      gemm_stream<true>(ga, SchedInproj{xc, jx, per, rp, 4, 2}, sf);
      gemm_stream<false>(ga, SchedInproj{xc, jx, per, rp, 6, 3}, sf);
    }
  }
  if (layer == 0) {
    const int t2 = blockIdx.x; const int l = t2 / 36, r = t2 % 36;
    GemmArgs ga{(const bf16_t*)(p.ws + WS_R1), nullptr, 1 << 30, DM, W + W_KV + (size_t)(l & 1) * 512 * 1024, DM, DM};
    auto sfm = [&](const SUnit& u, int wc) -> Seg {
      Seg s{}; s.rs = (const float*)(p.ws + WS_MISC + MS_RSM); s.scale = 1.0f;
      const int col0 = u.n0 + 64 * wc;
      if (col0 < 256) { s.type = SEG_NORM; s.dst = (bf16_t*)(p.ws + WS_MISC + MS_MK) + (size_t)l * 18 * 256 * 256; s.ld = 256; s.col = col0; s.gain = p.in[36] + l * 64; }
      else { s.type = SEG_CHMEM; s.dst = (bf16_t*)(p.ws + WS_MISC + MS_MVT) + (size_t)l * 18 * 256 * 256; s.col = col0 - 256; }
      return s; };
    gemm_stream<false>(ga, SchedOne{(r >> 1) * 256, 0, t2 < 72 && (r & 1) == 0}, sfm);
    gemm_stream<true>(ga, SchedOne{(r >> 1) * 256, 256, t2 < 72 && (r & 1) == 1}, sfm);
  }
  (void)smem;
}

DI void phase_mixer0(char* smem, const Params& p) {
#pragma unroll 1
  for (int item = blockIdx.x; item < 2048; item += gridDim.x) {
    const int kind = item >> 9, idx = item & 511;
#ifndef SUBP
#define SUBP -1
#endif
    if (kind == 0 || kind == 2) {
      if (PROBE & 4) diff_item(smem, p, (kind == 2 ? 512 : 0) + idx, true);
      diff_item(smem, p, (kind == 2 ? 512 : 0) + idx);
    } else if (kind == 1) {
      if (PROBE & 8) hyena_item<14, 1, 1>(smem, p, idx, 0);
      hyena_item<14, 1, 1>(smem, p, idx, 0);
    } else {
      if (PROBE & 8) hyena_item<11, 4, 2>(smem, p, idx, T_P);
      hyena_item<11, 4, 2>(smem, p, idx, T_P);
    }
  }
}
DI void phase_mixer1(char* smem, const Params& p) {
#pragma unroll 1
  for (int item = blockIdx.x; item < 4096; item += gridDim.x) {
    if (PROBE & 16) { if (item < 2048) na_item(smem, p, item, true); else wg_item(smem, p, item - 2048, true); }
    if (item < 2048) na_item(smem, p, item); else wg_item(smem, p, item - 2048);
  }
}

DI void phase_post(char* smem, const Params& p, int layer) {
  const bf16_t* W = (const bf16_t*)(p.ws + WS_W);
  float* RS = (float*)(p.ws + WS_MISC + MS_RS);
  bf16_t* XB = (bf16_t*)(p.ws + WS_XB);
  bf16_t* H = (bf16_t*)(p.ws + (layer == 0 ? WS_H_L0 : WS_H_L1));
  bf16_t* QM = (bf16_t*)(p.ws + WS_QM);
  const int wn = (threadIdx.x >> 6) & 1;
#pragma unroll 1
  for (int mt = blockIdx.x; mt < 256; mt += gridDim.x) {
    const int m0 = mt * 256;
    if (layer == 0) {
      const bf16_t* OBt = (const bf16_t*)(p.ws + WS_R3);
      bf16_t* OB = (bf16_t*)(p.ws + WS_R1);
      const int tid = threadIdx.x;
#pragma unroll 1
      for (int chunk = 0; chunk < 4; ++chunk) {
        __syncthreads();
        {
          const int c = tid >> 2, part = tid & 3;
          const uint4* src = (const uint4*)(OBt + chm_index(512, m0, chunk * 128 + c) + part * 64);
#pragma unroll
          for (int i = 0; i < 8; ++i) *(uint4*)(smem + c * 528 + part * 128 + i * 16) = src[i];
        }
        __syncthreads();
#pragma unroll 2
        for (int it = 0; it < 8; ++it) {
          const int item = it * NTHR + tid; const int t = item & 255, c8 = item >> 8;
          unsigned short v[8];
#pragma unroll
          for (int j = 0; j < 8; ++j) v[j] = *(const unsigned short*)(smem + (c8 * 8 + j) * 528 + t * 2);
          uint4 u; u.x = v[0] | ((unsigned)v[1] << 16); u.y = v[2] | ((unsigned)v[3] << 16); u.z = v[4] | ((unsigned)v[5] << 16); u.w = v[6] | ((unsigned)v[7] << 16);
          *(uint4*)(OB + (size_t)(m0 + t) * 512 + chunk * 128 + c8 * 8) = u;
        }
      }
      __syncthreads();
    }
#ifndef CHAINP
#define CHAINP -1
#endif
    if (CHAINP < 0 || CHAINP == 1) {
      GemmArgs ga{(const bf16_t*)(p.ws + WS_R0), (const bf16_t*)(p.ws + (layer == 0 ? WS_R1 : WS_R3)), 512, 512, W + (layer == 0 ? W_OUTE : W_OUTO), DM, DM};
      Seg s{}; s.type = SEG_RESID; s.xin0 = layer == 0 ? p.in[0] : nullptr; s.xin1 = layer == 0 ? p.in[1] : nullptr;
      s.xout = p.out; s.xb = XB; s.rs_out = RS + (size_t)(layer * 3 + 1) * T_ALL;
      gemm_stream<false>(ga, SchedRow{m0, 4}, [&](const SUnit& u, int wc) -> Seg { Seg t = s; t.col = u.n0 + 64 * wc; return t; });
    }
    block_sync_global();
    if (CHAINP < 0 || CHAINP == 2) {
      GemmArgs ga{XB, nullptr, 1 << 30, DM, W + W_Q + (size_t)layer * 256 * 1024, DM, DM};
      Seg s{}; s.type = SEG_NORM; s.rs = RS + (size_t)(layer * 3 + 1) * T_ALL; s.dst = QM; s.ld = 256; s.gain = p.in[35] + layer * 64; s.scale = QSCALE;
      gemm_stream<false>(ga, SchedRow{m0, 1}, [&](const SUnit& u, int wc) -> Seg { Seg t = s; t.col = u.n0 + 64 * wc; return t; });
    }
    block_sync_global();
    if (CHAINP < 0 || CHAINP == 3) mem_attn_tile(smem, p, layer, m0);
    block_sync_global();
    if (CHAINP < 0 || CHAINP == 4) {
      GemmArgs ga{QM, nullptr, 1 << 30, 256, W + W_O + (size_t)layer * 1024 * 256, 256, 256};
      Seg s{}; s.type = SEG_RESID; s.xout = p.out; s.xb = XB; s.rs_out = RS + (size_t)(layer * 3 + 2) * T_ALL;
      gemm_stream<false>(ga, SchedRow{m0, 4}, [&](const SUnit& u, int wc) -> Seg { Seg t = s; t.col = u.n0 + 64 * wc; return t; });
    }
    block_sync_global();
    if (CHAINP < 0 || CHAINP == 5) _Pragma("unroll 1") for (int hc = 0; hc < 4; ++hc) {
      {
        GemmArgs ga{XB, nullptr, 1 << 30, DM, W + W_1 + (size_t)layer * 4096 * 1024 + (size_t)hc * 1024 * 1024, DM, DM};
        Seg s{}; s.type = SEG_MLP1; s.rs = RS + (size_t)(layer * 3 + 2) * T_ALL; s.dst = H; s.ld = 1024;
        gemm_stream<false>(ga, SchedRow{m0, 4}, [&](const SUnit& u, int wc) -> Seg { Seg t = s; t.col = u.n0 + 64 * wc; return t; });
      }
      block_sync_global();
      {
        GemmArgs ga{H, nullptr, 1 << 30, 1024, W + W_2 + (size_t)layer * 4096 * 1024 + (size_t)hc * 1024, 4096, 1024};
        Seg s{}; s.type = SEG_RESID; s.xout = p.out;
        if (hc == 3 && layer == 0) { s.xb = XB; s.rs_out = RS + (size_t)3 * T_ALL; }
        gemm_stream<false>(ga, SchedRow{m0, 4}, [&](const SUnit& u, int wc) -> Seg { Seg t = s; t.col = u.n0 + 64 * wc; return t; });
      }
      block_sync_global();
    }
  }
  (void)wn;
}

__global__ void __launch_bounds__(NTHR) fwd_kernel(Params p, int ph_lo, int ph_hi) {
  extern __shared__ __attribute__((aligned(16))) char smem[];
#define RUN_PHASE(i_, call_) if (ph_lo <= (i_) && (i_) <= ph_hi) { if ((i_) > ph_lo) { __threadfence(); cg::this_grid().sync(); } call_; }
  RUN_PHASE(0, phase_prep(smem, p))
  if (PROBE & 1) { __syncthreads(); phase_prep(smem, p); }
  RUN_PHASE(1, phase_inproj(smem, p, 0))
  if (PROBE & 2) { __syncthreads(); phase_inproj(smem, p, 0); }
  RUN_PHASE(2, phase_mixer0(smem, p))
  RUN_PHASE(3, phase_post(smem, p, 0))
  RUN_PHASE(4, phase_inproj(smem, p, 1))
  if (PROBE & 2) { __syncthreads(); phase_inproj(smem, p, 1); }
  RUN_PHASE(5, phase_mixer1(smem, p))
  RUN_PHASE(6, phase_post(smem, p, 1))
}

#ifndef ONE_LAUNCH
#define ONE_LAUNCH 1
#endif

extern "C" void kernel_launch(void* const* d_in, const int* in_sizes, int n_in, void* d_out, int out_size, void* d_ws, size_t ws_size,
                              hipStream_t stream) {
  static int grid = 0;
  if (grid == 0) {
    if (n_in != 39 || ws_size < WS_NEED || out_size != T_ALL * DM) { fprintf(stderr, "kernel_launch: unexpected shapes n_in %d ws %zu out %d\n", n_in, ws_size, out_size); grid = -1; return; }
    if (hipFuncSetAttribute((const void*)fwd_kernel, hipFuncAttributeMaxDynamicSharedMemorySize, SMEM_BYTES) != hipSuccess) { fprintf(stderr, "hipFuncSetAttribute failed\n"); grid = -1; return; }
    int dev = 0, cus = 0, per_cu = 0;
    hipGetDevice(&dev);
    hipDeviceGetAttribute(&cus, hipDeviceAttributeMultiprocessorCount, dev);
    hipOccupancyMaxActiveBlocksPerMultiprocessor(&per_cu, (const void*)fwd_kernel, NTHR, SMEM_BYTES);
    if (per_cu < 1 || cus < 1) { fprintf(stderr, "occupancy query: %d blocks/CU, %d CUs\n", per_cu, cus); grid = -1; return; }
    grid = cus;
  }
  if (grid < 0) return;
  Params p{};
  for (int i = 0; i < 39; ++i) p.in[i] = (const float*)d_in[i];
  p.out = (float*)d_out; p.ws = (char*)d_ws;
#if ONE_LAUNCH
  int lo = 0, hi = 6;
  void* args[] = {&p, &lo, &hi};
  hipError_t e = hipLaunchCooperativeKernel((const void*)fwd_kernel, dim3(grid), dim3(NTHR), args, SMEM_BYTES, stream);
  if (e != hipSuccess) fprintf(stderr, "cooperative launch failed: %s\n", hipGetErrorString(e));
#else
  for (int ph = 0; ph <= 6; ++ph) hipLaunchKernelGGL(fwd_kernel, dim3(grid), dim3(NTHR), SMEM_BYTES, stream, p, ph, ph);
#endif
}
```

```cpp
#include <hip/hip_runtime.h>
#include <hip/hip_cooperative_groups.h>
#include <cstdio>
namespace cg = cooperative_groups;

#define DI __device__ __forceinline__
#define PROBE 0
typedef unsigned short bf16_t;
using bf16x8 = __attribute__((ext_vector_type(8))) short;
using s16x4 = __attribute__((ext_vector_type(4))) short;
using f32x4 = __attribute__((ext_vector_type(4))) float;
#define MFMA16(a, b, c) __builtin_amdgcn_mfma_f32_16x16x32_bf16((a), (b), (c), 0, 0, 0)

constexpr int NTHR = 512;
constexpr int T_ALL = 65536;
constexpr int T_P = 32768;
constexpr int LP = 16384, LS = 2048;
constexpr int DM = 1024;
constexpr float EPS = 1e-6f;
constexpr float LOG2E = 1.4426950408889634f;
constexpr float QSCALE = 0.125f * 1.4426950408889634f;
constexpr int SMEM_BYTES = 144 * 1024;
constexpr size_t MiB = (size_t)1 << 20;

constexpr size_t WS_XB = 0;
constexpr size_t WS_W = 128 * MiB;
constexpr size_t W_INE = 0;
constexpr size_t W_OUTE = W_INE + (size_t)3072 * 1024;
constexpr size_t W_INO = W_OUTE + (size_t)1024 * 1024;
constexpr size_t W_OUTO = W_INO + (size_t)2304 * 1024;
constexpr size_t W_Q = W_OUTO + (size_t)1024 * 1024;
constexpr size_t W_KV = W_Q + (size_t)2 * 256 * 1024;
constexpr size_t W_O = W_KV + (size_t)2 * 512 * 1024;
constexpr size_t W_1 = W_O + (size_t)2 * 1024 * 256;
constexpr size_t W_2 = W_1 + (size_t)2 * 4096 * 1024;
constexpr size_t W_END = W_2 + (size_t)2 * 4096 * 1024;
static_assert(W_END * 2 <= 51 * MiB, "weights");
constexpr size_t WS_MISC = 179 * MiB;
constexpr size_t MS_RS = 0;
constexpr size_t MS_RSM = MS_RS + (size_t)6 * T_ALL * 4;
constexpr size_t MS_MK = MS_RSM + 32768;
constexpr size_t MS_MVT = MS_MK + (size_t)2 * 18 * 256 * 256 * 2;
constexpr size_t MS_H2P = MS_MVT + (size_t)2 * 18 * 256 * 256 * 2;
constexpr size_t MS_H2S = MS_H2P + (size_t)LP * 64 * 4;
constexpr size_t MS_LUT = MS_H2S + (size_t)LS * 64 * 4;
constexpr size_t MS_LAM = MS_LUT + 16384;
constexpr size_t MS_END = MS_LAM + 256;
static_assert(MS_END <= 16 * MiB, "misc");
constexpr size_t WS_R0 = 195 * MiB;
constexpr size_t WS_R1 = 259 * MiB;
constexpr size_t WS_R2 = 323 * MiB;
constexpr size_t WS_R3 = 387 * MiB;
constexpr size_t WS_KD = 451 * MiB;
constexpr size_t WS_VDT = 467 * MiB;
constexpr size_t WS_QM = 451 * MiB;
constexpr size_t WS_H_L0 = 323 * MiB;
constexpr size_t WS_H_L1 = 259 * MiB;
constexpr size_t WS_NEED = 512 * MiB;
constexpr size_t HY_SCR_PER_BLOCK = 512 * 1024;

struct Params {
  const float* in[39];
  float* out;
  char* ws;
};

DI unsigned short f2bf(float x) { unsigned u = __float_as_uint(x); u += 0x7fffu + ((u >> 16) & 1u); return (unsigned short)(u >> 16); }
typedef __bf16 bf16v2_t __attribute__((ext_vector_type(2)));
typedef float f32v2_t __attribute__((ext_vector_type(2)));
DI unsigned pack2(float a, float b) { f32v2_t f = {a, b}; bf16v2_t h = __builtin_convertvector(f, bf16v2_t); return __builtin_bit_cast(unsigned, h); }
DI float bf2f(unsigned short h) { return __uint_as_float(((unsigned)h) << 16); }
DI float ex2(float x) { return __builtin_amdgcn_exp2f(x); }
DI float sin_rev(float r) { return __builtin_amdgcn_sinf(r); }
DI float cos_rev(float r) { return __builtin_amdgcn_cosf(r); }
DI int opaque(int x) { asm volatile("" : "+v"(x)); return x; }
DI float dpp_f(float v, int ctrl_sel) {
  int x = __float_as_int(v), r;
  if (ctrl_sel == 0) r = __builtin_amdgcn_update_dpp(x, x, 0xB1, 0xF, 0xF, false);
  else if (ctrl_sel == 1) r = __builtin_amdgcn_update_dpp(x, x, 0x4E, 0xF, 0xF, false);
  else if (ctrl_sel == 2) r = __builtin_amdgcn_update_dpp(x, x, 0x141, 0xF, 0xF, false);
  else r = __builtin_amdgcn_update_dpp(x, x, 0x140, 0xF, 0xF, false);
  return __int_as_float(r);
}
DI float row16_sum(float v) { v += dpp_f(v, 0); v += dpp_f(v, 1); v += dpp_f(v, 2); v += dpp_f(v, 3); return v; }
DI void block_sync_global() { __syncthreads(); }

DI size_t chm_index(int CH, int row, int ch) {
  if (row < T_P) { int b = row >> 14, t = row & (LP - 1); return ((size_t)(b * CH + ch) << 14) + t; }
  int r = row - T_P; int b = r >> 11, t = r & (LS - 1);
  return (size_t)T_P * CH + ((size_t)(b * CH + ch) << 11) + t;
}

struct GemmArgs {
  const bf16_t* A0; const bf16_t* A1; int ksplit; int lda;
  const bf16_t* Wt; int ldw; int K;
};
enum { SEG_NORM = 0, SEG_CHM = 1, SEG_CHMEM = 2, SEG_RESID = 3, SEG_MLP1 = 4 };
struct Seg {
  int type;
  bf16_t* dst; int ld; int col;
  const float* gain; float scale;
  int CH;
  const float* rs;
  const float* xin0; const float* xin1; float* xout; bf16_t* xb; float* rs_out;
};
constexpr int G_TILE_B = 256 * 64 * 2, G_STAGE_B = 2 * G_TILE_B;
DI int g_lds_byte(int r, int c) { int st = (r >> 4) * 2 + (c >> 5), ob = (r & 15) * 64 + (c & 31) * 2; return st * 1024 + (ob ^ (((ob >> 9) & 1) << 5)); }
DI void g_stage_rc(int b, int& R, int& C) { int st = b >> 10, sb = b & 1023, swz = sb ^ (((sb >> 9) & 1) << 5); R = (st >> 1) * 16 + swz / 64; C = (st & 1) * 32 + (swz % 64) / 2; }
#define WAIT_V0() asm volatile("s_waitcnt vmcnt(0)" ::: "memory")

DI void gemm_tile(char* smem_generic, const GemmArgs& ga, int m0, int n0, const Seg& sg) {
  extern __shared__ __attribute__((aligned(16))) char shm[];
  (void)smem_generic;
  const int tid = opaque((int)threadIdx.x), lane = tid & 63, wid = tid >> 6;
  const int l16 = lane & 15, g = lane >> 4;
  const int wr = wid >> 2, wc = wid & 3;
  int sR[4], sC[4];
#pragma unroll
  for (int i = 0; i < 4; ++i) g_stage_rc(wid * 1024 + i * 8192 + lane * 16, sR[i], sC[i]);
  const int KT = ga.K >> 6;
#define G_STAGE(buf_, kt_) do { const int k0_ = (kt_) << 6; \
    const bf16_t* Ab_ = (k0_ < ga.ksplit) ? ga.A0 + k0_ : ga.A1 + (k0_ - ga.ksplit); \
    _Pragma("unroll") for (int i = 0; i < 4; ++i) { \
      __builtin_amdgcn_global_load_lds((const unsigned*)(Ab_ + (size_t)(m0 + sR[i]) * ga.lda + sC[i]), (__attribute__((address_space(3))) unsigned*)(shm + (buf_) * G_STAGE_B + wid * 1024 + i * 8192), 16, 0, 0); \
      __builtin_amdgcn_global_load_lds((const unsigned*)(ga.Wt + (size_t)(n0 + sR[i]) * ga.ldw + k0_ + sC[i]), (__attribute__((address_space(3))) unsigned*)(shm + (buf_) * G_STAGE_B + G_TILE_B + wid * 1024 + i * 8192), 16, 0, 0); } } while (0)
  f32x4 acc[8][4];
#pragma unroll
  for (int i = 0; i < 8; ++i)
#pragma unroll
    for (int j = 0; j < 4; ++j) acc[i][j] = (f32x4){0.f, 0.f, 0.f, 0.f};
  float* rs_lds = (float*)(shm + 143360);
  G_STAGE(0, 0);
  if (sg.rs && tid < 256) rs_lds[tid] = rsqrtf(sg.rs[m0 + tid] * (1.0f / 1024.0f) + EPS);
  WAIT_V0(); __syncthreads();
#pragma unroll 1
  for (int t = 0; t < KT; ++t) {
    const int cur = t & 1;
    if (t + 1 < KT) G_STAGE(cur ^ 1, t + 1);
    const char* SAp = shm + cur * G_STAGE_B; const char* SBp = SAp + G_TILE_B;
#pragma unroll
    for (int ks = 0; ks < 2; ++ks) {
      bf16x8 At[8], Bf[4];
#pragma unroll
      for (int m = 0; m < 8; ++m) At[m] = *(const bf16x8*)(SAp + g_lds_byte(wr * 128 + m * 16 + l16, ks * 32 + g * 8));
#pragma unroll
      for (int n = 0; n < 4; ++n) Bf[n] = *(const bf16x8*)(SBp + g_lds_byte(wc * 64 + n * 16 + l16, ks * 32 + g * 8));
#pragma unroll
      for (int m = 0; m < 8; ++m)
#pragma unroll
        for (int n = 0; n < 4; ++n) acc[m][n] = MFMA16(At[m], Bf[n], acc[m][n]);
      __builtin_amdgcn_sched_barrier(0);
    }
    WAIT_V0(); __syncthreads();
  }
  const int rbase = m0 + 128 * wr + 4 * g;
  if (sg.rs) {
#pragma unroll
    for (int m = 0; m < 8; ++m)
#pragma unroll
      for (int r = 0; r < 4; ++r) {
        const float sc = rs_lds[128 * wr + 4 * g + 16 * m + r];
#pragma unroll
        for (int n = 0; n < 4; ++n) acc[m][n][r] *= sc;
      }
  }
  if (sg.type == SEG_NORM) {
    float gn[4];
#pragma unroll
    for (int n = 0; n < 4; ++n) gn[n] = sg.gain[16 * n + l16] * sg.scale;
#pragma unroll
    for (int m = 0; m < 8; ++m) {
#pragma unroll
      for (int r = 0; r < 4; ++r) {
        float ss = 0.f;
#pragma unroll
        for (int n = 0; n < 4; ++n) ss += acc[m][n][r] * acc[m][n][r];
        ss = row16_sum(ss);
        const float sc = rsqrtf(ss * (1.0f / 64.0f) + EPS);
        bf16_t* d = sg.dst + (size_t)(rbase + 16 * m + r) * sg.ld + sg.col + l16;
#pragma unroll
        for (int n = 0; n < 4; ++n) d[16 * n] = f2bf(acc[m][n][r] * sc * gn[n]);
      }
      __builtin_amdgcn_sched_barrier(0);
    }
  } else if (sg.type == SEG_CHM || sg.type == SEG_CHMEM) {
#pragma unroll
    for (int m = 0; m < 8; ++m) {
#pragma unroll
      for (int n = 0; n < 4; ++n) {
        const int row = rbase + 16 * m; const int ch = sg.col + l16 + 16 * n;
        size_t off;
        if (sg.type == SEG_CHM) off = chm_index(sg.CH, row, ch);
        else off = ((size_t)((row >> 8) * 256 + ch) << 8) + (row & 255);
        uint2 v; v.x = pack2(acc[m][n][0], acc[m][n][1]); v.y = pack2(acc[m][n][2], acc[m][n][3]);
        *(uint2*)(sg.dst + off) = v;
      }
      __builtin_amdgcn_sched_barrier(0);
    }
  } else {
    float* Cs = (float*)shm;
    const int rr = tid >> 5, c4 = (tid & 31) * 4;
#pragma unroll 1
    for (int half = 0; half < 2; ++half) {
      if ((wc >> 1) == half) {
#pragma unroll
        for (int m = 0; m < 8; ++m)
#pragma unroll
          for (int n = 0; n < 4; ++n)
#pragma unroll
            for (int r = 0; r < 4; ++r) Cs[(128 * wr + 16 * m + 4 * g + r) * 132 + 64 * (wc & 1) + 16 * n + l16] = acc[m][n][r];
      }
      __syncthreads();
      const int cg = sg.col + 128 * half + c4;
      if (sg.type == SEG_MLP1) {
#pragma unroll 4
        for (int it = 0; it < 16; ++it) {
          const int lr = it * 16 + rr; const int row = m0 + lr;
          f32x4 v = *(const f32x4*)(Cs + lr * 132 + c4);
          v[0] = fmaxf(v[0], 0.f); v[1] = fmaxf(v[1], 0.f); v[2] = fmaxf(v[2], 0.f); v[3] = fmaxf(v[3], 0.f);
          uint2 u; u.x = pack2(v[0] * v[0], v[1] * v[1]); u.y = pack2(v[2] * v[2], v[3] * v[3]);
          *(uint2*)(sg.dst + (size_t)row * sg.ld + cg) = u;
        }
      } else {
#pragma unroll 1
        for (int it0 = 0; it0 < 16; it0 += 8) {
          f32x4 xv[8];
#pragma unroll
          for (int k = 0; k < 8; ++k) {
            const int row = m0 + (it0 + k) * 16 + rr;
            const float* xo;
            if (sg.xin0) xo = (row < T_P) ? sg.xin0 + (size_t)row * DM : sg.xin1 + (size_t)(row - T_P) * DM;
            else xo = sg.xout + (size_t)row * DM;
            xv[k] = *(const f32x4*)(xo + cg);
          }
#pragma unroll
          for (int k = 0; k < 8; ++k) {
            const int lr = (it0 + k) * 16 + rr; const int row = m0 + lr;
            f32x4 v = *(const f32x4*)(Cs + lr * 132 + c4);
            v += xv[k];
            *(f32x4*)(sg.xout + (size_t)row * DM + cg) = v;
            if (sg.xb) { uint2 u; u.x = pack2(v[0], v[1]); u.y = pack2(v[2], v[3]); *(uint2*)(sg.xb + (size_t)row * DM + cg) = u; }
            if (sg.rs_out) {
              float ss = v[0] * v[0] + v[1] * v[1] + v[2] * v[2] + v[3] * v[3];
              ss = row16_sum(ss); ss += __shfl_xor(ss, 16);
              if ((tid & 31) == 0) atomicAdd(sg.rs_out + row, ss);
            }
          }
        }
      }
      __syncthreads();
    }
  }
}

#define LAS3 __attribute__((address_space(3)))
constexpr int S8_HTB = 128 * 64 * 2;
DI int s8_perm32(int rho) { const int n = rho >> 4, i = rho & 15; return 8 * (i >> 2) + 4 * n + (i & 3); }
struct SUnit { int m0, n0; };

template <bool NAT>
DI void s8_mma(f32x4 (&acc)[4][2], const bf16x8 (&At)[4][2], const bf16x8 (&Bt)[2][2]) {
  __builtin_amdgcn_s_setprio(1);
#pragma unroll
  for (int m = 0; m < 4; ++m)
#pragma unroll
    for (int n = 0; n < 2; ++n)
#pragma unroll
      for (int k = 0; k < 2; ++k) acc[m][n] = NAT ? MFMA16(At[m][k], Bt[n][k], acc[m][n]) : MFMA16(Bt[n][k], At[m][k], acc[m][n]);
  __builtin_amdgcn_s_setprio(0);
}

template <bool NAT>
DI void s8_epilogue(const f32x4 (&acc)[2][2][4][2], const Seg& sg, int m0, int wr, int fr, int fq) {
  if (!NAT && sg.type == SEG_NORM) {
    float gn[2][8];
#pragma unroll
    for (int bj = 0; bj < 2; ++bj)
#pragma unroll
      for (int k = 0; k < 8; ++k) gn[bj][k] = sg.gain[32 * bj + 8 * fq + k] * sg.scale;
#pragma unroll
    for (int ai = 0; ai < 2; ++ai)
#pragma unroll
      for (int m = 0; m < 4; ++m) {
        const int row = m0 + 128 * ai + 64 * wr + 16 * m + fr;
        float ss = 0.f;
#pragma unroll
        for (int bj = 0; bj < 2; ++bj)
#pragma unroll
          for (int n = 0; n < 2; ++n)
#pragma unroll
            for (int j = 0; j < 4; ++j) ss += acc[ai][bj][m][n][j] * acc[ai][bj][m][n][j];
        ss += __shfl_xor(ss, 16); ss += __shfl_xor(ss, 32);
        const float sc = rsqrtf(ss * (1.0f / 64.0f) + EPS);
#pragma unroll
        for (int bj = 0; bj < 2; ++bj) {
          uint4 u;
          u.x = pack2(acc[ai][bj][m][0][0] * sc * gn[bj][0], acc[ai][bj][m][0][1] * sc * gn[bj][1]);
          u.y = pack2(acc[ai][bj][m][0][2] * sc * gn[bj][2], acc[ai][bj][m][0][3] * sc * gn[bj][3]);
          u.z = pack2(acc[ai][bj][m][1][0] * sc * gn[bj][4], acc[ai][bj][m][1][1] * sc * gn[bj][5]);
          u.w = pack2(acc[ai][bj][m][1][2] * sc * gn[bj][6], acc[ai][bj][m][1][3] * sc * gn[bj][7]);
          *(uint4*)(sg.dst + (size_t)row * sg.ld + sg.col + 32 * bj + 8 * fq) = u;
        }
        __builtin_amdgcn_sched_barrier(0);
      }
  } else if (NAT) {
#pragma unroll
    for (int ai = 0; ai < 2; ++ai)
#pragma unroll
      for (int m = 0; m < 4; ++m) {
        const int row = m0 + 128 * ai + 64 * wr + 16 * m + 4 * fq;
        const f32x4 rv = *(const f32x4*)(sg.rs + row);
        f32x4 sc;
#pragma unroll
        for (int j = 0; j < 4; ++j) sc[j] = rsqrtf(rv[j] * (1.0f / 1024.0f) + EPS);
#pragma unroll
        for (int bj = 0; bj < 2; ++bj)
#pragma unroll
          for (int n = 0; n < 2; ++n) {
            const int ch = sg.col + 32 * bj + 8 * (fr >> 2) + 4 * n + (fr & 3);
            size_t off;
            if (sg.type == SEG_CHM) off = chm_index(sg.CH, row, ch);
            else off = ((size_t)((row >> 8) * 256 + ch) << 8) + (row & 255);
            const f32x4 v = acc[ai][bj][m][n] * sc;
            uint2 u; u.x = pack2(v[0], v[1]); u.y = pack2(v[2], v[3]);
            *(uint2*)(sg.dst + off) = u;
          }
        __builtin_amdgcn_sched_barrier(0);
      }
  } else if (sg.type == SEG_CHM) {
#pragma unroll
    for (int ai = 0; ai < 2; ++ai)
#pragma unroll
      for (int m = 0; m < 4; ++m) {
        const int row = m0 + 128 * ai + 64 * wr + 16 * m + fr;
        const float sc = rsqrtf(sg.rs[row] * (1.0f / 1024.0f) + EPS);
#pragma unroll
        for (int bj = 0; bj < 2; ++bj)
#pragma unroll
          for (int n = 0; n < 2; ++n)
#pragma unroll
            for (int j = 0; j < 4; ++j) sg.dst[chm_index(sg.CH, row, sg.col + 32 * bj + 8 * fq + 4 * n + j)] = f2bf(acc[ai][bj][m][n][j] * sc);
        __builtin_amdgcn_sched_barrier(0);
      }
  } else if (sg.type == SEG_MLP1) {
#pragma unroll
    for (int ai = 0; ai < 2; ++ai) {
      float sc[4];
#pragma unroll
      for (int m = 0; m < 4; ++m) sc[m] = rsqrtf(sg.rs[m0 + 128 * ai + 64 * wr + 16 * m + fr] * (1.0f / 1024.0f) + EPS);
#pragma unroll
      for (int m = 0; m < 4; ++m) {
        const int row = m0 + 128 * ai + 64 * wr + 16 * m + fr;
#pragma unroll
        for (int bj = 0; bj < 2; ++bj) {
          f32x4 a = acc[ai][bj][m][0] * sc[m], b = acc[ai][bj][m][1] * sc[m];
#pragma unroll
          for (int j = 0; j < 4; ++j) { a[j] = fmaxf(a[j], 0.f); a[j] *= a[j]; b[j] = fmaxf(b[j], 0.f); b[j] *= b[j]; }
          uint4 u; u.x = pack2(a[0], a[1]); u.y = pack2(a[2], a[3]); u.z = pack2(b[0], b[1]); u.w = pack2(b[2], b[3]);
          *(uint4*)(sg.dst + (size_t)row * sg.ld + sg.col + 32 * bj + 8 * fq) = u;
        }
        __builtin_amdgcn_sched_barrier(0);
      }
    }
  } else {
#pragma unroll
    for (int ai = 0; ai < 2; ++ai)
#pragma unroll
      for (int mp = 0; mp < 2; ++mp) {
        f32x4 xv[2][2][2];
#pragma unroll
        for (int mm = 0; mm < 2; ++mm) {
          const int row = m0 + 128 * ai + 64 * wr + 16 * (2 * mp + mm) + fr;
          const float* xo;
          if (sg.xin0) xo = (row < T_P) ? sg.xin0 + (size_t)row * DM : sg.xin1 + (size_t)(row - T_P) * DM;
          else xo = sg.xout + (size_t)row * DM;
#pragma unroll
          for (int bj = 0; bj < 2; ++bj) { xv[mm][bj][0] = *(const f32x4*)(xo + sg.col + 32 * bj + 8 * fq); xv[mm][bj][1] = *(const f32x4*)(xo + sg.col + 32 * bj + 8 * fq + 4); }
        }
#pragma unroll
        for (int mm = 0; mm < 2; ++mm) {
          const int m = 2 * mp + mm;
          const int row = m0 + 128 * ai + 64 * wr + 16 * m + fr;
          float ss = 0.f;
#pragma unroll
          for (int bj = 0; bj < 2; ++bj) {
            const f32x4 a = acc[ai][bj][m][0] + xv[mm][bj][0], b = acc[ai][bj][m][1] + xv[mm][bj][1];
            float* op = sg.xout + (size_t)row * DM + sg.col + 32 * bj + 8 * fq;
            *(f32x4*)op = a; *(f32x4*)(op + 4) = b;
            if (sg.xb) { uint4 u; u.x = pack2(a[0], a[1]); u.y = pack2(a[2], a[3]); u.z = pack2(b[0], b[1]); u.w = pack2(b[2], b[3]); *(uint4*)(sg.xb + (size_t)row * DM + sg.col + 32 * bj + 8 * fq) = u; }
#pragma unroll
            for (int j = 0; j < 4; ++j) ss += a[j] * a[j] + b[j] * b[j];
          }
          if (sg.rs_out) {
            ss += __shfl_xor(ss, 16); ss += __shfl_xor(ss, 32);
            if (fq == 0) atomicAdd(sg.rs_out + row, ss);
          }
          __builtin_amdgcn_sched_barrier(0);
        }
        __builtin_amdgcn_sched_barrier(0);
      }
  }
}

template <bool NAT, class Sched, class SegFn>
DI void gemm_stream(const GemmArgs& ga, const Sched& S, const SegFn& segfn) {
  extern __shared__ __attribute__((aligned(16))) char shm[];
  LAS3 unsigned char* lds = (LAS3 unsigned char*)shm;
  const int tid = opaque((int)threadIdx.x), wid = __builtin_amdgcn_readfirstlane(tid >> 6), lane = tid & 63, wr = wid >> 2, wc = wid & 3, fr = lane & 15, fq = lane >> 4;
  const int nt = ga.K >> 6, kst = ga.ksplit >> 6;
  unsigned voffA[2], voffB[2];
#pragma unroll
  for (int i = 0; i < 2; ++i) {
    int R, C; g_stage_rc(tid * 16 + i * 8192, R, C);
    const int Rb = ((R & ~31) << 1) + s8_perm32(R & 31);
    voffA[i] = (unsigned)(R * ga.lda + C) * 2u; voffB[i] = (unsigned)(Rb * ga.ldw + C) * 2u;
  }
  const size_t hstepA = (size_t)128 * ga.lda * 2, hstepB = (size_t)32 * ga.ldw * 2;
  const unsigned ldsw = (unsigned)wid * 1024u;
  const int aoff = g_lds_byte(wr * 64 + fr, fq * 8), boff = g_lds_byte(wc * 32 + fr, fq * 8);
#define S8_SA(b, h) (((b) * 2 + (h)) * S8_HTB)
#define S8_SB(b, h) ((4 + (b) * 2 + (h)) * S8_HTB)
#define S8_STAGE(bufoff, gbase, voff) do { _Pragma("unroll") for (int _i = 0; _i < 2; ++_i) \
    __builtin_amdgcn_global_load_lds((const unsigned*)((const char*)(gbase) + (voff)[_i]), (LAS3 unsigned*)(lds + (bufoff) + ldsw + _i * 8192), 16, 0, 0); } while (0)
#define S8_LDA(dst, b, h) do { _Pragma("unroll") for (int m = 0; m < 4; ++m) _Pragma("unroll") for (int k = 0; k < 2; ++k) dst[m][k] = *(const LAS3 bf16x8*)(lds + S8_SA(b, h) + aoff + m * 2048 + k * 1024); } while (0)
#define S8_LDB(dst, b, h) do { _Pragma("unroll") for (int n = 0; n < 2; ++n) _Pragma("unroll") for (int k = 0; k < 2; ++k) dst[n][k] = *(const LAS3 bf16x8*)(lds + S8_SB(b, h) + boff + n * 2048 + k * 1024); } while (0)
#define S8_MMA(ai, bj, At, Bt) s8_mma<NAT>(acc[ai][bj], At, Bt)
#define S8_WAIT_V(n) asm volatile("s_waitcnt vmcnt(" #n ")" ::: "memory")
#define S8_WAIT_L(n) asm volatile("s_waitcnt lgkmcnt(" #n ")" ::: "memory")
#define S8_BAR __builtin_amdgcn_s_barrier()
#define S8_SCHED __builtin_amdgcn_sched_barrier(0)
  auto aptr = [&](const SUnit& u, int t) -> const char* {
    return (const char*)((t < kst ? ga.A0 + (size_t)t * 64 : ga.A1 + (size_t)(t - kst) * 64) + (size_t)u.m0 * ga.lda);
  };
  auto bptr = [&](const SUnit& u, int t) -> const char* { return (const char*)(ga.Wt + (size_t)u.n0 * ga.ldw + (size_t)t * 64); };
  SUnit cur, nxt; int ui = 0;
  if (!S.next(0, cur)) return;
  f32x4 acc[2][2][4][2];
#pragma unroll
  for (int a = 0; a < 2; ++a)
#pragma unroll
    for (int b = 0; b < 2; ++b)
#pragma unroll
      for (int m = 0; m < 4; ++m)
#pragma unroll
        for (int n = 0; n < 2; ++n) acc[a][b][m][n] = (f32x4){0.f, 0.f, 0.f, 0.f};
  bf16x8 At[4][2], B0[2][2], B1[2][2];
  Seg seg = segfn(cur, wc);
  { const char* cA = aptr(cur, 0); const char* cB = bptr(cur, 0); const char* cA1 = aptr(cur, 1); const char* cB1 = bptr(cur, 1);
    S8_STAGE(S8_SB(0, 0), cB, voffB); S8_STAGE(S8_SA(0, 0), cA, voffA); S8_STAGE(S8_SB(0, 1), cB + hstepB, voffB); S8_STAGE(S8_SA(0, 1), cA + hstepA, voffA);
    if (wr == 1) S8_BAR;
    S8_WAIT_V(4); S8_BAR;
    S8_STAGE(S8_SB(1, 0), cB1, voffB); S8_STAGE(S8_SA(1, 0), cA1, voffA); S8_STAGE(S8_SB(1, 1), cB1 + hstepB, voffB);
    S8_WAIT_V(6); S8_BAR; }
  for (;;) {
    const bool has_next = S.next(ui + 1, nxt);
    const SUnit nu = has_next ? nxt : cur;
#pragma unroll 1
    for (int t = 0; t < nt; t += 2) {
      const bool last = (t == nt - 2);
      const char* a1 = aptr(cur, t + 1);
      const char* a2 = last ? aptr(nu, 0) : aptr(cur, t + 2); const char* b2 = last ? bptr(nu, 0) : bptr(cur, t + 2);
      const char* a3 = last ? aptr(nu, 1) : aptr(cur, t + 3); const char* b3 = last ? bptr(nu, 1) : bptr(cur, t + 3);
      S8_LDB(B0, 0, 0); S8_SCHED; S8_LDA(At, 0, 0); S8_STAGE(S8_SA(1, 1), a1 + hstepA, voffA);
      S8_WAIT_L(8); S8_BAR; S8_WAIT_L(0); S8_MMA(0, 0, At, B0); S8_BAR; S8_SCHED;
      S8_LDB(B1, 0, 1); S8_STAGE(S8_SB(0, 0), b2, voffB);
      S8_BAR; S8_WAIT_L(0); S8_MMA(0, 1, At, B1); S8_BAR;
      S8_LDA(At, 0, 1); S8_STAGE(S8_SA(0, 0), a2, voffA);
      S8_BAR; S8_WAIT_L(0); S8_MMA(1, 0, At, B0); S8_BAR; S8_SCHED;
      S8_STAGE(S8_SB(0, 1), b2 + hstepB, voffB);
      S8_WAIT_V(6); S8_BAR; S8_MMA(1, 1, At, B1); S8_BAR;
      S8_LDB(B0, 1, 0); S8_SCHED; S8_LDA(At, 1, 0); S8_STAGE(S8_SA(0, 1), a2 + hstepA, voffA);
      S8_WAIT_L(8); S8_BAR; S8_WAIT_L(0); S8_MMA(0, 0, At, B0); S8_BAR; S8_SCHED;
      S8_LDB(B1, 1, 1); S8_STAGE(S8_SB(1, 0), b3, voffB);
      S8_BAR; S8_WAIT_L(0); S8_MMA(0, 1, At, B1); S8_BAR;
      S8_LDA(At, 1, 1); S8_STAGE(S8_SA(1, 0), a3, voffA);
      S8_BAR; S8_WAIT_L(0); S8_MMA(1, 0, At, B0); S8_BAR; S8_SCHED;
      S8_STAGE(S8_SB(1, 1), b3 + hstepB, voffB);
      S8_WAIT_V(6); S8_BAR; S8_MMA(1, 1, At, B1); S8_BAR;
    }
#ifndef S8_NOEPI
    { const int lane2 = opaque((int)__builtin_amdgcn_mbcnt_hi(~0u, __builtin_amdgcn_mbcnt_lo(~0u, 0u))); s8_epilogue<NAT>(acc, seg, cur.m0, wr, lane2 & 15, lane2 >> 4); }
#else
    if (seg.type == 77) *(f32x4*)(seg.xout + fr) = acc[0][0][0][0] + acc[1][1][3][1] + acc[0][1][2][0] + acc[1][0][1][1];
#endif
    if (!has_next) break;
#pragma unroll
    for (int a = 0; a < 2; ++a)
#pragma unroll
      for (int b = 0; b < 2; ++b)
#pragma unroll
        for (int m = 0; m < 4; ++m)
#pragma unroll
          for (int n = 0; n < 2; ++n) acc[a][b][m][n] = (f32x4){0.f, 0.f, 0.f, 0.f};
    cur = nxt; ++ui;
    seg = segfn(cur, wc);
  }
  S8_WAIT_V(0);
  if (wr == 0) S8_BAR;
  S8_BAR;
}

enum { AM_MEM = 0, AM_DIFF = 1, AM_WG = 2, AM_NA = 3 };
constexpr int ATT_LUT_OFS = 73728;
constexpr int ATT_O0_OFS = 77824;

template <int VD, int MODE>
DI void attn_core(char* smem, const bf16_t* Q, int ldq, const bf16_t* K, int ldk, const bf16_t* Vt, int ldv,
                  int qpos0, int kbeg, int kend, int nrows, float sink_l2, float (&O)[2][VD / 16][4]) {
  constexpr int NDB = VD / 16;
  constexpr int STAGE = 8192 + VD * 128;
  constexpr int NL = 1 + VD / 64;
  extern __shared__ __attribute__((aligned(16))) char shm[];
  const int tid = opaque((int)threadIdx.x), lane = tid & 63, wave = tid >> 6;
  const int l16 = lane & 15, g = lane >> 4;
  const float* lut = (const float*)(smem + ATT_LUT_OFS);
  bf16x8 qf[2][2];
#pragma unroll
  for (int qb = 0; qb < 2; ++qb)
#pragma unroll
    for (int kk = 0; kk < 2; ++kk) qf[qb][kk] = *(const bf16x8*)(Q + (size_t)(32 * wave + 16 * qb + l16) * ldq + 32 * kk + 8 * g);
  float m[2] = {-1e30f, -1e30f};
  f32x4 Oa[2][NDB], Ol[2];
#pragma unroll
  for (int qb = 0; qb < 2; ++qb) {
    Ol[qb] = (f32x4){0.f, 0.f, 0.f, 0.f};
#pragma unroll
    for (int db = 0; db < NDB; ++db) Oa[qb][db] = (f32x4){0.f, 0.f, 0.f, 0.f};
  }
  bf16x8 ones;
#pragma unroll
  for (int j = 0; j < 8; ++j) ones[j] = (short)0x3F80;
  const int wq0 = qpos0 + 32 * wave;
  const int srow = 8 * wave + (lane >> 3);
  const int schunk = (lane & 7) ^ (lane >> 3);
#define ATT_ISSUE(k0_, st_) do { \
    __builtin_amdgcn_global_load_lds((const unsigned*)(K + (size_t)((k0_) + srow) * ldk + 8 * schunk), (__attribute__((address_space(3))) unsigned*)(shm + (st_) * STAGE + wave * 1024), 16, 0, 0); \
    __builtin_amdgcn_global_load_lds((const unsigned*)(Vt + (size_t)(srow) * ldv + (k0_) + 8 * schunk), (__attribute__((address_space(3))) unsigned*)(shm + (st_) * STAGE + 8192 + wave * 1024), 16, 0, 0); \
    if (VD == 128) __builtin_amdgcn_global_load_lds((const unsigned*)(Vt + (size_t)(srow + 64) * ldv + (k0_) + 8 * schunk), (__attribute__((address_space(3))) unsigned*)(shm + (st_) * STAGE + 8192 + 8192 + wave * 1024), 16, 0, 0); } while (0)
  const int ntile = (kend - kbeg) >> 6;
  ATT_ISSUE(kbeg, 0);
  if (ntile > 1) { ATT_ISSUE(kbeg + 64, 1); asm volatile("s_waitcnt vmcnt(%0)" :: "n"(NL) : "memory"); }
  else asm volatile("s_waitcnt vmcnt(0)" ::: "memory");
  __builtin_amdgcn_s_barrier();
  int it = 0, st = 0;
  for (int k0 = kbeg; k0 < kend; k0 += 64, ++it) {
    { const int st2 = (st >= 1) ? st - 1 : 2; if (it + 2 < ntile) ATT_ISSUE(k0 + 128, st2); }
    const char* Ks = shm + st * STAGE; const char* Vs = Ks + 8192;
    bool active = true;
    if (MODE == AM_WG) active = !(k0 + 63 < wq0 - 128 || k0 > wq0 + 31 + 128);
    int na_rs = 0; const int qr = wq0 >> 6, kr = k0 >> 6;
    if (MODE == AM_NA) { na_rs = min(max(qr - 4, 0), nrows - 8); active = (kr >= na_rs && kr < na_rs + 8); }
    if (active) {
      float coff = 0.f;
      bool lut_tile = false;
      if (MODE == AM_DIFF) {
        if (k0 + 63 - wq0 <= -128) coff = lut[0];
        else if (k0 - (wq0 + 31) >= 128) coff = lut[256];
        else lut_tile = true;
      }
      float nsh[2];
#pragma unroll
      for (int qb = 0; qb < 2; ++qb) nsh[qb] = (m[qb] > -1e29f) ? (coff - m[qb]) : 0.f;
      f32x4 S[2][4];
#pragma unroll
      for (int kb = 0; kb < 4; ++kb) {
        bf16x8 kf0 = *(const bf16x8*)(Ks + (16 * kb + l16) * 128 + ((g ^ (l16 & 7)) << 4));
        bf16x8 kf1 = *(const bf16x8*)(Ks + (16 * kb + l16) * 128 + (((4 + g) ^ (l16 & 7)) << 4));
#pragma unroll
        for (int qb = 0; qb < 2; ++qb) {
          f32x4 z = (f32x4){nsh[qb], nsh[qb], nsh[qb], nsh[qb]};
          z = MFMA16(kf0, qf[qb][0], z);
          S[qb][kb] = MFMA16(kf1, qf[qb][1], z);
        }
      }
#pragma unroll
      for (int qb = 0; qb < 2; ++qb) {
        const int q = wq0 + 16 * qb + l16;
        if ((MODE == AM_DIFF && lut_tile) || MODE == AM_WG) {
#pragma unroll
          for (int kb = 0; kb < 4; ++kb)
#pragma unroll
            for (int r = 0; r < 4; ++r) {
              const int rel = k0 + 16 * kb + 4 * g + r - q;
              const int rc = min(max(rel, -128), 128);
              float sv = S[qb][kb][r] + lut[rc + 128];
              if (MODE == AM_WG && (rel > 128 || rel < -128)) sv = -1e30f;
              S[qb][kb][r] = sv;
            }
        } else if (MODE == AM_NA) {
          const int qc = q & 63;
          const int cs = min(max(qc - 8, 0), 48);
          const int dr = kr - qr + 7;
#pragma unroll
          for (int kb = 0; kb < 4; ++kb)
#pragma unroll
            for (int r = 0; r < 4; ++r) {
              const int kc = 16 * kb + 4 * g + r;
              const bool ok = (kc >= cs) && (kc < cs + 16);
              const int dc = min(max(kc - qc + 15, 0), 30);
              float sv = S[qb][kb][r] + lut[dr * 31 + dc];
              S[qb][kb][r] = ok ? sv : -1e30f;
            }
        }
      }
      float mx[2];
      bool need = false;
#pragma unroll
      for (int qb = 0; qb < 2; ++qb) {
        float v = -1e30f;
#pragma unroll
        for (int kb = 0; kb < 4; ++kb) v = fmaxf(v, fmaxf(fmaxf(S[qb][kb][0], S[qb][kb][1]), fmaxf(S[qb][kb][2], S[qb][kb][3])));
        v = fmaxf(v, __shfl_xor(v, 16)); v = fmaxf(v, __shfl_xor(v, 32));
        mx[qb] = v;
        need = need || (m[qb] <= -1e29f) || (v > 8.0f);
      }
      if (__any(need)) {
#pragma unroll
        for (int qb = 0; qb < 2; ++qb) {
          const bool lf = (m[qb] <= -1e29f);
          const float delta = lf ? mx[qb] : fmaxf(mx[qb], 0.f);
          const float alpha = lf ? 0.f : ex2(-delta);
          m[qb] = lf ? (mx[qb] + coff) : (m[qb] + delta);
          Ol[qb] *= alpha;
#pragma unroll
          for (int db = 0; db < NDB; ++db) Oa[qb][db] *= alpha;
#pragma unroll
          for (int kb = 0; kb < 4; ++kb)
#pragma unroll
            for (int r = 0; r < 4; ++r) S[qb][kb][r] -= delta;
        }
      }
#pragma unroll
      for (int qb = 0; qb < 2; ++qb)
#pragma unroll
        for (int kb = 0; kb < 4; ++kb)
#pragma unroll
          for (int r = 0; r < 4; ++r) S[qb][kb][r] = ex2(S[qb][kb][r]);
#pragma unroll
      for (int ks = 0; ks < 2; ++ks) {
        bf16x8 pf[2];
#pragma unroll
        for (int qb = 0; qb < 2; ++qb) {
          uint4 u;
          u.x = pack2(S[qb][2 * ks][0], S[qb][2 * ks][1]); u.y = pack2(S[qb][2 * ks][2], S[qb][2 * ks][3]);
          u.z = pack2(S[qb][2 * ks + 1][0], S[qb][2 * ks + 1][1]); u.w = pack2(S[qb][2 * ks + 1][2], S[qb][2 * ks + 1][3]);
          pf[qb] = __builtin_bit_cast(bf16x8, u);
          Ol[qb] = MFMA16(ones, pf[qb], Ol[qb]);
        }
#pragma unroll
        for (int db = 0; db < NDB; ++db) {
          const char* vrow = Vs + (16 * db + l16) * 128 + 8 * (g & 1);
          uint2 v0 = *(const uint2*)(vrow + (((4 * ks + (g >> 1)) ^ (l16 & 7)) << 4));
          uint2 v1 = *(const uint2*)(vrow + (((4 * ks + 2 + (g >> 1)) ^ (l16 & 7)) << 4));
          uint4 u; u.x = v0.x; u.y = v0.y; u.z = v1.x; u.w = v1.y;
          bf16x8 vf = __builtin_bit_cast(bf16x8, u);
#pragma unroll
          for (int qb = 0; qb < 2; ++qb) Oa[qb][db] = MFMA16(vf, pf[qb], Oa[qb][db]);
        }
      }
    }
    if (it + 2 < ntile) asm volatile("s_waitcnt vmcnt(%0)" :: "n"(NL) : "memory");
    else asm volatile("s_waitcnt vmcnt(0)" ::: "memory");
    asm volatile("s_waitcnt lgkmcnt(0)" ::: "memory");
    __builtin_amdgcn_s_barrier();
    st = (st == 2) ? 0 : st + 1;
  }
#pragma unroll
  for (int qb = 0; qb < 2; ++qb) {
    float lt = Ol[qb][0];
    if (MODE == AM_WG) lt += ex2(sink_l2 - m[qb]);
    const float inv = 1.0f / lt;
#pragma unroll
    for (int db = 0; db < NDB; ++db)
#pragma unroll
      for (int r = 0; r < 4; ++r) O[qb][db][r] = Oa[qb][db][r] * inv;
  }
}

template <int NDB>
DI void attn_store(bf16_t* dst, int ld, const float (&O)[2][NDB][4]) {
  const int lane = threadIdx.x & 63, wave = threadIdx.x >> 6, l16 = lane & 15, g = lane >> 4;
#pragma unroll
  for (int qb = 0; qb < 2; ++qb)
#pragma unroll
    for (int db = 0; db < NDB; ++db) {
      uint2 v; v.x = pack2(O[qb][db][0], O[qb][db][1]); v.y = pack2(O[qb][db][2], O[qb][db][3]);
      *(uint2*)(dst + (size_t)(32 * wave + 16 * qb + l16) * ld + 16 * db + 4 * g) = v;
    }
}

DI void seq_of_row(int row0, int& L, int& seq_row0, int& b_glob) {
  if (row0 < T_P) { L = LP; int b = row0 >> 14; seq_row0 = b << 14; b_glob = b; }
  else { L = LS; int b = (row0 - T_P) >> 11; seq_row0 = T_P + (b << 11); b_glob = 2 + b; }
}

DI void diff_item(char* smem, const Params& p, int item, bool dry = false) {
  bf16_t* QA = (bf16_t*)(p.ws + WS_R0);
  const bf16_t* KA = (const bf16_t*)((const char*)p.out + 192 * MiB);
  const bf16_t* VAt = (const bf16_t*)(p.ws + WS_R2);
  const float* misc_lut = (const float*)(p.ws + WS_MISC + MS_LUT);
  const float lam = *(const float*)(p.ws + WS_MISC + MS_LAM);
  int h, row0;
  if (item < 512) { h = item & 3; row0 = (item >> 2) * 256; }
  else { int i2 = item - 512; h = i2 & 3; row0 = T_P + (i2 >> 2) * 256; }
  int L, srow0, bg; seq_of_row(row0, L, srow0, bg);
  const int qpos0 = row0 - srow0;
  const bf16_t* Vt = VAt + chm_index(512, srow0, h * 128);
  float O[2][8][4];
  unsigned* o0s = (unsigned*)(smem + ATT_O0_OFS) + threadIdx.x;
  const int tid = threadIdx.x;
#pragma unroll 1
  for (int mp = 0; mp < 2; ++mp) {
    __syncthreads();
    for (int i = tid; i < 257; i += NTHR) ((float*)(smem + ATT_LUT_OFS))[i] = misc_lut[(h * 2 + mp) * 257 + i];
    __syncthreads();
    attn_core<128, AM_DIFF>(smem, QA + (size_t)row0 * 512 + h * 128 + mp * 64, 512, KA + (size_t)srow0 * 512 + h * 128 + mp * 64, 512,
                            Vt, L, qpos0, 0, L, 0, 0.f, O);
    if (mp == 0) {
#pragma unroll
      for (int qb = 0; qb < 2; ++qb)
#pragma unroll
        for (int db = 0; db < 8; ++db) { o0s[((qb * 8 + db) * 2) * NTHR] = pack2(O[qb][db][0], O[qb][db][1]); o0s[((qb * 8 + db) * 2 + 1) * NTHR] = pack2(O[qb][db][2], O[qb][db][3]); }
    }
  }
  const int tid2 = opaque((int)threadIdx.x);
  const int lane = tid2 & 63, l16 = lane & 15, g = lane >> 4;
  const float* sg = p.in[13];
#pragma unroll
  for (int qb = 0; qb < 2; ++qb) {
    float ss = 0.f;
#pragma unroll
    for (int db = 0; db < 8; ++db) {
      const unsigned w0 = o0s[((qb * 8 + db) * 2) * NTHR], w1 = o0s[((qb * 8 + db) * 2 + 1) * NTHR];
      float a0 = bf2f((unsigned short)(w0 & 0xffff)), a1 = bf2f((unsigned short)(w0 >> 16));
      float a2 = bf2f((unsigned short)(w1 & 0xffff)), a3 = bf2f((unsigned short)(w1 >> 16));
      O[qb][db][0] = a0 - lam * O[qb][db][0]; O[qb][db][1] = a1 - lam * O[qb][db][1];
      O[qb][db][2] = a2 - lam * O[qb][db][2]; O[qb][db][3] = a3 - lam * O[qb][db][3];
#pragma unroll
      for (int r = 0; r < 4; ++r) ss += O[qb][db][r] * O[qb][db][r];
    }
    ss += __shfl_xor(ss, 16); ss += __shfl_xor(ss, 32);
    const float sc = rsqrtf(ss * (1.0f / 128.0f) + EPS) * 0.8f;
#pragma unroll
    for (int db = 0; db < 8; ++db)
#pragma unroll
      for (int r = 0; r < 4; ++r) O[qb][db][r] *= sc * sg[16 * db + 4 * g + r];
  }
  if (dry) attn_store<8>((bf16_t*)(p.ws + 484 * MiB), 512, O); else attn_store<8>(QA + (size_t)row0 * 512 + h * 128, 512, O);
}

DI void wg_item(char* smem, const Params& p, int item, bool dry = false) {
  bf16_t* QD = (bf16_t*)(p.ws + WS_R3);
  const bf16_t* KD = (const bf16_t*)(p.ws + WS_KD);
  const bf16_t* VDt = (const bf16_t*)(p.ws + WS_VDT);
  const float* misc_lut = (const float*)(p.ws + WS_MISC + MS_LUT);
  const int hq = item & 7; const int row0 = (item >> 3) * 256;
  int L, srow0, bg; seq_of_row(row0, L, srow0, bg);
  const int qpos0 = row0 - srow0;
  const int kvh = hq >> 2;
  __syncthreads();
  for (int i = threadIdx.x; i < 257; i += NTHR) ((float*)(smem + ATT_LUT_OFS))[i] = misc_lut[hq * 257 + i];
  __syncthreads();
  float O[2][4][4];
  const int kbeg = max(0, qpos0 - 128), kend = min(L, qpos0 + 256 + 128);
  attn_core<64, AM_WG>(smem, QD + (size_t)row0 * 512 + hq * 64, 512, KD + (size_t)srow0 * 128 + kvh * 64, 128,
                       VDt + chm_index(128, srow0, kvh * 64), L, qpos0, kbeg, kend, 0, p.in[30][hq] * LOG2E, O);
  if (dry) attn_store<4>((bf16_t*)(p.ws + 484 * MiB), 512, O); else attn_store<4>(QD + (size_t)row0 * 512 + hq * 64, 512, O);
}

DI void na_item(char* smem, const Params& p, int item, bool dry = false) {
  bf16_t* QC = (bf16_t*)(p.ws + WS_R0);
  const bf16_t* KC = (const bf16_t*)(p.ws + WS_R1);
  const bf16_t* VCt = (const bf16_t*)(p.ws + WS_R2);
  const int h = item & 7; const int row0 = (item >> 3) * 256;
  int L, srow0, bg; seq_of_row(row0, L, srow0, bg);
  const int qpos0 = row0 - srow0;
  const int nrows = L >> 6;
  __syncthreads();
  for (int i = threadIdx.x; i < 465; i += NTHR) ((float*)(smem + ATT_LUT_OFS))[i] = p.in[27][h * 465 + i] * LOG2E;
  __syncthreads();
  const int qr0 = qpos0 >> 6;
  const int rs0 = min(max(qr0 - 4, 0), nrows - 8), rs3 = min(max(qr0 + 3 - 4, 0), nrows - 8);
  float O[2][4][4];
  attn_core<64, AM_NA>(smem, QC + (size_t)row0 * 512 + h * 64, 512, KC + (size_t)srow0 * 512 + h * 64, 512,
                       VCt + chm_index(512, srow0, h * 64), L, qpos0, rs0 * 64, (rs3 + 8) * 64, nrows, 0.f, O);
  if (dry) attn_store<4>((bf16_t*)(p.ws + 484 * MiB), 512, O); else attn_store<4>(QC + (size_t)row0 * 512 + h * 64, 512, O);
}

DI void mem_attn_tile(char* smem, const Params& p, int layer, int row0) {
  bf16_t* QM = (bf16_t*)(p.ws + WS_QM);
  const bf16_t* MK = (const bf16_t*)(p.ws + WS_MISC + MS_MK) + (size_t)layer * 18 * 256 * 256;
  const bf16_t* MVt = (const bf16_t*)(p.ws + WS_MISC + MS_MVT) + (size_t)layer * 18 * 256 * 256;
  int L, srow0, bg; seq_of_row(row0, L, srow0, bg);
#pragma unroll 1
  for (int h = 0; h < 4; ++h) {
    float O[2][4][4];
    attn_core<64, AM_MEM>(smem, QM + (size_t)row0 * 256 + h * 64, 256, MK + (size_t)bg * 256 * 256 + h * 64, 256,
                          MVt + ((size_t)(bg * 256 + h * 64) << 8), 256, 0, 0, 256, 0, 0.f, O);
    attn_store<4>(QM + (size_t)row0 * 256 + h * 64, 256, O);
  }
}

DI int PADI(int i) { return i + (i >> 5); }
DI float2 cmul(float2 a, float2 b) { return make_float2(a.x * b.x - a.y * b.y, a.x * b.y + a.y * b.x); }
DI float2 cmulc(float2 a, float2 b) { return make_float2(a.x * b.x + a.y * b.y, a.y * b.x - a.x * b.y); }
DI constexpr float C16(int m) { return m == 0 ? 1.f : m == 1 ? 0.92387953251128674f : m == 2 ? 0.70710678118654752f : m == 3 ? 0.38268343236508977f : m == 4 ? 0.f : m == 5 ? -0.38268343236508977f : m == 6 ? -0.70710678118654752f : -0.92387953251128674f; }
DI constexpr float S16(int m) { return m == 0 ? 0.f : m == 1 ? 0.38268343236508977f : m == 2 ? 0.70710678118654752f : m == 3 ? 0.92387953251128674f : m == 4 ? 1.f : m == 5 ? 0.92387953251128674f : m == 6 ? 0.70710678118654752f : 0.38268343236508977f; }

template <int LOGR, int LOGS, bool INV>
DI void fft_pass(float2* buf, int total) {
  constexpr int R = 1 << LOGR;
  constexpr int S = 1 << LOGS;
  const int tid0 = opaque((int)threadIdx.x);
#pragma unroll 1
  for (int u = tid0; u < (total >> LOGR); u += NTHR) {
    const int j = u & (S - 1);
    const int base = ((u >> LOGS) << (LOGS + LOGR)) + j;
    float2* bp = buf + PADI(base);
    float2 x[R];
#pragma unroll
    for (int k = 0; k < R; ++k) x[k] = bp[k * S + ((k * S) >> 5)];
    float2 pw[LOGR];
    {
      const float rev = -(float)j * (1.0f / (float)(R * S));
      pw[0] = make_float2(cos_rev(rev), sin_rev(rev));
#pragma unroll
      for (int i = 1; i < LOGR; ++i) pw[i] = cmul(pw[i - 1], pw[i - 1]);
    }
    if (!INV) {
#pragma unroll
      for (int i = 0; i < LOGR; ++i) {
        const int h = R >> (i + 1);
#pragma unroll
        for (int k = 0; k < R; ++k) {
          if ((k & h) == 0) {
            const int mm = (k & (h - 1)) * 8 / h;
            float2 a = x[k], b = x[k + h];
            x[k] = make_float2(a.x + b.x, a.y + b.y);
            float2 d = make_float2(a.x - b.x, a.y - b.y);
            if (mm != 0) d = cmul(d, make_float2(C16(mm), -S16(mm)));
            x[k + h] = cmul(d, pw[i]);
          }
        }
      }
    } else {
#pragma unroll
      for (int i = LOGR - 1; i >= 0; --i) {
        const int h = R >> (i + 1);
#pragma unroll
        for (int k = 0; k < R; ++k) {
          if ((k & h) == 0) {
            const int mm = (k & (h - 1)) * 8 / h;
            float2 a = x[k];
            float2 d = cmulc(x[k + h], pw[i]);
            if (mm != 0) d = cmulc(d, make_float2(C16(mm), -S16(mm)));
            x[k] = make_float2(a.x + d.x, a.y + d.y);
            x[k + h] = make_float2(a.x - d.x, a.y - d.y);
          }
        }
      }
    }
#pragma unroll
    for (int k = 0; k < R; ++k) bp[k * S + ((k * S) >> 5)] = x[k];
  }
  __syncthreads();
}

template <int LOGN>
DI void fft_fwd(float2* buf, int total) {
  if (LOGN == 14) { fft_pass<4, 10, false>(buf, total); fft_pass<4, 6, false>(buf, total); fft_pass<4, 2, false>(buf, total); fft_pass<2, 0, false>(buf, total); }
  else { fft_pass<4, 7, false>(buf, total); fft_pass<4, 3, false>(buf, total); fft_pass<3, 0, false>(buf, total); }
}
template <int LOGN>
DI void fft_inv(float2* buf, int total) {
  if (LOGN == 14) { fft_pass<2, 0, true>(buf, total); fft_pass<4, 2, true>(buf, total); fft_pass<4, 6, true>(buf, total); fft_pass<4, 10, true>(buf, total); }
  else { fft_pass<3, 0, true>(buf, total); fft_pass<4, 3, true>(buf, total); fft_pass<4, 7, true>(buf, total); }
}

template <int LOGN, int NB, int NSUB>
DI void hyena_item(char* smem, const Params& p, int c, int row_base  ) {
  constexpr int L = 1 << LOGN;
  constexpr int SPT = L / NTHR;
  constexpr int EPT = NB * L / NTHR;
  const int tid = opaque((int)threadIdx.x);
  float2* buf = (float2*)smem;
  float* sm_w3 = (float*)(smem + 135168);
  float* sm_red = sm_w3 + 256;
  char* scr = p.ws + WS_XB + (size_t)blockIdx.x * HY_SCR_PER_BLOCK;
  float* scrF0 = (float*)scr;
  float* scrB0 = scrF0 + L;
  float* scrF1 = (float*)(p.ws + 451 * MiB + (size_t)blockIdx.x * 128 * 1024);
  float* scrB1 = scrF1 + L;
  float2* scrY = (float2*)(scr + 128 * 1024);
  float2* scrZ = (float2*)(scr + 256 * 1024);
  float2* scrS = (float2*)(scr + 384 * 1024);
  const bf16_t* UH = (const bf16_t*)p.out;
  bf16_t* OBt = (bf16_t*)(p.ws + WS_R3);
  const bf16_t* h2b = (const bf16_t*)(p.ws + WS_MISC + (LOGN == 14 ? MS_H2P : MS_H2S));
  const float* w3 = p.in[21];
  const float* cw = p.in[14]; const float* cb = p.in[15]; const float* skp = p.in[22];
  const float delta = fabsf(-3.0701134573253945f + (float)c * ((-15.350567286626973f + 3.0701134573253945f) / 511.0f));
  const float invLm1 = 1.0f / (float)(L - 1);

  float wv[3][4];
#pragma unroll
  for (int q = 0; q < 3; ++q) { const int ch = q * 512 + c; wv[q][0] = cw[ch]; wv[q][1] = cw[1536 + ch]; wv[q][2] = cw[2 * 1536 + ch]; wv[q][3] = cb[ch]; }
  auto loadu3 = [&](int b, int ch, int n, float (&r)[3]) {
    const bf16_t* u = UH + chm_index(1536, row_base + b * L, ch) + n;
    r[1] = bf2f(u[0]);
    r[0] = (n > 0) ? bf2f(u[-1]) : 0.f;
    r[2] = (n < L - 1) ? bf2f(u[1]) : 0.f;
  };
  auto convw = [&](int q, const float (&r)[3]) -> float { return r[0] * wv[q][0] + r[1] * wv[q][1] + r[2] * wv[q][2] + wv[q][3]; };

  {
    __syncthreads();
    if (tid < 256) sm_w3[tid] = w3[(size_t)(tid & 63) * 2048 + (tid >> 6) * 512 + c];
    __syncthreads();
    float asum0 = 0.f, asum1 = 0.f;
    constexpr int NP = L / (2 * NTHR);
    constexpr int CHK = NP < 8 ? NP : 8;
#pragma unroll 1
    for (int rep = 0; rep < ((PROBE & 64) ? 2 : 1); ++rep) {
      asum0 = 0.f; asum1 = 0.f;
#pragma unroll 1
      for (int i0 = 0; i0 < NP; i0 += CHK) {
        float acc[CHK][4][2];
#pragma unroll
        for (int i = 0; i < CHK; ++i)
#pragma unroll
          for (int q = 0; q < 4; ++q) { acc[i][q][0] = 0.f; acc[i][q][1] = 0.f; }
#pragma unroll 1
        for (int j = 0; j < 64; ++j) {
          const float w0 = sm_w3[j], w1 = sm_w3[64 + j], w2 = sm_w3[128 + j], w3v = sm_w3[192 + j];
          const unsigned* hp = (const unsigned*)(h2b + (size_t)j * L) + tid + NTHR * i0;
#pragma unroll
          for (int i = 0; i < CHK; ++i) {
            const unsigned hv = hp[NTHR * i];
            const float h0 = __uint_as_float(hv << 16), h1 = __uint_as_float(hv & 0xffff0000u);
            acc[i][0][0] += h0 * w0; acc[i][0][1] += h1 * w0; acc[i][1][0] += h0 * w1; acc[i][1][1] += h1 * w1;
            acc[i][2][0] += h0 * w2; acc[i][2][1] += h1 * w2; acc[i][3][0] += h0 * w3v; acc[i][3][1] += h1 * w3v;
          }
        }
#pragma unroll
        for (int i = 0; i < CHK; ++i) {
          const int t0 = 2 * (tid + NTHR * (i0 + i));
          const float d0 = ex2(-(float)t0 * invLm1 * delta * LOG2E), d1 = ex2(-(float)(t0 + 1) * invLm1 * delta * LOG2E);
          const float f00 = acc[i][0][0] * d0, f01 = acc[i][0][1] * d1, b00 = acc[i][1][0] * d0, b01 = acc[i][1][1] * d1;
          const float f10 = acc[i][2][0] * d0, f11 = acc[i][2][1] * d1, b10 = acc[i][3][0] * d0, b11 = acc[i][3][1] * d1;
          *(float2*)(scrF0 + t0) = make_float2(f00, f01); *(float2*)(scrB0 + t0) = make_float2(b00, b01);
          *(float2*)(scrF1 + t0) = make_float2(f10, f11); *(float2*)(scrB1 + t0) = make_float2(b10, b11);
          asum0 += fabsf(f00) + fabsf(f01) + (t0 >= 1 ? fabsf(b00) : 0.f) + fabsf(b01);
          asum1 += fabsf(f10) + fabsf(f11) + (t0 >= 1 ? fabsf(b10) : 0.f) + fabsf(b11);
        }
      }
    }
#pragma unroll
    for (int s = 32; s >= 1; s >>= 1) { asum0 += __shfl_xor(asum0, s); asum1 += __shfl_xor(asum1, s); }
    if ((tid & 63) == 0) { sm_red[tid >> 6] = asum0; sm_red[8 + (tid >> 6)] = asum1; }
    block_sync_global();
  }
#pragma unroll 1
  for (int o = 0; o < 2; ++o) {
    float nrm = 0.f;
#pragma unroll
    for (int w = 0; w < 8; ++w) nrm += sm_red[8 * o + w];
    const float inv_nrm = 1.0f / nrm;
    const float* scrF = o ? scrF1 : scrF0;
    const float* scrB = o ? scrB1 : scrB0;
    const float sk = skp[o * 512 + c];

#pragma unroll 1
    for (int par = 0; par < 2; ++par) {
#pragma unroll 2
      for (int i = 0; i < SPT; ++i) {
        const int n = tid + NTHR * i;
        const float f = scrF[n];
        const float br = (n == 0) ? 0.f : scrB[L - n];
        float2 v;
        if (par == 0) v = make_float2((f + br) * inv_nrm, 0.f);
        else { const float gm = (f - br) * inv_nrm; const float rev = -(float)n / (float)(2 * L); v = make_float2(gm * cos_rev(rev), gm * sin_rev(rev)); }
        buf[PADI(n)] = v;
      }
      __syncthreads();
      fft_fwd<LOGN>(buf, L);
#pragma unroll 8
      for (int i = 0; i < SPT; ++i) scrS[tid + NTHR * i] = buf[PADI(tid + NTHR * i)];
      __syncthreads();
#pragma unroll 1
      for (int sub = 0; sub < NSUB; ++sub) {
        constexpr int BT = 4;
#pragma unroll 1
        for (int i0 = 0; i0 < EPT; i0 += BT) {
          float2 zz[BT];
          if (o == 0 && par == 0) {
            float ra[BT][3], rb[BT][3];
#pragma unroll
            for (int k = 0; k < BT; ++k) {
              const int e = tid + NTHR * (i0 + k); const int f = e >> LOGN, n = e & (L - 1); const int pp = sub * NB + f;
              loadu3(2 * pp, c, n, ra[k]); loadu3(2 * pp + 1, c, n, rb[k]);
            }
#pragma unroll
            for (int k = 0; k < BT; ++k) {
              const int e = tid + NTHR * (i0 + k); const int f = e >> LOGN, n = e & (L - 1); const int pp = sub * NB + f;
              zz[k] = make_float2(convw(0, ra[k]), convw(0, rb[k]));
              scrZ[(size_t)pp * L + n] = zz[k];
            }
          } else {
#pragma unroll
            for (int k = 0; k < BT; ++k) {
              const int e = tid + NTHR * (i0 + k); const int f = e >> LOGN, n = e & (L - 1); const int pp = sub * NB + f;
              zz[k] = scrZ[(size_t)pp * L + n];
            }
          }
#pragma unroll
          for (int k = 0; k < BT; ++k) {
            const int e = tid + NTHR * (i0 + k); const int n = e & (L - 1);
            float2 z = zz[k];
            if (par == 1) { const float rev = -(float)n / (float)(2 * L); z = cmul(z, make_float2(cos_rev(rev), sin_rev(rev))); }
            buf[PADI(e)] = z;
          }
        }
        __syncthreads();
        if (PROBE & 32) {
          fft_fwd<LOGN>(buf, NB * L); fft_inv<LOGN>(buf, NB * L);
          _Pragma("unroll 1") for (int i = 0; i < EPT; ++i) { const int e = tid + NTHR * i; float2 v = buf[PADI(e)]; buf[PADI(e)] = make_float2(v.x * (1.0f / L), v.y * (1.0f / L)); }
          __syncthreads();
        }
        fft_fwd<LOGN>(buf, NB * L);
#pragma unroll 1
        for (int i0 = 0; i0 < EPT; i0 += BT) {
          float2 ss[BT];
#pragma unroll
          for (int k = 0; k < BT; ++k) ss[k] = scrS[(tid + NTHR * (i0 + k)) & (L - 1)];
#pragma unroll
          for (int k = 0; k < BT; ++k) { const int e = tid + NTHR * (i0 + k); buf[PADI(e)] = cmul(buf[PADI(e)], ss[k]); }
        }
        __syncthreads();
        fft_inv<LOGN>(buf, NB * L);
        if (par == 0) {
#pragma unroll 8
          for (int i = 0; i < EPT; ++i) {
            const int e = tid + NTHR * i; const int f = e >> LOGN, n = e & (L - 1);
            scrY[(size_t)(sub * NB + f) * L + n] = buf[PADI(e)];
          }
        } else {
          const int gsel = (o == 0 ? 1 : 2);
#pragma unroll 1
          for (int i0 = 0; i0 < EPT; i0 += BT) {
            float2 ye[BT], zz[BT]; float ga[BT][3], gb[BT][3];
#pragma unroll
            for (int k = 0; k < BT; ++k) {
              const int e = tid + NTHR * (i0 + k); const int f = e >> LOGN, n = e & (L - 1); const int pp = sub * NB + f;
              ye[k] = scrY[(size_t)pp * L + n]; zz[k] = scrZ[(size_t)pp * L + n];
              loadu3(2 * pp, gsel * 512 + c, n, ga[k]); loadu3(2 * pp + 1, gsel * 512 + c, n, gb[k]);
            }
#pragma unroll
            for (int k = 0; k < BT; ++k) {
              const int e = tid + NTHR * (i0 + k); const int f = e >> LOGN, n = e & (L - 1); const int pp = sub * NB + f;
              float2 y = buf[PADI(e)];
              const float rev = -(float)n / (float)(2 * L);
              y = cmulc(y, make_float2(cos_rev(rev), sin_rev(rev)));
              const float sc = 0.5f / (float)L;
              const float c0 = (ye[k].x + y.x) * sc + sk * zz[k].x;
              const float c1 = (ye[k].y + y.y) * sc + sk * zz[k].y;
              const float z0 = convw(gsel, ga[k]) * c0;
              const float z1 = convw(gsel, gb[k]) * c1;
              if (o == 0) scrZ[(size_t)pp * L + n] = make_float2(z0, z1);
              else {
                OBt[chm_index(512, row_base + (2 * pp) * L, c) + n] = f2bf(z0);
                OBt[chm_index(512, row_base + (2 * pp + 1) * L, c) + n] = f2bf(z1);
              }
            }
          }
        }
        __syncthreads();
      }
    }
  }
}

struct WMat { const float* src; int K; int N; const float* gain; bf16_t* dst; };
DI WMat get_wmat(const Params& p, int id) {
  bf16_t* W = (bf16_t*)(p.ws + WS_W);
  WMat m;
  switch (id) {
    case 0: m = {p.in[9], 1024, 3072, p.in[5], W + W_INE}; break;
    case 1: m = {p.in[23], 1024, 1024, nullptr, W + W_OUTE}; break;
    case 2: m = {p.in[24], 1024, 2304, p.in[5] + 1024, W + W_INO}; break;
    case 3: m = {p.in[31], 1024, 1024, nullptr, W + W_OUTO}; break;
    case 4: m = {p.in[32], 1024, 256, p.in[6], W + W_Q}; break;
    case 5: m = {p.in[32] + 1024 * 256, 1024, 256, p.in[6] + 1024, W + W_Q + 256 * 1024}; break;
    case 6: m = {p.in[33], 1024, 512, p.in[7], W + W_KV}; break;
    case 7: m = {p.in[33] + 1024 * 512, 1024, 512, p.in[7] + 1024, W + W_KV + 512 * 1024}; break;
    case 8: m = {p.in[34], 256, 1024, nullptr, W + W_O}; break;
    case 9: m = {p.in[34] + 256 * 1024, 256, 1024, nullptr, W + W_O + 1024 * 256}; break;
    case 10: m = {p.in[37], 1024, 4096, p.in[8], W + W_1}; break;
    case 11: m = {p.in[37] + (size_t)1024 * 4096, 1024, 4096, p.in[8] + 1024, W + W_1 + (size_t)4096 * 1024}; break;
    case 12: m = {p.in[38], 4096, 1024, nullptr, W + W_2}; break;
    default: m = {p.in[38] + (size_t)4096 * 1024, 4096, 1024, nullptr, W + W_2 + (size_t)4096 * 1024}; break;
  }
  return m;
}

DI void prep_wtile(char* smem, const WMat& m, int tile) {
  float* t = (float*)smem;
  const int ntn = m.N >> 6;
  const int k0 = (tile / ntn) << 6, n0 = (tile % ntn) << 6;
  const int tid = threadIdx.x;
  __syncthreads();
  {
    const int kk = tid >> 4, n4 = (tid & 15) * 4;
#pragma unroll
    for (int i = 0; i < 2; ++i) {
      const int k = kk + 32 * i;
      float4 v = *(const float4*)(m.src + (size_t)(k0 + k) * m.N + n0 + n4);
      const float gk = m.gain ? m.gain[k0 + k] : 1.0f;
      t[k * 65 + n4] = v.x * gk; t[k * 65 + n4 + 1] = v.y * gk; t[k * 65 + n4 + 2] = v.z * gk; t[k * 65 + n4 + 3] = v.w * gk;
    }
  }
  __syncthreads();
  {
    const int n = tid >> 3, kc = tid & 7;
    uint4 u;
    u.x = pack2(t[(8 * kc) * 65 + n], t[(8 * kc + 1) * 65 + n]); u.y = pack2(t[(8 * kc + 2) * 65 + n], t[(8 * kc + 3) * 65 + n]);
    u.z = pack2(t[(8 * kc + 4) * 65 + n], t[(8 * kc + 5) * 65 + n]); u.w = pack2(t[(8 * kc + 6) * 65 + n], t[(8 * kc + 7) * 65 + n]);
    *(uint4*)(m.dst + (size_t)(n0 + n) * m.K + k0 + 8 * kc) = u;
  }
}

DI void prep_row(const float* src, bf16_t* dst, float* ssq) {
  const int lane = threadIdx.x & 63;
  float ss = 0.f;
#pragma unroll
  for (int i = 0; i < 4; ++i) {
    float4 v = *(const float4*)(src + (i * 64 + lane) * 4);
    ss += v.x * v.x + v.y * v.y + v.z * v.z + v.w * v.w;
    uint2 u; u.x = pack2(v.x, v.y); u.y = pack2(v.z, v.w);
    *(uint2*)(dst + (i * 64 + lane) * 4) = u;
  }
#pragma unroll
  for (int s = 32; s >= 1; s >>= 1) ss += __shfl_xor(ss, s);
  if (lane == 0) *ssq = ss;
}

DI void prep_h2(const Params& p, int L, int t, bf16_t* dst) {
  const int j = threadIdx.x & 63;
  const float* w1 = p.in[16]; const float* b1 = p.in[17]; const float* fr = p.in[18]; const float* w2 = p.in[19]; const float* b2 = p.in[20];
  const float t01 = (float)t / (float)(L - 1);
  const float tl = (float)t / (float)L;
  float a = t01 * w1[j] + b1[j];
#pragma unroll
  for (int k = 0; k < 8; ++k) {
    const float fk = 1e-4f + (float)k * ((7.0f - 1e-4f) / 7.0f);
    const float rev = tl * fk;
    a += cos_rev(rev) * w1[(1 + k) * 64 + j] - sin_rev(rev) * w1[(9 + k) * 64 + j];
  }
  const float h1 = sin_rev(fr[j] * a * 0.15915494309189535f);
  float a2 = b2[j];
  for (int i = 0; i < 64; ++i) a2 += __shfl(h1, i) * w2[i * 64 + j];
  dst[(size_t)j * L + t] = f2bf(sin_rev(fr[64 + j] * a2 * 0.15915494309189535f));
}

constexpr int PREP_NW = 768 + 256 + 576 + 256 + 64 + 64 + 128 + 128 + 64 + 64 + 1024 + 1024 + 1024 + 1024;
constexpr int PREP_T_ROWS = PREP_NW;
constexpr int PREP_T_MEM = PREP_T_ROWS + 8192;
constexpr int PREP_T_H2 = PREP_T_MEM + 576;
constexpr int PREP_T_MISC = PREP_T_H2 + 2304;
constexpr int PREP_TOTAL = PREP_T_MISC + 1;

DI void phase_prep(char* smem, const Params& p) {
  const int tid = threadIdx.x, wave = tid >> 6;
#pragma unroll 1
  for (int task = blockIdx.x; task < PREP_TOTAL; task += gridDim.x) {
    if (task < PREP_NW) {
      int t = task, id = 0;
      for (; id < 14; ++id) { WMat m = get_wmat(p, id); int n = (m.K >> 6) * (m.N >> 6); if (t < n) break; t -= n; }
      WMat m = get_wmat(p, id);
      prep_wtile(smem, m, t);
    } else if (task < PREP_T_MEM) {
      const int row = (task - PREP_T_ROWS) * 8 + wave;
      const float* src = (row < T_P) ? p.in[0] + (size_t)row * DM : p.in[1] + (size_t)(row - T_P) * DM;
      float* RS = (float*)(p.ws + WS_MISC + MS_RS);
      prep_row(src, (bf16_t*)(p.ws + WS_XB) + (size_t)row * DM, RS + row);
      if ((tid & 63) < 5) RS[(size_t)(1 + (tid & 63)) * T_ALL + row] = 0.f;
    } else if (task < PREP_T_H2) {
      const int row = (task - PREP_T_MEM) * 8 + wave;
      const float* src = (row < 512) ? p.in[2] + (size_t)row * DM : p.in[3] + (size_t)(row - 512) * DM;
      prep_row(src, (bf16_t*)(p.ws + WS_R1) + (size_t)row * DM, (float*)(p.ws + WS_MISC + MS_RSM) + row);
    } else if (task < PREP_T_MISC) {
      const int t = (task - PREP_T_H2) * 8 + wave;
      if (t < LP) prep_h2(p, LP, t, (bf16_t*)(p.ws + WS_MISC + MS_H2P));
      else prep_h2(p, LS, t - LP, (bf16_t*)(p.ws + WS_MISC + MS_H2S));
    } else {
      float* lut = (float*)(p.ws + WS_MISC + MS_LUT);
      for (int i = tid; i < 8 * 257; i += NTHR) {
        const int hh = i / 257, rel = (i % 257) - 128;
        const int n = rel < 0 ? -rel : rel;
        int bkt;
        if (n < 8) bkt = n; else { bkt = 2 + (31 - __clz(n * n)); if (bkt > 15) bkt = 15; }
        if (rel > 0) bkt += 16;
        lut[i] = p.in[4][bkt * 8 + hh] * LOG2E;
      }
      if (tid < 64) {
        const float* lf = p.in[12];
        float a = lf[tid] * lf[64 + tid], b = lf[128 + tid] * lf[192 + tid];
#pragma unroll
        for (int s = 32; s >= 1; s >>= 1) { a += __shfl_xor(a, s); b += __shfl_xor(b, s); }
        if (tid == 0) *(float*)(p.ws + WS_MISC + MS_LAM) = expf(a) - expf(b) + 0.2f;
      }
    }
  }
}

DI Seg seg_inproj(const Params& p, int layer, int col0, const float* rs) {
  Seg s{}; s.rs = rs; s.scale = 1.0f;
  if (layer == 0) {
    if (col0 < 512) { s.type = SEG_NORM; s.dst = (bf16_t*)(p.ws + WS_R0); s.ld = 512; s.col = col0; s.gain = p.in[10]; s.scale = QSCALE; }
    else if (col0 < 1024) { s.type = SEG_NORM; s.dst = (bf16_t*)((char*)p.out + 192 * MiB); s.ld = 512; s.col = col0 - 512; s.gain = p.in[11]; }
    else if (col0 < 1536) { s.type = SEG_CHM; s.dst = (bf16_t*)(p.ws + WS_R2); s.CH = 512; s.col = col0 - 1024; }
    else { s.type = SEG_CHM; s.dst = (bf16_t*)p.out; s.CH = 1536; s.col = col0 - 1536; }
  } else {
    if (col0 < 512) { s.type = SEG_NORM; s.dst = (bf16_t*)(p.ws + WS_R0); s.ld = 512; s.col = col0; s.gain = p.in[25]; s.scale = QSCALE; }
    else if (col0 < 1024) { s.type = SEG_NORM; s.dst = (bf16_t*)(p.ws + WS_R1); s.ld = 512; s.col = col0 - 512; s.gain = p.in[26]; }
    else if (col0 < 1536) { s.type = SEG_CHM; s.dst = (bf16_t*)(p.ws + WS_R2); s.CH = 512; s.col = col0 - 1024; }
    else if (col0 < 2048) { s.type = SEG_NORM; s.dst = (bf16_t*)(p.ws + WS_R3); s.ld = 512; s.col = col0 - 1536; s.gain = p.in[28]; s.scale = QSCALE; }
    else if (col0 < 2176) { s.type = SEG_NORM; s.dst = (bf16_t*)(p.ws + WS_KD); s.ld = 128; s.col = col0 - 2048; s.gain = p.in[29]; }
    else { s.type = SEG_CHM; s.dst = (bf16_t*)(p.ws + WS_VDT); s.CH = 128; s.col = col0 - 2176; }
  }
  return s;
}

struct SchedInproj { int xcd, jx, per, rows_per, nt_lo, nt_n;
  DI bool next(int i, SUnit& u) const { const int q = jx + i * per; if (q >= rows_per * nt_n) return false; u.m0 = (xcd * rows_per + q / nt_n) * 256; u.n0 = (nt_lo + q % nt_n) * 256; return true; } };
struct SchedOne { int m0, n0; bool valid;
  DI bool next(int i, SUnit& u) const { if (i > 0 || !valid) return false; u.m0 = m0; u.n0 = n0; return true; } };
struct SchedRow { int m0, n;
  DI bool next(int i, SUnit& u) const { if (i >= n) return false; u.m0 = m0; u.n0 = i * 256; return true; } };

DI void phase_inproj(char* smem, const Params& p, int layer) {
  const bf16_t* W = (const bf16_t*)(p.ws + WS_W);
  const int nxg = (gridDim.x >= 8 && (gridDim.x & 7) == 0) ? 8 : 1;
  {
    GemmArgs ga{(const bf16_t*)(p.ws + WS_XB), nullptr, 1 << 30, DM, W + (layer == 0 ? W_INE : W_INO), DM, DM};
    const int xc = blockIdx.x % nxg, jx = blockIdx.x / nxg, per = gridDim.x / nxg, rp = 256 / nxg;
    const float* rs = (const float*)(p.ws + WS_MISC + MS_RS) + (size_t)(layer * 3) * T_ALL;
    auto sf = [&](const SUnit& u, int wc) -> Seg { return seg_inproj(p, layer, u.n0 + 64 * wc, rs); };
    if (layer == 0) {
      gemm_stream<false>(ga, SchedInproj{xc, jx, per, rp, 0, 4}, sf);
      gemm_stream<true>(ga, SchedInproj{xc, jx, per, rp, 4, 8}, sf);
    } else {
      gemm_stream<false>(ga, SchedInproj{xc, jx, per, rp, 0, 4}, sf);
      gemm_stream<true>(ga, SchedInproj{xc, jx, per, rp, 4, 2}, sf);
      gemm_stream<false>(ga, SchedInproj{xc, jx, per, rp, 6, 3}, sf);
    }
  }
  if (layer == 0) {
    const int t2 = blockIdx.x; const int l = t2 / 36, r = t2 % 36;
    GemmArgs ga{(const bf16_t*)(p.ws + WS_R1), nullptr, 1 << 30, DM, W + W_KV + (size_t)(l & 1) * 512 * 1024, DM, DM};
    auto sfm = [&](const SUnit& u, int wc) -> Seg {
      Seg s{}; s.rs = (const float*)(p.ws + WS_MISC + MS_RSM); s.scale = 1.0f;
      const int col0 = u.n0 + 64 * wc;
      if (col0 < 256) { s.type = SEG_NORM; s.dst = (bf16_t*)(p.ws + WS_MISC + MS_MK) + (size_t)l * 18 * 256 * 256; s.ld = 256; s.col = col0; s.gain = p.in[36] + l * 64; }
      else { s.type = SEG_CHMEM; s.dst = (bf16_t*)(p.ws + WS_MISC + MS_MVT) + (size_t)l * 18 * 256 * 256; s.col = col0 - 256; }
      return s; };
    gemm_stream<false>(ga, SchedOne{(r >> 1) * 256, 0, t2 < 72 && (r & 1) == 0}, sfm);
    gemm_stream<true>(ga, SchedOne{(r >> 1) * 256, 256, t2 < 72 && (r & 1) == 1}, sfm);
  }
  (void)smem;
}

DI void phase_mixer0(char* smem, const Params& p) {
#pragma unroll 1
  for (int item = blockIdx.x; item < 2048; item += gridDim.x) {
    const int kind = item >> 9, idx = item & 511;
#ifndef SUBP
#define SUBP -1
#endif
    if (kind == 0 || kind == 2) {
      if (PROBE & 4) diff_item(smem, p, (kind == 2 ? 512 : 0) + idx, true);
      diff_item(smem, p, (kind == 2 ? 512 : 0) + idx);
    } else if (kind == 1) {
      if (PROBE & 8) hyena_item<14, 1, 1>(smem, p, idx, 0);
      hyena_item<14, 1, 1>(smem, p, idx, 0);
    } else {
      if (PROBE & 8) hyena_item<11, 4, 2>(smem, p, idx, T_P);
      hyena_item<11, 4, 2>(smem, p, idx, T_P);
    }
  }
}
DI void phase_mixer1(char* smem, const Params& p) {
#pragma unroll 1
  for (int item = blockIdx.x; item < 4096; item += gridDim.x) {
    if (PROBE & 16) { if (item < 2048) na_item(smem, p, item, true); else wg_item(smem, p, item - 2048, true); }
    if (item < 2048) na_item(smem, p, item); else wg_item(smem, p, item - 2048);
  }
}

DI void phase_post(char* smem, const Params& p, int layer, int part) {
  const bf16_t* W = (const bf16_t*)(p.ws + WS_W);
  float* RS = (float*)(p.ws + WS_MISC + MS_RS);
  bf16_t* XB = (bf16_t*)(p.ws + WS_XB);
  bf16_t* H0 = (bf16_t*)(p.ws + 195 * MiB);
  bf16_t* H1 = (bf16_t*)(p.ws + 323 * MiB);
  bf16_t* QM = (bf16_t*)(p.ws + WS_QM);
  const int wn = (threadIdx.x >> 6) & 1;
#pragma unroll 1
  for (int mt = blockIdx.x; mt < 256; mt += gridDim.x) {
    const int m0 = mt * 256;
    if (layer == 0 && part == 0) {
      const bf16_t* OBt = (const bf16_t*)(p.ws + WS_R3);
      bf16_t* OB = (bf16_t*)(p.ws + WS_R1);
      const int tid = threadIdx.x;
#pragma unroll 1
      for (int chunk = 0; chunk < 4; ++chunk) {
        __syncthreads();
        {
          const int c = tid >> 2, part = tid & 3;
          const uint4* src = (const uint4*)(OBt + chm_index(512, m0, chunk * 128 + c) + part * 64);
#pragma unroll
          for (int i = 0; i < 8; ++i) *(uint4*)(smem + c * 528 + part * 128 + i * 16) = src[i];
        }
        __syncthreads();
#pragma unroll 2
        for (int it = 0; it < 8; ++it) {
          const int item = it * NTHR + tid; const int t = item & 255, c8 = item >> 8;
          unsigned short v[8];
#pragma unroll
          for (int j = 0; j < 8; ++j) v[j] = *(const unsigned short*)(smem + (c8 * 8 + j) * 528 + t * 2);
          uint4 u; u.x = v[0] | ((unsigned)v[1] << 16); u.y = v[2] | ((unsigned)v[3] << 16); u.z = v[4] | ((unsigned)v[5] << 16); u.w = v[6] | ((unsigned)v[7] << 16);
          *(uint4*)(OB + (size_t)(m0 + t) * 512 + chunk * 128 + c8 * 8) = u;
        }
      }
      __syncthreads();
    }
#ifndef CHAINP
#define CHAINP -1
#endif
    if (part == 0) {
      GemmArgs ga{(const bf16_t*)(p.ws + WS_R0), (const bf16_t*)(p.ws + (layer == 0 ? WS_R1 : WS_R3)), 512, 512, W + (layer == 0 ? W_OUTE : W_OUTO), DM, DM};
      Seg s{}; s.type = SEG_RESID; s.xin0 = layer == 0 ? p.in[0] : nullptr; s.xin1 = layer == 0 ? p.in[1] : nullptr;
      s.xout = p.out; s.xb = XB; s.rs_out = RS + (size_t)(layer * 3 + 1) * T_ALL;
      gemm_stream<false>(ga, SchedRow{m0, 4}, [&](const SUnit& u, int wc) -> Seg { Seg t = s; t.col = u.n0 + 64 * wc; return t; });
    }
    if (part == 0) continue;
    if (CHAINP < 0 || CHAINP == 2) {
      GemmArgs ga{XB, nullptr, 1 << 30, DM, W + W_Q + (size_t)layer * 256 * 1024, DM, DM};
      Seg s{}; s.type = SEG_NORM; s.rs = RS + (size_t)(layer * 3 + 1) * T_ALL; s.dst = QM; s.ld = 256; s.gain = p.in[35] + layer * 64; s.scale = QSCALE;
      gemm_stream<false>(ga, SchedRow{m0, 1}, [&](const SUnit& u, int wc) -> Seg { Seg t = s; t.col = u.n0 + 64 * wc; return t; });
    }
    block_sync_global();
    if (CHAINP < 0 || CHAINP == 3) mem_attn_tile(smem, p, layer, m0);
    block_sync_global();
    if (CHAINP < 0 || CHAINP == 4) {
      GemmArgs ga{QM, nullptr, 1 << 30, 256, W + W_O + (size_t)layer * 1024 * 256, 256, 256};
      Seg s{}; s.type = SEG_RESID; s.xout = p.out; s.xb = XB; s.rs_out = RS + (size_t)(layer * 3 + 2) * T_ALL;
      gemm_stream<false>(ga, SchedRow{m0, 4}, [&](const SUnit& u, int wc) -> Seg { Seg t = s; t.col = u.n0 + 64 * wc; return t; });
    }
    block_sync_global();
    _Pragma("unroll 1") for (int hc = 0; hc < 2; ++hc) {
      {
        GemmArgs ga{XB, nullptr, 1 << 30, DM, W + W_1 + (size_t)layer * 4096 * 1024 + (size_t)hc * 2048 * 1024, DM, DM};
        Seg s{}; s.type = SEG_MLP1; s.rs = RS + (size_t)(layer * 3 + 2) * T_ALL; s.ld = 1024;
        gemm_stream<false>(ga, SchedRow{m0, 8}, [&](const SUnit& u, int wc) -> Seg { Seg t = s; t.dst = (u.n0 < 1024) ? H0 : H1; t.col = (u.n0 & 1023) + 64 * wc; return t; });
      }
      block_sync_global();
      {
        GemmArgs ga{H0, H1, 1024, 1024, W + W_2 + (size_t)layer * 4096 * 1024 + (size_t)hc * 2048, 4096, 2048};
        Seg s{}; s.type = SEG_RESID; s.xout = p.out;
        if (hc == 1 && layer == 0) { s.xb = XB; s.rs_out = RS + (size_t)3 * T_ALL; }
        gemm_stream<false>(ga, SchedRow{m0, 4}, [&](const SUnit& u, int wc) -> Seg { Seg t = s; t.col = u.n0 + 64 * wc; return t; });
      }
      block_sync_global();
    }
  }
  (void)wn;
}

__global__ void __launch_bounds__(NTHR) fwd_kernel(Params p, int ph_lo, int ph_hi) {
  extern __shared__ __attribute__((aligned(16))) char smem[];
#define RUN_PHASE(i_, call_) if (ph_lo <= (i_) && (i_) <= ph_hi) { if ((i_) > ph_lo) { __threadfence(); cg::this_grid().sync(); } call_; }
  RUN_PHASE(0, phase_prep(smem, p))
  if (PROBE & 1) { __syncthreads(); phase_prep(smem, p); }
  RUN_PHASE(1, phase_inproj(smem, p, 0))
  if (PROBE & 2) { __syncthreads(); phase_inproj(smem, p, 0); }
  RUN_PHASE(2, phase_mixer0(smem, p))
  RUN_PHASE(3, phase_post(smem, p, 0, 0))
  RUN_PHASE(4, phase_post(smem, p, 0, 1))
  RUN_PHASE(5, phase_inproj(smem, p, 1))
  if (PROBE & 2) { __syncthreads(); phase_inproj(smem, p, 1); }
  RUN_PHASE(6, phase_mixer1(smem, p))
  RUN_PHASE(7, phase_post(smem, p, 1, 0))
  RUN_PHASE(8, phase_post(smem, p, 1, 1))
}

#ifndef ONE_LAUNCH
#define ONE_LAUNCH 1
#endif

extern "C" void kernel_launch(void* const* d_in, const int* in_sizes, int n_in, void* d_out, int out_size, void* d_ws, size_t ws_size,
                              hipStream_t stream) {
  static int grid = 0;
  if (grid == 0) {
    if (n_in != 39 || ws_size < WS_NEED || out_size != T_ALL * DM) { fprintf(stderr, "kernel_launch: unexpected shapes n_in %d ws %zu out %d\n", n_in, ws_size, out_size); grid = -1; return; }
    if (hipFuncSetAttribute((const void*)fwd_kernel, hipFuncAttributeMaxDynamicSharedMemorySize, SMEM_BYTES) != hipSuccess) { fprintf(stderr, "hipFuncSetAttribute failed\n"); grid = -1; return; }
    int dev = 0, cus = 0, per_cu = 0;
    hipGetDevice(&dev);
    hipDeviceGetAttribute(&cus, hipDeviceAttributeMultiprocessorCount, dev);
    hipOccupancyMaxActiveBlocksPerMultiprocessor(&per_cu, (const void*)fwd_kernel, NTHR, SMEM_BYTES);
    if (per_cu < 1 || cus < 1) { fprintf(stderr, "occupancy query: %d blocks/CU, %d CUs\n", per_cu, cus); grid = -1; return; }
    grid = cus;
  }
  if (grid < 0) return;
  Params p{};
  for (int i = 0; i < 39; ++i) p.in[i] = (const float*)d_in[i];
  p.out = (float*)d_out; p.ws = (char*)d_ws;
#if ONE_LAUNCH
  int lo = 0, hi = 8;
  void* args[] = {&p, &lo, &hi};
  hipError_t e = hipLaunchCooperativeKernel((const void*)fwd_kernel, dim3(grid), dim3(NTHR), args, SMEM_BYTES, stream);
  if (e != hipSuccess) fprintf(stderr, "cooperative launch failed: %s\n", hipGetErrorString(e));
#else
  for (int ph = 0; ph <= 8; ++ph) hipLaunchKernelGGL(fwd_kernel, dim3(grid), dim3(NTHR), SMEM_BYTES, stream, p, ph, ph);
#endif
}
```

```cpp
#include <hip/hip_runtime.h>
#include <hip/hip_cooperative_groups.h>
#include <cstdio>
namespace cg = cooperative_groups;

#define DI __device__ __forceinline__
#define PROBE 0
typedef unsigned short bf16_t;
using bf16x8 = __attribute__((ext_vector_type(8))) short;
using s16x4 = __attribute__((ext_vector_type(4))) short;
using f32x4 = __attribute__((ext_vector_type(4))) float;
#define MFMA16(a, b, c) __builtin_amdgcn_mfma_f32_16x16x32_bf16((a), (b), (c), 0, 0, 0)

constexpr int NTHR = 512;
constexpr int T_ALL = 65536;
constexpr int T_P = 32768;
constexpr int LP = 16384, LS = 2048;
constexpr int DM = 1024;
constexpr float EPS = 1e-6f;
constexpr float LOG2E = 1.4426950408889634f;
constexpr float QSCALE = 0.125f * 1.4426950408889634f;
constexpr int SMEM_BYTES = 144 * 1024;
constexpr size_t MiB = (size_t)1 << 20;

constexpr size_t WS_XB = 0;
constexpr size_t WS_W = 128 * MiB;
constexpr size_t W_INE = 0;
constexpr size_t W_OUTE = W_INE + (size_t)3072 * 1024;
constexpr size_t W_INO = W_OUTE + (size_t)1024 * 1024;
constexpr size_t W_OUTO = W_INO + (size_t)2304 * 1024;
constexpr size_t W_Q = W_OUTO + (size_t)1024 * 1024;
constexpr size_t W_KV = W_Q + (size_t)2 * 256 * 1024;
constexpr size_t W_O = W_KV + (size_t)2 * 512 * 1024;
constexpr size_t W_1 = W_O + (size_t)2 * 1024 * 256;
constexpr size_t W_2 = W_1 + (size_t)2 * 4096 * 1024;
constexpr size_t W_END = W_2 + (size_t)2 * 4096 * 1024;
static_assert(W_END * 2 <= 51 * MiB, "weights");
constexpr size_t WS_MISC = 179 * MiB;
constexpr size_t MS_RS = 0;
constexpr size_t MS_RSM = MS_RS + (size_t)6 * T_ALL * 4;
constexpr size_t MS_MK = MS_RSM + 32768;
constexpr size_t MS_MVT = MS_MK + (size_t)2 * 18 * 256 * 256 * 2;
constexpr size_t MS_H2P = MS_MVT + (size_t)2 * 18 * 256 * 256 * 2;
constexpr size_t MS_H2S = MS_H2P + (size_t)LP * 64 * 4;
constexpr size_t MS_LUT = MS_H2S + (size_t)LS * 64 * 4;
constexpr size_t MS_LAM = MS_LUT + 16384;
constexpr size_t MS_END = MS_LAM + 256;
static_assert(MS_END <= 16 * MiB, "misc");
constexpr size_t WS_R0 = 195 * MiB;
constexpr size_t WS_R1 = 259 * MiB;
constexpr size_t WS_R2 = 323 * MiB;
constexpr size_t WS_R3 = 387 * MiB;
constexpr size_t WS_KD = 451 * MiB;
constexpr size_t WS_VDT = 467 * MiB;
constexpr size_t WS_QM = 451 * MiB;
constexpr size_t WS_H_L0 = 323 * MiB;
constexpr size_t WS_H_L1 = 259 * MiB;
constexpr size_t WS_NEED = 512 * MiB;
constexpr size_t HY_SCR_PER_BLOCK = 512 * 1024;

struct Params {
  const float* in[39];
  float* out;
  char* ws;
};

DI unsigned short f2bf(float x) { unsigned u = __float_as_uint(x); u += 0x7fffu + ((u >> 16) & 1u); return (unsigned short)(u >> 16); }
typedef __bf16 bf16v2_t __attribute__((ext_vector_type(2)));
typedef float f32v2_t __attribute__((ext_vector_type(2)));
DI unsigned pack2(float a, float b) { f32v2_t f = {a, b}; bf16v2_t h = __builtin_convertvector(f, bf16v2_t); return __builtin_bit_cast(unsigned, h); }
DI float bf2f(unsigned short h) { return __uint_as_float(((unsigned)h) << 16); }
DI float ex2(float x) { return __builtin_amdgcn_exp2f(x); }
DI float sin_rev(float r) { return __builtin_amdgcn_sinf(r); }
DI float cos_rev(float r) { return __builtin_amdgcn_cosf(r); }
DI int opaque(int x) { asm volatile("" : "+v"(x)); return x; }
DI float dpp_f(float v, int ctrl_sel) {
  int x = __float_as_int(v), r;
  if (ctrl_sel == 0) r = __builtin_amdgcn_update_dpp(x, x, 0xB1, 0xF, 0xF, false);
  else if (ctrl_sel == 1) r = __builtin_amdgcn_update_dpp(x, x, 0x4E, 0xF, 0xF, false);
  else if (ctrl_sel == 2) r = __builtin_amdgcn_update_dpp(x, x, 0x141, 0xF, 0xF, false);
  else r = __builtin_amdgcn_update_dpp(x, x, 0x140, 0xF, 0xF, false);
  return __int_as_float(r);
}
DI float row16_sum(float v) { v += dpp_f(v, 0); v += dpp_f(v, 1); v += dpp_f(v, 2); v += dpp_f(v, 3); return v; }
DI void block_sync_global() { __syncthreads(); }

DI size_t chm_index(int CH, int row, int ch) {
  if (row < T_P) { int b = row >> 14, t = row & (LP - 1); return ((size_t)(b * CH + ch) << 14) + t; }
  int r = row - T_P; int b = r >> 11, t = r & (LS - 1);
  return (size_t)T_P * CH + ((size_t)(b * CH + ch) << 11) + t;
}

struct GemmArgs {
  const bf16_t* A0; const bf16_t* A1; int ksplit; int lda;
  const bf16_t* Wt; int ldw; int K;
};
enum { SEG_NORM = 0, SEG_CHM = 1, SEG_CHMEM = 2, SEG_RESID = 3, SEG_MLP1 = 4 };
struct Seg {
  int type;
  bf16_t* dst; int ld; int col;
  const float* gain; float scale;
  int CH;
  const float* rs;
  const float* xin0; const float* xin1; float* xout; bf16_t* xb; float* rs_out;
};
constexpr int G_TILE_B = 256 * 64 * 2, G_STAGE_B = 2 * G_TILE_B;
DI int g_lds_byte(int r, int c) { int st = (r >> 4) * 2 + (c >> 5), ob = (r & 15) * 64 + (c & 31) * 2; return st * 1024 + (ob ^ (((ob >> 9) & 1) << 5)); }
DI void g_stage_rc(int b, int& R, int& C) { int st = b >> 10, sb = b & 1023, swz = sb ^ (((sb >> 9) & 1) << 5); R = (st >> 1) * 16 + swz / 64; C = (st & 1) * 32 + (swz % 64) / 2; }
#define WAIT_V0() asm volatile("s_waitcnt vmcnt(0)" ::: "memory")

DI void gemm_tile(char* smem_generic, const GemmArgs& ga, int m0, int n0, const Seg& sg) {
  extern __shared__ __attribute__((aligned(16))) char shm[];
  (void)smem_generic;
  const int tid = opaque((int)threadIdx.x), lane = tid & 63, wid = tid >> 6;
  const int l16 = lane & 15, g = lane >> 4;
  const int wr = wid >> 2, wc = wid & 3;
  int sR[4], sC[4];
#pragma unroll
  for (int i = 0; i < 4; ++i) g_stage_rc(wid * 1024 + i * 8192 + lane * 16, sR[i], sC[i]);
  const int KT = ga.K >> 6;
#define G_STAGE(buf_, kt_) do { const int k0_ = (kt_) << 6; \
    const bf16_t* Ab_ = (k0_ < ga.ksplit) ? ga.A0 + k0_ : ga.A1 + (k0_ - ga.ksplit); \
    _Pragma("unroll") for (int i = 0; i < 4; ++i) { \
      __builtin_amdgcn_global_load_lds((const unsigned*)(Ab_ + (size_t)(m0 + sR[i]) * ga.lda + sC[i]), (__attribute__((address_space(3))) unsigned*)(shm + (buf_) * G_STAGE_B + wid * 1024 + i * 8192), 16, 0, 0); \
      __builtin_amdgcn_global_load_lds((const unsigned*)(ga.Wt + (size_t)(n0 + sR[i]) * ga.ldw + k0_ + sC[i]), (__attribute__((address_space(3))) unsigned*)(shm + (buf_) * G_STAGE_B + G_TILE_B + wid * 1024 + i * 8192), 16, 0, 0); } } while (0)
  f32x4 acc[8][4];
#pragma unroll
  for (int i = 0; i < 8; ++i)
#pragma unroll
    for (int j = 0; j < 4; ++j) acc[i][j] = (f32x4){0.f, 0.f, 0.f, 0.f};
  float* rs_lds = (float*)(shm + 143360);
  G_STAGE(0, 0);
  if (sg.rs && tid < 256) rs_lds[tid] = rsqrtf(sg.rs[m0 + tid] * (1.0f / 1024.0f) + EPS);
  WAIT_V0(); __syncthreads();
#pragma unroll 1
  for (int t = 0; t < KT; ++t) {
    const int cur = t & 1;
    if (t + 1 < KT) G_STAGE(cur ^ 1, t + 1);
    const char* SAp = shm + cur * G_STAGE_B; const char* SBp = SAp + G_TILE_B;
#pragma unroll
    for (int ks = 0; ks < 2; ++ks) {
      bf16x8 At[8], Bf[4];
#pragma unroll
      for (int m = 0; m < 8; ++m) At[m] = *(const bf16x8*)(SAp + g_lds_byte(wr * 128 + m * 16 + l16, ks * 32 + g * 8));
#pragma unroll
      for (int n = 0; n < 4; ++n) Bf[n] = *(const bf16x8*)(SBp + g_lds_byte(wc * 64 + n * 16 + l16, ks * 32 + g * 8));
#pragma unroll
      for (int m = 0; m < 8; ++m)
#pragma unroll
        for (int n = 0; n < 4; ++n) acc[m][n] = MFMA16(At[m], Bf[n], acc[m][n]);
      __builtin_amdgcn_sched_barrier(0);
    }
    WAIT_V0(); __syncthreads();
  }
  const int rbase = m0 + 128 * wr + 4 * g;
  if (sg.rs) {
#pragma unroll
    for (int m = 0; m < 8; ++m)
#pragma unroll
      for (int r = 0; r < 4; ++r) {
        const float sc = rs_lds[128 * wr + 4 * g + 16 * m + r];
#pragma unroll
        for (int n = 0; n < 4; ++n) acc[m][n][r] *= sc;
      }
  }
  if (sg.type == SEG_NORM) {
    float gn[4];
#pragma unroll
    for (int n = 0; n < 4; ++n) gn[n] = sg.gain[16 * n + l16] * sg.scale;
#pragma unroll
    for (int m = 0; m < 8; ++m) {
#pragma unroll
      for (int r = 0; r < 4; ++r) {
        float ss = 0.f;
#pragma unroll
        for (int n = 0; n < 4; ++n) ss += acc[m][n][r] * acc[m][n][r];
        ss = row16_sum(ss);
        const float sc = rsqrtf(ss * (1.0f / 64.0f) + EPS);
        bf16_t* d = sg.dst + (size_t)(rbase + 16 * m + r) * sg.ld + sg.col + l16;
#pragma unroll
        for (int n = 0; n < 4; ++n) d[16 * n] = f2bf(acc[m][n][r] * sc * gn[n]);
      }
      __builtin_amdgcn_sched_barrier(0);
    }
  } else if (sg.type == SEG_CHM || sg.type == SEG_CHMEM) {
#pragma unroll
    for (int m = 0; m < 8; ++m) {
#pragma unroll
      for (int n = 0; n < 4; ++n) {
        const int row = rbase + 16 * m; const int ch = sg.col + l16 + 16 * n;
        size_t off;
        if (sg.type == SEG_CHM) off = chm_index(sg.CH, row, ch);
        else off = ((size_t)((row >> 8) * 256 + ch) << 8) + (row & 255);
        uint2 v; v.x = pack2(acc[m][n][0], acc[m][n][1]); v.y = pack2(acc[m][n][2], acc[m][n][3]);
        *(uint2*)(sg.dst + off) = v;
      }
      __builtin_amdgcn_sched_barrier(0);
    }
  } else {
    float* Cs = (float*)shm;
    const int rr = tid >> 5, c4 = (tid & 31) * 4;
#pragma unroll 1
    for (int half = 0; half < 2; ++half) {
      if ((wc >> 1) == half) {
#pragma unroll
        for (int m = 0; m < 8; ++m)
#pragma unroll
          for (int n = 0; n < 4; ++n)
#pragma unroll
            for (int r = 0; r < 4; ++r) Cs[(128 * wr + 16 * m + 4 * g + r) * 132 + 64 * (wc & 1) + 16 * n + l16] = acc[m][n][r];
      }
      __syncthreads();
      const int cg = sg.col + 128 * half + c4;
      if (sg.type == SEG_MLP1) {
#pragma unroll 4
        for (int it = 0; it < 16; ++it) {
          const int lr = it * 16 + rr; const int row = m0 + lr;
          f32x4 v = *(const f32x4*)(Cs + lr * 132 + c4);
          v[0] = fmaxf(v[0], 0.f); v[1] = fmaxf(v[1], 0.f); v[2] = fmaxf(v[2], 0.f); v[3] = fmaxf(v[3], 0.f);
          uint2 u; u.x = pack2(v[0] * v[0], v[1] * v[1]); u.y = pack2(v[2] * v[2], v[3] * v[3]);
          *(uint2*)(sg.dst + (size_t)row * sg.ld + cg) = u;
        }
      } else {
#pragma unroll 1
        for (int it0 = 0; it0 < 16; it0 += 8) {
          f32x4 xv[8];
#pragma unroll
          for (int k = 0; k < 8; ++k) {
            const int row = m0 + (it0 + k) * 16 + rr;
            const float* xo;
            if (sg.xin0) xo = (row < T_P) ? sg.xin0 + (size_t)row * DM : sg.xin1 + (size_t)(row - T_P) * DM;
            else xo = sg.xout + (size_t)row * DM;
            xv[k] = *(const f32x4*)(xo + cg);
          }
#pragma unroll
          for (int k = 0; k < 8; ++k) {
            const int lr = (it0 + k) * 16 + rr; const int row = m0 + lr;
            f32x4 v = *(const f32x4*)(Cs + lr * 132 + c4);
            v += xv[k];
            *(f32x4*)(sg.xout + (size_t)row * DM + cg) = v;
            if (sg.xb) { uint2 u; u.x = pack2(v[0], v[1]); u.y = pack2(v[2], v[3]); *(uint2*)(sg.xb + (size_t)row * DM + cg) = u; }
            if (sg.rs_out) {
              float ss = v[0] * v[0] + v[1] * v[1] + v[2] * v[2] + v[3] * v[3];
              ss = row16_sum(ss); ss += __shfl_xor(ss, 16);
              if ((tid & 31) == 0) atomicAdd(sg.rs_out + row, ss);
            }
          }
        }
      }
      __syncthreads();
    }
  }
}

#define LAS3 __attribute__((address_space(3)))
constexpr int S8_HTB = 128 * 64 * 2;
DI int s8_perm32(int rho) { const int n = rho >> 4, i = rho & 15; return 8 * (i >> 2) + 4 * n + (i & 3); }
struct SUnit { int m0, n0; };

template <bool NAT>
DI void s8_mma(f32x4 (&acc)[4][2], const bf16x8 (&At)[4][2], const bf16x8 (&Bt)[2][2]) {
  __builtin_amdgcn_s_setprio(1);
#pragma unroll
  for (int m = 0; m < 4; ++m)
#pragma unroll
    for (int n = 0; n < 2; ++n)
#pragma unroll
      for (int k = 0; k < 2; ++k) acc[m][n] = NAT ? MFMA16(At[m][k], Bt[n][k], acc[m][n]) : MFMA16(Bt[n][k], At[m][k], acc[m][n]);
  __builtin_amdgcn_s_setprio(0);
}

template <bool NAT>
DI void s8_epilogue(const f32x4 (&acc)[2][2][4][2], const Seg& sg, int m0, int wr, int fr, int fq) {
  if (!NAT && sg.type == SEG_NORM) {
    float gn[2][8];
#pragma unroll
    for (int bj = 0; bj < 2; ++bj)
#pragma unroll
      for (int k = 0; k < 8; ++k) gn[bj][k] = sg.gain[32 * bj + 8 * fq + k] * sg.scale;
#pragma unroll
    for (int ai = 0; ai < 2; ++ai)
#pragma unroll
      for (int m = 0; m < 4; ++m) {
        const int row = m0 + 128 * ai + 64 * wr + 16 * m + fr;
        float ss = 0.f;
#pragma unroll
        for (int bj = 0; bj < 2; ++bj)
#pragma unroll
          for (int n = 0; n < 2; ++n)
#pragma unroll
            for (int j = 0; j < 4; ++j) ss += acc[ai][bj][m][n][j] * acc[ai][bj][m][n][j];
        ss += __shfl_xor(ss, 16); ss += __shfl_xor(ss, 32);
        const float sc = rsqrtf(ss * (1.0f / 64.0f) + EPS);
#pragma unroll
        for (int bj = 0; bj < 2; ++bj) {
          uint4 u;
          u.x = pack2(acc[ai][bj][m][0][0] * sc * gn[bj][0], acc[ai][bj][m][0][1] * sc * gn[bj][1]);
          u.y = pack2(acc[ai][bj][m][0][2] * sc * gn[bj][2], acc[ai][bj][m][0][3] * sc * gn[bj][3]);
          u.z = pack2(acc[ai][bj][m][1][0] * sc * gn[bj][4], acc[ai][bj][m][1][1] * sc * gn[bj][5]);
          u.w = pack2(acc[ai][bj][m][1][2] * sc * gn[bj][6], acc[ai][bj][m][1][3] * sc * gn[bj][7]);
          *(uint4*)(sg.dst + (size_t)row * sg.ld + sg.col + 32 * bj + 8 * fq) = u;
        }
        __builtin_amdgcn_sched_barrier(0);
      }
  } else if (NAT) {
#pragma unroll
    for (int ai = 0; ai < 2; ++ai)
#pragma unroll
      for (int m = 0; m < 4; ++m) {
        const int row = m0 + 128 * ai + 64 * wr + 16 * m + 4 * fq;
        const f32x4 rv = *(const f32x4*)(sg.rs + row);
        f32x4 sc;
#pragma unroll
        for (int j = 0; j < 4; ++j) sc[j] = rsqrtf(rv[j] * (1.0f / 1024.0f) + EPS);
#pragma unroll
        for (int bj = 0; bj < 2; ++bj)
#pragma unroll
          for (int n = 0; n < 2; ++n) {
            const int ch = sg.col + 32 * bj + 8 * (fr >> 2) + 4 * n + (fr & 3);
            size_t off;
            if (sg.type == SEG_CHM) off = chm_index(sg.CH, row, ch);
            else off = ((size_t)((row >> 8) * 256 + ch) << 8) + (row & 255);
            const f32x4 v = acc[ai][bj][m][n] * sc;
            uint2 u; u.x = pack2(v[0], v[1]); u.y = pack2(v[2], v[3]);
            *(uint2*)(sg.dst + off) = u;
          }
        __builtin_amdgcn_sched_barrier(0);
      }
  } else if (sg.type == SEG_CHM) {
#pragma unroll
    for (int ai = 0; ai < 2; ++ai)
#pragma unroll
      for (int m = 0; m < 4; ++m) {
        const int row = m0 + 128 * ai + 64 * wr + 16 * m + fr;
        const float sc = rsqrtf(sg.rs[row] * (1.0f / 1024.0f) + EPS);
#pragma unroll
        for (int bj = 0; bj < 2; ++bj)
#pragma unroll
          for (int n = 0; n < 2; ++n)
#pragma unroll
            for (int j = 0; j < 4; ++j) sg.dst[chm_index(sg.CH, row, sg.col + 32 * bj + 8 * fq + 4 * n + j)] = f2bf(acc[ai][bj][m][n][j] * sc);
        __builtin_amdgcn_sched_barrier(0);
      }
  } else if (sg.type == SEG_MLP1) {
#pragma unroll
    for (int ai = 0; ai < 2; ++ai) {
      float sc[4];
#pragma unroll
      for (int m = 0; m < 4; ++m) sc[m] = rsqrtf(sg.rs[m0 + 128 * ai + 64 * wr + 16 * m + fr] * (1.0f / 1024.0f) + EPS);
#pragma unroll
      for (int m = 0; m < 4; ++m) {
        const int row = m0 + 128 * ai + 64 * wr + 16 * m + fr;
#pragma unroll
        for (int bj = 0; bj < 2; ++bj) {
          f32x4 a = acc[ai][bj][m][0] * sc[m], b = acc[ai][bj][m][1] * sc[m];
#pragma unroll
          for (int j = 0; j < 4; ++j) { a[j] = fmaxf(a[j], 0.f); a[j] *= a[j]; b[j] = fmaxf(b[j], 0.f); b[j] *= b[j]; }
          uint4 u; u.x = pack2(a[0], a[1]); u.y = pack2(a[2], a[3]); u.z = pack2(b[0], b[1]); u.w = pack2(b[2], b[3]);
          *(uint4*)(sg.dst + (size_t)row * sg.ld + sg.col + 32 * bj + 8 * fq) = u;
        }
        __builtin_amdgcn_sched_barrier(0);
      }
    }
  } else {
#pragma unroll
    for (int ai = 0; ai < 2; ++ai)
#pragma unroll
      for (int mp = 0; mp < 2; ++mp) {
        f32x4 xv[2][2][2];
#pragma unroll
        for (int mm = 0; mm < 2; ++mm) {
          const int row = m0 + 128 * ai + 64 * wr + 16 * (2 * mp + mm) + fr;
          const float* xo;
          if (sg.xin0) xo = (row < T_P) ? sg.xin0 + (size_t)row * DM : sg.xin1 + (size_t)(row - T_P) * DM;
          else xo = sg.xout + (size_t)row * DM;
#pragma unroll
          for (int bj = 0; bj < 2; ++bj) { xv[mm][bj][0] = *(const f32x4*)(xo + sg.col + 32 * bj + 8 * fq); xv[mm][bj][1] = *(const f32x4*)(xo + sg.col + 32 * bj + 8 * fq + 4); }
        }
#pragma unroll
        for (int mm = 0; mm < 2; ++mm) {
          const int m = 2 * mp + mm;
          const int row = m0 + 128 * ai + 64 * wr + 16 * m + fr;
          float ss = 0.f;
#pragma unroll
          for (int bj = 0; bj < 2; ++bj) {
            const f32x4 a = acc[ai][bj][m][0] + xv[mm][bj][0], b = acc[ai][bj][m][1] + xv[mm][bj][1];
            float* op = sg.xout + (size_t)row * DM + sg.col + 32 * bj + 8 * fq;
            *(f32x4*)op = a; *(f32x4*)(op + 4) = b;
            if (sg.xb) { uint4 u; u.x = pack2(a[0], a[1]); u.y = pack2(a[2], a[3]); u.z = pack2(b[0], b[1]); u.w = pack2(b[2], b[3]); *(uint4*)(sg.xb + (size_t)row * DM + sg.col + 32 * bj + 8 * fq) = u; }
#pragma unroll
            for (int j = 0; j < 4; ++j) ss += a[j] * a[j] + b[j] * b[j];
          }
          if (sg.rs_out) {
            ss += __shfl_xor(ss, 16); ss += __shfl_xor(ss, 32);
            if (fq == 0) atomicAdd(sg.rs_out + row, ss);
          }
          __builtin_amdgcn_sched_barrier(0);
        }
        __builtin_amdgcn_sched_barrier(0);
      }
  }
}

template <bool NAT, class Sched, class SegFn>
DI void gemm_stream(const GemmArgs& ga, const Sched& S, const SegFn& segfn) {
  extern __shared__ __attribute__((aligned(16))) char shm[];
  LAS3 unsigned char* lds = (LAS3 unsigned char*)shm;
  const int tid = opaque((int)threadIdx.x), wid = __builtin_amdgcn_readfirstlane(tid >> 6), lane = tid & 63, wr = wid >> 2, wc = wid & 3, fr = lane & 15, fq = lane >> 4;
  const int nt = ga.K >> 6, kst = ga.ksplit >> 6;
  unsigned voffA[2], voffB[2];
#pragma unroll
  for (int i = 0; i < 2; ++i) {
    int R, C; g_stage_rc(tid * 16 + i * 8192, R, C);
    const int Rb = ((R & ~31) << 1) + s8_perm32(R & 31);
    voffA[i] = (unsigned)(R * ga.lda + C) * 2u; voffB[i] = (unsigned)(Rb * ga.ldw + C) * 2u;
  }
  const size_t hstepA = (size_t)128 * ga.lda * 2, hstepB = (size_t)32 * ga.ldw * 2;
  const unsigned ldsw = (unsigned)wid * 1024u;
  const int aoff = g_lds_byte(wr * 64 + fr, fq * 8), boff = g_lds_byte(wc * 32 + fr, fq * 8);
#define S8_SA(b, h) (((b) * 2 + (h)) * S8_HTB)
#define S8_SB(b, h) ((4 + (b) * 2 + (h)) * S8_HTB)
#define S8_STAGE(bufoff, gbase, voff) do { _Pragma("unroll") for (int _i = 0; _i < 2; ++_i) \
    __builtin_amdgcn_global_load_lds((const unsigned*)((const char*)(gbase) + (voff)[_i]), (LAS3 unsigned*)(lds + (bufoff) + ldsw + _i * 8192), 16, 0, 0); } while (0)
#define S8_LDA(dst, b, h) do { _Pragma("unroll") for (int m = 0; m < 4; ++m) _Pragma("unroll") for (int k = 0; k < 2; ++k) dst[m][k] = *(const LAS3 bf16x8*)(lds + S8_SA(b, h) + aoff + m * 2048 + k * 1024); } while (0)
#define S8_LDB(dst, b, h) do { _Pragma("unroll") for (int n = 0; n < 2; ++n) _Pragma("unroll") for (int k = 0; k < 2; ++k) dst[n][k] = *(const LAS3 bf16x8*)(lds + S8_SB(b, h) + boff + n * 2048 + k * 1024); } while (0)
#define S8_MMA(ai, bj, At, Bt) s8_mma<NAT>(acc[ai][bj], At, Bt)
#define S8_WAIT_V(n) asm volatile("s_waitcnt vmcnt(" #n ")" ::: "memory")
#define S8_WAIT_L(n) asm volatile("s_waitcnt lgkmcnt(" #n ")" ::: "memory")
#define S8_BAR __builtin_amdgcn_s_barrier()
#define S8_SCHED __builtin_amdgcn_sched_barrier(0)
  auto aptr = [&](const SUnit& u, int t) -> const char* {
    return (const char*)((t < kst ? ga.A0 + (size_t)t * 64 : ga.A1 + (size_t)(t - kst) * 64) + (size_t)u.m0 * ga.lda);
  };
  auto bptr = [&](const SUnit& u, int t) -> const char* { return (const char*)(ga.Wt + (size_t)u.n0 * ga.ldw + (size_t)t * 64); };
  SUnit cur, nxt; int ui = 0;
  if (!S.next(0, cur)) return;
  f32x4 acc[2][2][4][2];
#pragma unroll
  for (int a = 0; a < 2; ++a)
#pragma unroll
    for (int b = 0; b < 2; ++b)
#pragma unroll
      for (int m = 0; m < 4; ++m)
#pragma unroll
        for (int n = 0; n < 2; ++n) acc[a][b][m][n] = (f32x4){0.f, 0.f, 0.f, 0.f};
  bf16x8 At[4][2], B0[2][2], B1[2][2];
  Seg seg = segfn(cur, wc);
  { const char* cA = aptr(cur, 0); const char* cB = bptr(cur, 0); const char* cA1 = aptr(cur, 1); const char* cB1 = bptr(cur, 1);
    S8_STAGE(S8_SB(0, 0), cB, voffB); S8_STAGE(S8_SA(0, 0), cA, voffA); S8_STAGE(S8_SB(0, 1), cB + hstepB, voffB); S8_STAGE(S8_SA(0, 1), cA + hstepA, voffA);
    if (wr == 1) S8_BAR;
    S8_WAIT_V(4); S8_BAR;
    S8_STAGE(S8_SB(1, 0), cB1, voffB); S8_STAGE(S8_SA(1, 0), cA1, voffA); S8_STAGE(S8_SB(1, 1), cB1 + hstepB, voffB);
    S8_WAIT_V(6); S8_BAR; }
  for (;;) {
    const bool has_next = S.next(ui + 1, nxt);
    const SUnit nu = has_next ? nxt : cur;
#pragma unroll 1
    for (int t = 0; t < nt; t += 2) {
      const bool last = (t == nt - 2);
      const char* a1 = aptr(cur, t + 1);
      const char* a2 = last ? aptr(nu, 0) : aptr(cur, t + 2); const char* b2 = last ? bptr(nu, 0) : bptr(cur, t + 2);
      const char* a3 = last ? aptr(nu, 1) : aptr(cur, t + 3); const char* b3 = last ? bptr(nu, 1) : bptr(cur, t + 3);
      S8_LDB(B0, 0, 0); S8_SCHED; S8_LDA(At, 0, 0); S8_STAGE(S8_SA(1, 1), a1 + hstepA, voffA);
      S8_WAIT_L(8); S8_BAR; S8_WAIT_L(0); S8_MMA(0, 0, At, B0); S8_BAR; S8_SCHED;
      S8_LDB(B1, 0, 1); S8_STAGE(S8_SB(0, 0), b2, voffB);
      S8_BAR; S8_WAIT_L(0); S8_MMA(0, 1, At, B1); S8_BAR;
      S8_LDA(At, 0, 1); S8_STAGE(S8_SA(0, 0), a2, voffA);
      S8_BAR; S8_WAIT_L(0); S8_MMA(1, 0, At, B0); S8_BAR; S8_SCHED;
      S8_STAGE(S8_SB(0, 1), b2 + hstepB, voffB);
      S8_WAIT_V(6); S8_BAR; S8_MMA(1, 1, At, B1); S8_BAR;
      S8_LDB(B0, 1, 0); S8_SCHED; S8_LDA(At, 1, 0); S8_STAGE(S8_SA(0, 1), a2 + hstepA, voffA);
      S8_WAIT_L(8); S8_BAR; S8_WAIT_L(0); S8_MMA(0, 0, At, B0); S8_BAR; S8_SCHED;
      S8_LDB(B1, 1, 1); S8_STAGE(S8_SB(1, 0), b3, voffB);
      S8_BAR; S8_WAIT_L(0); S8_MMA(0, 1, At, B1); S8_BAR;
      S8_LDA(At, 1, 1); S8_STAGE(S8_SA(1, 0), a3, voffA);
      S8_BAR; S8_WAIT_L(0); S8_MMA(1, 0, At, B0); S8_BAR; S8_SCHED;
      S8_STAGE(S8_SB(1, 1), b3 + hstepB, voffB);
      S8_WAIT_V(6); S8_BAR; S8_MMA(1, 1, At, B1); S8_BAR;
    }
#ifndef S8_NOEPI
    { const int lane2 = opaque((int)__builtin_amdgcn_mbcnt_hi(~0u, __builtin_amdgcn_mbcnt_lo(~0u, 0u))); s8_epilogue<NAT>(acc, seg, cur.m0, wr, lane2 & 15, lane2 >> 4); }
#else
    if (seg.type == 77) *(f32x4*)(seg.xout + fr) = acc[0][0][0][0] + acc[1][1][3][1] + acc[0][1][2][0] + acc[1][0][1][1];
#endif
    if (!has_next) break;
#pragma unroll
    for (int a = 0; a < 2; ++a)
#pragma unroll
      for (int b = 0; b < 2; ++b)
#pragma unroll
        for (int m = 0; m < 4; ++m)
#pragma unroll
          for (int n = 0; n < 2; ++n) acc[a][b][m][n] = (f32x4){0.f, 0.f, 0.f, 0.f};
    cur = nxt; ++ui;
    seg = segfn(cur, wc);
  }
  S8_WAIT_V(0);
  if (wr == 0) S8_BAR;
  S8_BAR;
}

enum { AM_MEM = 0, AM_DIFF = 1, AM_WG = 2, AM_NA = 3 };
constexpr int ATT_LUT_OFS = 73728;
constexpr int ATT_O0_OFS = 77824;

template <int VD, int MODE>
DI void attn_core(char* smem, const bf16_t* Q, int ldq, const bf16_t* K, int ldk, const bf16_t* Vt, int ldv,
                  int qpos0, int kbeg, int kend, int nrows, float sink_l2, float (&O)[2][VD / 16][4]) {
  constexpr int NDB = VD / 16;
  constexpr int STAGE = 8192 + VD * 128;
  constexpr int NL = 1 + VD / 64;
  extern __shared__ __attribute__((aligned(16))) char shm[];
  const int tid = opaque((int)threadIdx.x), lane = tid & 63, wave = tid >> 6;
  const int l16 = lane & 15, g = lane >> 4;
  const float* lut = (const float*)(smem + ATT_LUT_OFS);
  bf16x8 qf[2][2];
#pragma unroll
  for (int qb = 0; qb < 2; ++qb)
#pragma unroll
    for (int kk = 0; kk < 2; ++kk) qf[qb][kk] = *(const bf16x8*)(Q + (size_t)(32 * wave + 16 * qb + l16) * ldq + 32 * kk + 8 * g);
  float m[2] = {-1e30f, -1e30f};
  f32x4 Oa[2][NDB], Ol[2];
#pragma unroll
  for (int qb = 0; qb < 2; ++qb) {
    Ol[qb] = (f32x4){0.f, 0.f, 0.f, 0.f};
#pragma unroll
    for (int db = 0; db < NDB; ++db) Oa[qb][db] = (f32x4){0.f, 0.f, 0.f, 0.f};
  }
  bf16x8 ones;
#pragma unroll
  for (int j = 0; j < 8; ++j) ones[j] = (short)0x3F80;
  const int wq0 = qpos0 + 32 * wave;
  const int srow = 8 * wave + (lane >> 3);
  const int schunk = (lane & 7) ^ (lane >> 3);
  const int schunkK = (lane & 7) ^ ((wave & 3) | ((((lane >> 3) >> 1) & 1) << 2));
#define ATT_ISSUE(k0_, st_) do { \
    __builtin_amdgcn_global_load_lds((const unsigned*)(K + (size_t)((k0_) + srow) * ldk + 8 * schunkK), (__attribute__((address_space(3))) unsigned*)(shm + (st_) * STAGE + wave * 1024), 16, 0, 0); \
    __builtin_amdgcn_global_load_lds((const unsigned*)(Vt + (size_t)(srow) * ldv + (k0_) + 8 * schunk), (__attribute__((address_space(3))) unsigned*)(shm + (st_) * STAGE + 8192 + wave * 1024), 16, 0, 0); \
    if (VD == 128) __builtin_amdgcn_global_load_lds((const unsigned*)(Vt + (size_t)(srow + 64) * ldv + (k0_) + 8 * schunk), (__attribute__((address_space(3))) unsigned*)(shm + (st_) * STAGE + 8192 + 8192 + wave * 1024), 16, 0, 0); } while (0)
  const int ntile = (kend - kbeg) >> 6;
  ATT_ISSUE(kbeg, 0);
  if (ntile > 1) { ATT_ISSUE(kbeg + 64, 1); asm volatile("s_waitcnt vmcnt(%0)" :: "n"(NL) : "memory"); }
  else asm volatile("s_waitcnt vmcnt(0)" ::: "memory");
  __builtin_amdgcn_s_barrier();
  int it = 0, st = 0;
  for (int k0 = kbeg; k0 < kend; k0 += 64, ++it) {
    { const int st2 = (st >= 1) ? st - 1 : 2; if (it + 2 < ntile) ATT_ISSUE(k0 + 128, st2); }
    const char* Ks = shm + st * STAGE; const char* Vs = Ks + 8192;
    bool active = true;
    if (MODE == AM_WG) active = !(k0 + 63 < wq0 - 128 || k0 > wq0 + 31 + 128);
    int na_rs = 0; const int qr = wq0 >> 6, kr = k0 >> 6;
    if (MODE == AM_NA) { na_rs = min(max(qr - 4, 0), nrows - 8); active = (kr >= na_rs && kr < na_rs + 8); }
    if (active) {
      float coff = 0.f;
      bool lut_tile = false;
      if (MODE == AM_DIFF) {
        if (k0 + 63 - wq0 <= -128) coff = lut[0];
        else if (k0 - (wq0 + 31) >= 128) coff = lut[256];
        else lut_tile = true;
      }
      float nsh[2];
#pragma unroll
      for (int qb = 0; qb < 2; ++qb) nsh[qb] = (m[qb] > -1e29f) ? (coff - m[qb]) : 0.f;
      f32x4 S[2][4];
#pragma unroll
      for (int kb = 0; kb < 4; ++kb) {
        const int krow = 32 * (kb >> 1) + 8 * (l16 >> 2) + 4 * (kb & 1) + (l16 & 3);
        const int kfz = ((krow >> 3) & 3) | (((krow >> 1) & 1) << 2);
        bf16x8 kf0 = *(const bf16x8*)(Ks + krow * 128 + ((g ^ kfz) << 4));
        bf16x8 kf1 = *(const bf16x8*)(Ks + krow * 128 + (((4 + g) ^ kfz) << 4));
#pragma unroll
        for (int qb = 0; qb < 2; ++qb) {
          f32x4 z = (f32x4){nsh[qb], nsh[qb], nsh[qb], nsh[qb]};
          z = MFMA16(kf0, qf[qb][0], z);
          S[qb][kb] = MFMA16(kf1, qf[qb][1], z);
        }
      }
#pragma unroll
      for (int qb = 0; qb < 2; ++qb) {
        const int q = wq0 + 16 * qb + l16;
        if ((MODE == AM_DIFF && lut_tile) || MODE == AM_WG) {
#pragma unroll
          for (int kb = 0; kb < 4; ++kb)
#pragma unroll
            for (int r = 0; r < 4; ++r) {
              const int rel = k0 + 32 * (kb >> 1) + 8 * g + 4 * (kb & 1) + r - q;
              const int rc = min(max(rel, -128), 128);
              float sv = S[qb][kb][r] + lut[rc + 128];
              if (MODE == AM_WG && (rel > 128 || rel < -128)) sv = -1e30f;
              S[qb][kb][r] = sv;
            }
        } else if (MODE == AM_NA) {
          const int qc = q & 63;
          const int cs = min(max(qc - 8, 0), 48);
          const int dr = kr - qr + 7;
#pragma unroll
          for (int kb = 0; kb < 4; ++kb)
#pragma unroll
            for (int r = 0; r < 4; ++r) {
              const int kc = 32 * (kb >> 1) + 8 * g + 4 * (kb & 1) + r;
              const bool ok = (kc >= cs) && (kc < cs + 16);
              const int dc = min(max(kc - qc + 15, 0), 30);
              float sv = S[qb][kb][r] + lut[dr * 31 + dc];
              S[qb][kb][r] = ok ? sv : -1e30f;
            }
        }
      }
      bool need = (m[0] <= -1e29f) || (m[1] <= -1e29f);
#pragma unroll
      for (int qb = 0; qb < 2; ++qb)
#pragma unroll
        for (int kb = 0; kb < 4; ++kb)
#pragma unroll
          for (int r = 0; r < 4; ++r) need = need || (S[qb][kb][r] > 8.0f);
      if (__any(need)) {
#pragma unroll
        for (int qb = 0; qb < 2; ++qb) {
          float v = -1e30f;
#pragma unroll
          for (int kb = 0; kb < 4; ++kb) v = fmaxf(v, fmaxf(fmaxf(S[qb][kb][0], S[qb][kb][1]), fmaxf(S[qb][kb][2], S[qb][kb][3])));
          v = fmaxf(v, __shfl_xor(v, 16)); v = fmaxf(v, __shfl_xor(v, 32));
          const bool lf = (m[qb] <= -1e29f);
          const float delta = lf ? v : fmaxf(v, 0.f);
          const float alpha = lf ? 0.f : ex2(-delta);
          m[qb] = lf ? (v + coff) : (m[qb] + delta);
          Ol[qb] *= alpha;
#pragma unroll
          for (int db = 0; db < NDB; ++db) Oa[qb][db] *= alpha;
#pragma unroll
          for (int kb = 0; kb < 4; ++kb)
#pragma unroll
            for (int r = 0; r < 4; ++r) S[qb][kb][r] -= delta;
        }
      }
#pragma unroll
      for (int qb = 0; qb < 2; ++qb)
#pragma unroll
        for (int kb = 0; kb < 4; ++kb)
#pragma unroll
          for (int r = 0; r < 4; ++r) S[qb][kb][r] = ex2(S[qb][kb][r]);
#pragma unroll
      for (int ks = 0; ks < 2; ++ks) {
        bf16x8 pf[2];
#pragma unroll
        for (int qb = 0; qb < 2; ++qb) {
          uint4 u;
          u.x = pack2(S[qb][2 * ks][0], S[qb][2 * ks][1]); u.y = pack2(S[qb][2 * ks][2], S[qb][2 * ks][3]);
          u.z = pack2(S[qb][2 * ks + 1][0], S[qb][2 * ks + 1][1]); u.w = pack2(S[qb][2 * ks + 1][2], S[qb][2 * ks + 1][3]);
          pf[qb] = __builtin_bit_cast(bf16x8, u);
          Ol[qb] = MFMA16(ones, pf[qb], Ol[qb]);
        }
#pragma unroll
        for (int db = 0; db < NDB; ++db) {
          const bf16x8 vf = *(const bf16x8*)(Vs + (16 * db + l16) * 128 + (((4 * ks + g) ^ (l16 & 7)) << 4));
#pragma unroll
          for (int qb = 0; qb < 2; ++qb) Oa[qb][db] = MFMA16(vf, pf[qb], Oa[qb][db]);
        }
      }
    }
    if (it + 2 < ntile) asm volatile("s_waitcnt vmcnt(%0)" :: "n"(NL) : "memory");
    else asm volatile("s_waitcnt vmcnt(0)" ::: "memory");
    asm volatile("s_waitcnt lgkmcnt(0)" ::: "memory");
    __builtin_amdgcn_s_barrier();
    st = (st == 2) ? 0 : st + 1;
  }
#pragma unroll
  for (int qb = 0; qb < 2; ++qb) {
    float lt = Ol[qb][0];
    if (MODE == AM_WG) lt += ex2(sink_l2 - m[qb]);
    const float inv = 1.0f / lt;
#pragma unroll
    for (int db = 0; db < NDB; ++db)
#pragma unroll
      for (int r = 0; r < 4; ++r) O[qb][db][r] = Oa[qb][db][r] * inv;
  }
}

template <int NDB>
DI void attn_store(bf16_t* dst, int ld, const float (&O)[2][NDB][4]) {
  const int lane = threadIdx.x & 63, wave = threadIdx.x >> 6, l16 = lane & 15, g = lane >> 4;
#pragma unroll
  for (int qb = 0; qb < 2; ++qb)
#pragma unroll
    for (int db = 0; db < NDB; ++db) {
      uint2 v; v.x = pack2(O[qb][db][0], O[qb][db][1]); v.y = pack2(O[qb][db][2], O[qb][db][3]);
      *(uint2*)(dst + (size_t)(32 * wave + 16 * qb + l16) * ld + 16 * db + 4 * g) = v;
    }
}

DI void seq_of_row(int row0, int& L, int& seq_row0, int& b_glob) {
  if (row0 < T_P) { L = LP; int b = row0 >> 14; seq_row0 = b << 14; b_glob = b; }
  else { L = LS; int b = (row0 - T_P) >> 11; seq_row0 = T_P + (b << 11); b_glob = 2 + b; }
}

DI void diff_item(char* smem, const Params& p, int item, bool dry = false) {
  bf16_t* QA = (bf16_t*)(p.ws + WS_R0);
  const bf16_t* KA = (const bf16_t*)((const char*)p.out + 192 * MiB);
  const bf16_t* VAt = (const bf16_t*)(p.ws + WS_R2);
  const float* misc_lut = (const float*)(p.ws + WS_MISC + MS_LUT);
  const float lam = *(const float*)(p.ws + WS_MISC + MS_LAM);
  int h, row0;
  if (item < 512) { h = item & 3; row0 = (item >> 2) * 256; }
  else { int i2 = item - 512; h = i2 & 3; row0 = T_P + (i2 >> 2) * 256; }
  int L, srow0, bg; seq_of_row(row0, L, srow0, bg);
  const int qpos0 = row0 - srow0;
  const bf16_t* Vt = VAt + chm_index(512, srow0, h * 128);
  float O[2][8][4];
  unsigned* o0s = (unsigned*)(smem + ATT_O0_OFS) + threadIdx.x;
  const int tid = threadIdx.x;
#pragma unroll 1
  for (int mp = 0; mp < 2; ++mp) {
    __syncthreads();
    for (int i = tid; i < 257; i += NTHR) ((float*)(smem + ATT_LUT_OFS))[i] = misc_lut[(h * 2 + mp) * 257 + i];
    __syncthreads();
    attn_core<128, AM_DIFF>(smem, QA + (size_t)row0 * 512 + h * 128 + mp * 64, 512, KA + (size_t)srow0 * 512 + h * 128 + mp * 64, 512,
                            Vt, L, qpos0, 0, L, 0, 0.f, O);
    if (mp == 0) {
#pragma unroll
      for (int qb = 0; qb < 2; ++qb)
#pragma unroll
        for (int db = 0; db < 8; ++db) { o0s[((qb * 8 + db) * 2) * NTHR] = pack2(O[qb][db][0], O[qb][db][1]); o0s[((qb * 8 + db) * 2 + 1) * NTHR] = pack2(O[qb][db][2], O[qb][db][3]); }
    }
  }
  const int tid2 = opaque((int)threadIdx.x);
  const int lane = tid2 & 63, l16 = lane & 15, g = lane >> 4;
  const float* sg = p.in[13];
#pragma unroll
  for (int qb = 0; qb < 2; ++qb) {
    float ss = 0.f;
#pragma unroll
    for (int db = 0; db < 8; ++db) {
      const unsigned w0 = o0s[((qb * 8 + db) * 2) * NTHR], w1 = o0s[((qb * 8 + db) * 2 + 1) * NTHR];
      float a0 = bf2f((unsigned short)(w0 & 0xffff)), a1 = bf2f((unsigned short)(w0 >> 16));
      float a2 = bf2f((unsigned short)(w1 & 0xffff)), a3 = bf2f((unsigned short)(w1 >> 16));
      O[qb][db][0] = a0 - lam * O[qb][db][0]; O[qb][db][1] = a1 - lam * O[qb][db][1];
      O[qb][db][2] = a2 - lam * O[qb][db][2]; O[qb][db][3] = a3 - lam * O[qb][db][3];
#pragma unroll
      for (int r = 0; r < 4; ++r) ss += O[qb][db][r] * O[qb][db][r];
    }
    ss += __shfl_xor(ss, 16); ss += __shfl_xor(ss, 32);
    const float sc = rsqrtf(ss * (1.0f / 128.0f) + EPS) * 0.8f;
#pragma unroll
    for (int db = 0; db < 8; ++db)
#pragma unroll
      for (int r = 0; r < 4; ++r) O[qb][db][r] *= sc * sg[16 * db + 4 * g + r];
  }
  if (dry) attn_store<8>((bf16_t*)(p.ws + 484 * MiB), 512, O); else attn_store<8>(QA + (size_t)row0 * 512 + h * 128, 512, O);
}

DI void wg_item(char* smem, const Params& p, int item, bool dry = false) {
  bf16_t* QD = (bf16_t*)(p.ws + WS_R3);
  const bf16_t* KD = (const bf16_t*)(p.ws + WS_KD);
  const bf16_t* VDt = (const bf16_t*)(p.ws + WS_VDT);
  const float* misc_lut = (const float*)(p.ws + WS_MISC + MS_LUT);
  const int hq = item & 7; const int row0 = (item >> 3) * 256;
  int L, srow0, bg; seq_of_row(row0, L, srow0, bg);
  const int qpos0 = row0 - srow0;
  const int kvh = hq >> 2;
  __syncthreads();
  for (int i = threadIdx.x; i < 257; i += NTHR) ((float*)(smem + ATT_LUT_OFS))[i] = misc_lut[hq * 257 + i];
  __syncthreads();
  float O[2][4][4];
  const int kbeg = max(0, qpos0 - 128), kend = min(L, qpos0 + 256 + 128);
  attn_core<64, AM_WG>(smem, QD + (size_t)row0 * 512 + hq * 64, 512, KD + (size_t)srow0 * 128 + kvh * 64, 128,
                       VDt + chm_index(128, srow0, kvh * 64), L, qpos0, kbeg, kend, 0, p.in[30][hq] * LOG2E, O);
  if (dry) attn_store<4>((bf16_t*)(p.ws + 484 * MiB), 512, O); else attn_store<4>(QD + (size_t)row0 * 512 + hq * 64, 512, O);
}

DI void na_item(char* smem, const Params& p, int item, bool dry = false) {
  bf16_t* QC = (bf16_t*)(p.ws + WS_R0);
  const bf16_t* KC = (const bf16_t*)(p.ws + WS_R1);
  const bf16_t* VCt = (const bf16_t*)(p.ws + WS_R2);
  const int h = item & 7; const int row0 = (item >> 3) * 256;
  int L, srow0, bg; seq_of_row(row0, L, srow0, bg);
  const int qpos0 = row0 - srow0;
  const int nrows = L >> 6;
  __syncthreads();
  for (int i = threadIdx.x; i < 465; i += NTHR) ((float*)(smem + ATT_LUT_OFS))[i] = p.in[27][h * 465 + i] * LOG2E;
  __syncthreads();
  const int qr0 = qpos0 >> 6;
  const int rs0 = min(max(qr0 - 4, 0), nrows - 8), rs3 = min(max(qr0 + 3 - 4, 0), nrows - 8);
  float O[2][4][4];
  attn_core<64, AM_NA>(smem, QC + (size_t)row0 * 512 + h * 64, 512, KC + (size_t)srow0 * 512 + h * 64, 512,
                       VCt + chm_index(512, srow0, h * 64), L, qpos0, rs0 * 64, (rs3 + 8) * 64, nrows, 0.f, O);
  if (dry) attn_store<4>((bf16_t*)(p.ws + 484 * MiB), 512, O); else attn_store<4>(QC + (size_t)row0 * 512 + h * 64, 512, O);
}

DI void mem_attn_tile(char* smem, const Params& p, int layer, int row0) {
  bf16_t* QM = (bf16_t*)(p.ws + WS_QM);
  const bf16_t* MK = (const bf16_t*)(p.ws + WS_MISC + MS_MK) + (size_t)layer * 18 * 256 * 256;
  const bf16_t* MVt = (const bf16_t*)(p.ws + WS_MISC + MS_MVT) + (size_t)layer * 18 * 256 * 256;
  int L, srow0, bg; seq_of_row(row0, L, srow0, bg);
#pragma unroll 1
  for (int h = 0; h < 4; ++h) {
    float O[2][4][4];
    attn_core<64, AM_MEM>(smem, QM + (size_t)row0 * 256 + h * 64, 256, MK + (size_t)bg * 256 * 256 + h * 64, 256,
                          MVt + ((size_t)(bg * 256 + h * 64) << 8), 256, 0, 0, 256, 0, 0.f, O);
    attn_store<4>(QM + (size_t)row0 * 256 + h * 64, 256, O);
  }
}

DI int PADI(int i) { return i + (i >> 5); }
DI float2 cmul(float2 a, float2 b) { return make_float2(a.x * b.x - a.y * b.y, a.x * b.y + a.y * b.x); }
DI float2 cmulc(float2 a, float2 b) { return make_float2(a.x * b.x + a.y * b.y, a.y * b.x - a.x * b.y); }
DI constexpr float C16(int m) { return m == 0 ? 1.f : m == 1 ? 0.92387953251128674f : m == 2 ? 0.70710678118654752f : m == 3 ? 0.38268343236508977f : m == 4 ? 0.f : m == 5 ? -0.38268343236508977f : m == 6 ? -0.70710678118654752f : -0.92387953251128674f; }
DI constexpr float S16(int m) { return m == 0 ? 0.f : m == 1 ? 0.38268343236508977f : m == 2 ? 0.70710678118654752f : m == 3 ? 0.92387953251128674f : m == 4 ? 1.f : m == 5 ? 0.92387953251128674f : m == 6 ? 0.70710678118654752f : 0.38268343236508977f; }

template <int LOGR, int LOGS, bool INV>
DI void fft_pass(float2* buf, int total) {
  constexpr int R = 1 << LOGR;
  constexpr int S = 1 << LOGS;
  const int tid0 = opaque((int)threadIdx.x);
#pragma unroll 1
  for (int u = tid0; u < (total >> LOGR); u += NTHR) {
    const int j = u & (S - 1);
    const int base = ((u >> LOGS) << (LOGS + LOGR)) + j;
    float2* bp = buf + PADI(base);
    float2 x[R];
#pragma unroll
    for (int k = 0; k < R; ++k) x[k] = bp[k * S + ((k * S) >> 5)];
    float2 pw[LOGR];
    {
      const float rev = -(float)j * (1.0f / (float)(R * S));
      pw[0] = make_float2(cos_rev(rev), sin_rev(rev));
#pragma unroll
      for (int i = 1; i < LOGR; ++i) pw[i] = cmul(pw[i - 1], pw[i - 1]);
    }
    if (!INV) {
#pragma unroll
      for (int i = 0; i < LOGR; ++i) {
        const int h = R >> (i + 1);
#pragma unroll
        for (int k = 0; k < R; ++k) {
          if ((k & h) == 0) {
            const int mm = (k & (h - 1)) * 8 / h;
            float2 a = x[k], b = x[k + h];
            x[k] = make_float2(a.x + b.x, a.y + b.y);
            float2 d = make_float2(a.x - b.x, a.y - b.y);
            if (mm != 0) d = cmul(d, make_float2(C16(mm), -S16(mm)));
            x[k + h] = cmul(d, pw[i]);
          }
        }
      }
    } else {
#pragma unroll
      for (int i = LOGR - 1; i >= 0; --i) {
        const int h = R >> (i + 1);
#pragma unroll
        for (int k = 0; k < R; ++k) {
          if ((k & h) == 0) {
            const int mm = (k & (h - 1)) * 8 / h;
            float2 a = x[k];
            float2 d = cmulc(x[k + h], pw[i]);
            if (mm != 0) d = cmulc(d, make_float2(C16(mm), -S16(mm)));
            x[k] = make_float2(a.x + d.x, a.y + d.y);
            x[k + h] = make_float2(a.x - d.x, a.y - d.y);
          }
        }
      }
    }
#pragma unroll
    for (int k = 0; k < R; ++k) bp[k * S + ((k * S) >> 5)] = x[k];
  }
  __syncthreads();
}

template <int LOGN>
DI void fft_fwd(float2* buf, int total) {
  if (LOGN == 14) { fft_pass<4, 10, false>(buf, total); fft_pass<4, 6, false>(buf, total); fft_pass<4, 2, false>(buf, total); fft_pass<2, 0, false>(buf, total); }
  else { fft_pass<4, 7, false>(buf, total); fft_pass<4, 3, false>(buf, total); fft_pass<3, 0, false>(buf, total); }
}
template <int LOGN>
DI void fft_inv(float2* buf, int total) {
  if (LOGN == 14) { fft_pass<2, 0, true>(buf, total); fft_pass<4, 2, true>(buf, total); fft_pass<4, 6, true>(buf, total); fft_pass<4, 10, true>(buf, total); }
  else { fft_pass<3, 0, true>(buf, total); fft_pass<4, 3, true>(buf, total); fft_pass<4, 7, true>(buf, total); }
}

template <int LOGN, int NB, int NSUB>
DI void hyena_item(char* smem, const Params& p, int c, int row_base  ) {
  constexpr int L = 1 << LOGN;
  constexpr int SPT = L / NTHR;
  constexpr int EPT = NB * L / NTHR;
  const int tid = opaque((int)threadIdx.x);
  float2* buf = (float2*)smem;
  float* sm_w3 = (float*)(smem + 135168);
  float* sm_red = sm_w3 + 256;
  char* scr = p.ws + WS_XB + (size_t)blockIdx.x * HY_SCR_PER_BLOCK;
  float* scrF0 = (float*)scr;
  float* scrB0 = scrF0 + L;
  float* scrF1 = (float*)(p.ws + 451 * MiB + (size_t)blockIdx.x * 128 * 1024);
  float* scrB1 = scrF1 + L;
  float2* scrY = (float2*)(scr + 128 * 1024);
  float2* scrZ = (float2*)(scr + 256 * 1024);
  float2* scrS = (float2*)(scr + 384 * 1024);
  const bf16_t* UH = (const bf16_t*)p.out;
  bf16_t* OBt = (bf16_t*)(p.ws + WS_R3);
  const bf16_t* h2b = (const bf16_t*)(p.ws + WS_MISC + (LOGN == 14 ? MS_H2P : MS_H2S));
  const float* w3 = p.in[21];
  const float* cw = p.in[14]; const float* cb = p.in[15]; const float* skp = p.in[22];
  const float delta = fabsf(-3.0701134573253945f + (float)c * ((-15.350567286626973f + 3.0701134573253945f) / 511.0f));
  const float invLm1 = 1.0f / (float)(L - 1);

  float wv[3][4];
#pragma unroll
  for (int q = 0; q < 3; ++q) { const int ch = q * 512 + c; wv[q][0] = cw[ch]; wv[q][1] = cw[1536 + ch]; wv[q][2] = cw[2 * 1536 + ch]; wv[q][3] = cb[ch]; }
  auto loadu3 = [&](int b, int ch, int n, float (&r)[3]) {
    const bf16_t* u = UH + chm_index(1536, row_base + b * L, ch) + n;
    r[1] = bf2f(u[0]);
    r[0] = (n > 0) ? bf2f(u[-1]) : 0.f;
    r[2] = (n < L - 1) ? bf2f(u[1]) : 0.f;
  };
  auto convw = [&](int q, const float (&r)[3]) -> float { return r[0] * wv[q][0] + r[1] * wv[q][1] + r[2] * wv[q][2] + wv[q][3]; };

  {
    __syncthreads();
    if (tid < 256) sm_w3[tid] = w3[(size_t)(tid & 63) * 2048 + (tid >> 6) * 512 + c];
    __syncthreads();
    float asum0 = 0.f, asum1 = 0.f;
    constexpr int NP = L / (2 * NTHR);
    constexpr int CHK = NP < 8 ? NP : 8;
#pragma unroll 1
    for (int rep = 0; rep < ((PROBE & 64) ? 2 : 1); ++rep) {
      asum0 = 0.f; asum1 = 0.f;
#pragma unroll 1
      for (int i0 = 0; i0 < NP; i0 += CHK) {
        float acc[CHK][4][2];
#pragma unroll
        for (int i = 0; i < CHK; ++i)
#pragma unroll
          for (int q = 0; q < 4; ++q) { acc[i][q][0] = 0.f; acc[i][q][1] = 0.f; }
#pragma unroll 1
        for (int j = 0; j < 64; ++j) {
          const float w0 = sm_w3[j], w1 = sm_w3[64 + j], w2 = sm_w3[128 + j], w3v = sm_w3[192 + j];
          const unsigned* hp = (const unsigned*)(h2b + (size_t)j * L) + tid + NTHR * i0;
#pragma unroll
          for (int i = 0; i < CHK; ++i) {
            const unsigned hv = hp[NTHR * i];
            const float h0 = __uint_as_float(hv << 16), h1 = __uint_as_float(hv & 0xffff0000u);
            acc[i][0][0] += h0 * w0; acc[i][0][1] += h1 * w0; acc[i][1][0] += h0 * w1; acc[i][1][1] += h1 * w1;
            acc[i][2][0] += h0 * w2; acc[i][2][1] += h1 * w2; acc[i][3][0] += h0 * w3v; acc[i][3][1] += h1 * w3v;
          }
        }
#pragma unroll
        for (int i = 0; i < CHK; ++i) {
          const int t0 = 2 * (tid + NTHR * (i0 + i));
          const float d0 = ex2(-(float)t0 * invLm1 * delta * LOG2E), d1 = ex2(-(float)(t0 + 1) * invLm1 * delta * LOG2E);
          const float f00 = acc[i][0][0] * d0, f01 = acc[i][0][1] * d1, b00 = acc[i][1][0] * d0, b01 = acc[i][1][1] * d1;
          const float f10 = acc[i][2][0] * d0, f11 = acc[i][2][1] * d1, b10 = acc[i][3][0] * d0, b11 = acc[i][3][1] * d1;
          *(float2*)(scrF0 + t0) = make_float2(f00, f01); *(float2*)(scrB0 + t0) = make_float2(b00, b01);
          *(float2*)(scrF1 + t0) = make_float2(f10, f11); *(float2*)(scrB1 + t0) = make_float2(b10, b11);
          asum0 += fabsf(f00) + fabsf(f01) + (t0 >= 1 ? fabsf(b00) : 0.f) + fabsf(b01);
          asum1 += fabsf(f10) + fabsf(f11) + (t0 >= 1 ? fabsf(b10) : 0.f) + fabsf(b11);
        }
      }
    }
#pragma unroll
    for (int s = 32; s >= 1; s >>= 1) { asum0 += __shfl_xor(asum0, s); asum1 += __shfl_xor(asum1, s); }
    if ((tid & 63) == 0) { sm_red[tid >> 6] = asum0; sm_red[8 + (tid >> 6)] = asum1; }
    block_sync_global();
  }
#pragma unroll 1
  for (int o = 0; o < 2; ++o) {
    float nrm = 0.f;
#pragma unroll
    for (int w = 0; w < 8; ++w) nrm += sm_red[8 * o + w];
    const float inv_nrm = 1.0f / nrm;
    const float* scrF = o ? scrF1 : scrF0;
    const float* scrB = o ? scrB1 : scrB0;
    const float sk = skp[o * 512 + c];

#pragma unroll 1
    for (int par = 0; par < 2; ++par) {
#pragma unroll 2
      for (int i = 0; i < SPT; ++i) {
        const int n = tid + NTHR * i;
        const float f = scrF[n];
        const float br = (n == 0) ? 0.f : scrB[L - n];
        float2 v;
        if (par == 0) v = make_float2((f + br) * inv_nrm, 0.f);
        else { const float gm = (f - br) * inv_nrm; const float rev = -(float)n / (float)(2 * L); v = make_float2(gm * cos_rev(rev), gm * sin_rev(rev)); }
        buf[PADI(n)] = v;
      }
      __syncthreads();
      fft_fwd<LOGN>(buf, L);
#pragma unroll 8
      for (int i = 0; i < SPT; ++i) scrS[tid + NTHR * i] = buf[PADI(tid + NTHR * i)];
      __syncthreads();
#pragma unroll 1
      for (int sub = 0; sub < NSUB; ++sub) {
        constexpr int BT = 4;
#pragma unroll 1
        for (int i0 = 0; i0 < EPT; i0 += BT) {
          float2 zz[BT];
          if (o == 0 && par == 0) {
            float ra[BT][3], rb[BT][3];
#pragma unroll
            for (int k = 0; k < BT; ++k) {
              const int e = tid + NTHR * (i0 + k); const int f = e >> LOGN, n = e & (L - 1); const int pp = sub * NB + f;
              loadu3(2 * pp, c, n, ra[k]); loadu3(2 * pp + 1, c, n, rb[k]);
            }
#pragma unroll
            for (int k = 0; k < BT; ++k) {
              const int e = tid + NTHR * (i0 + k); const int f = e >> LOGN, n = e & (L - 1); const int pp = sub * NB + f;
              zz[k] = make_float2(convw(0, ra[k]), convw(0, rb[k]));
              scrZ[(size_t)pp * L + n] = zz[k];
            }
          } else {
#pragma unroll
            for (int k = 0; k < BT; ++k) {
              const int e = tid + NTHR * (i0 + k); const int f = e >> LOGN, n = e & (L - 1); const int pp = sub * NB + f;
              zz[k] = scrZ[(size_t)pp * L + n];
            }
          }
#pragma unroll
          for (int k = 0; k < BT; ++k) {
            const int e = tid + NTHR * (i0 + k); const int n = e & (L - 1);
            float2 z = zz[k];
            if (par == 1) { const float rev = -(float)n / (float)(2 * L); z = cmul(z, make_float2(cos_rev(rev), sin_rev(rev))); }
            buf[PADI(e)] = z;
          }
        }
        __syncthreads();
        if (PROBE & 32) {
          fft_fwd<LOGN>(buf, NB * L); fft_inv<LOGN>(buf, NB * L);
          _Pragma("unroll 1") for (int i = 0; i < EPT; ++i) { const int e = tid + NTHR * i; float2 v = buf[PADI(e)]; buf[PADI(e)] = make_float2(v.x * (1.0f / L), v.y * (1.0f / L)); }
          __syncthreads();
        }
        fft_fwd<LOGN>(buf, NB * L);
#pragma unroll 1
        for (int i0 = 0; i0 < EPT; i0 += BT) {
          float2 ss[BT];
#pragma unroll
          for (int k = 0; k < BT; ++k) ss[k] = scrS[(tid + NTHR * (i0 + k)) & (L - 1)];
#pragma unroll
          for (int k = 0; k < BT; ++k) { const int e = tid + NTHR * (i0 + k); buf[PADI(e)] = cmul(buf[PADI(e)], ss[k]); }
        }
        __syncthreads();
        fft_inv<LOGN>(buf, NB * L);
        if (par == 0) {
#pragma unroll 8
          for (int i = 0; i < EPT; ++i) {
            const int e = tid + NTHR * i; const int f = e >> LOGN, n = e & (L - 1);
            scrY[(size_t)(sub * NB + f) * L + n] = buf[PADI(e)];
          }
        } else {
          const int gsel = (o == 0 ? 1 : 2);
#pragma unroll 1
          for (int i0 = 0; i0 < EPT; i0 += BT) {
            float2 ye[BT], zz[BT]; float ga[BT][3], gb[BT][3];
#pragma unroll
            for (int k = 0; k < BT; ++k) {
              const int e = tid + NTHR * (i0 + k); const int f = e >> LOGN, n = e & (L - 1); const int pp = sub * NB + f;
              ye[k] = scrY[(size_t)pp * L + n]; zz[k] = scrZ[(size_t)pp * L + n];
              loadu3(2 * pp, gsel * 512 + c, n, ga[k]); loadu3(2 * pp + 1, gsel * 512 + c, n, gb[k]);
            }
#pragma unroll
            for (int k = 0; k < BT; ++k) {
              const int e = tid + NTHR * (i0 + k); const int f = e >> LOGN, n = e & (L - 1); const int pp = sub * NB + f;
              float2 y = buf[PADI(e)];
              const float rev = -(float)n / (float)(2 * L);
              y = cmulc(y, make_float2(cos_rev(rev), sin_rev(rev)));
              const float sc = 0.5f / (float)L;
              const float c0 = (ye[k].x + y.x) * sc + sk * zz[k].x;
              const float c1 = (ye[k].y + y.y) * sc + sk * zz[k].y;
              const float z0 = convw(gsel, ga[k]) * c0;
              const float z1 = convw(gsel, gb[k]) * c1;
              if (o == 0) scrZ[(size_t)pp * L + n] = make_float2(z0, z1);
              else {
                OBt[chm_index(512, row_base + (2 * pp) * L, c) + n] = f2bf(z0);
                OBt[chm_index(512, row_base + (2 * pp + 1) * L, c) + n] = f2bf(z1);
              }
            }
          }
        }
        __syncthreads();
      }
    }
  }
}

struct WMat { const float* src; int K; int N; const float* gain; bf16_t* dst; };
DI WMat get_wmat(const Params& p, int id) {
  bf16_t* W = (bf16_t*)(p.ws + WS_W);
  WMat m;
  switch (id) {
    case 0: m = {p.in[9], 1024, 3072, p.in[5], W + W_INE}; break;
    case 1: m = {p.in[23], 1024, 1024, nullptr, W + W_OUTE}; break;
    case 2: m = {p.in[24], 1024, 2304, p.in[5] + 1024, W + W_INO}; break;
    case 3: m = {p.in[31], 1024, 1024, nullptr, W + W_OUTO}; break;
    case 4: m = {p.in[32], 1024, 256, p.in[6], W + W_Q}; break;
    case 5: m = {p.in[32] + 1024 * 256, 1024, 256, p.in[6] + 1024, W + W_Q + 256 * 1024}; break;
    case 6: m = {p.in[33], 1024, 512, p.in[7], W + W_KV}; break;
    case 7: m = {p.in[33] + 1024 * 512, 1024, 512, p.in[7] + 1024, W + W_KV + 512 * 1024}; break;
    case 8: m = {p.in[34], 256, 1024, nullptr, W + W_O}; break;
    case 9: m = {p.in[34] + 256 * 1024, 256, 1024, nullptr, W + W_O + 1024 * 256}; break;
    case 10: m = {p.in[37], 1024, 4096, p.in[8], W + W_1}; break;
    case 11: m = {p.in[37] + (size_t)1024 * 4096, 1024, 4096, p.in[8] + 1024, W + W_1 + (size_t)4096 * 1024}; break;
    case 12: m = {p.in[38], 4096, 1024, nullptr, W + W_2}; break;
    default: m = {p.in[38] + (size_t)4096 * 1024, 4096, 1024, nullptr, W + W_2 + (size_t)4096 * 1024}; break;
  }
  return m;
}

DI void prep_wtile(char* smem, const WMat& m, int tile) {
  float* t = (float*)smem;
  const int ntn = m.N >> 6;
  const int k0 = (tile / ntn) << 6, n0 = (tile % ntn) << 6;
  const int tid = threadIdx.x;
  __syncthreads();
  {
    const int kk = tid >> 4, n4 = (tid & 15) * 4;
#pragma unroll
    for (int i = 0; i < 2; ++i) {
      const int k = kk + 32 * i;
      float4 v = *(const float4*)(m.src + (size_t)(k0 + k) * m.N + n0 + n4);
      const float gk = m.gain ? m.gain[k0 + k] : 1.0f;
      t[k * 65 + n4] = v.x * gk; t[k * 65 + n4 + 1] = v.y * gk; t[k * 65 + n4 + 2] = v.z * gk; t[k * 65 + n4 + 3] = v.w * gk;
    }
  }
  __syncthreads();
  {
    const int n = tid >> 3, kc = tid & 7;
    uint4 u;
    u.x = pack2(t[(8 * kc) * 65 + n], t[(8 * kc + 1) * 65 + n]); u.y = pack2(t[(8 * kc + 2) * 65 + n], t[(8 * kc + 3) * 65 + n]);
    u.z = pack2(t[(8 * kc + 4) * 65 + n], t[(8 * kc + 5) * 65 + n]); u.w = pack2(t[(8 * kc + 6) * 65 + n], t[(8 * kc + 7) * 65 + n]);
    *(uint4*)(m.dst + (size_t)(n0 + n) * m.K + k0 + 8 * kc) = u;
  }
}

DI void prep_row(const float* src, bf16_t* dst, float* ssq) {
  const int lane = threadIdx.x & 63;
  float ss = 0.f;
#pragma unroll
  for (int i = 0; i < 4; ++i) {
    float4 v = *(const float4*)(src + (i * 64 + lane) * 4);
    ss += v.x * v.x + v.y * v.y + v.z * v.z + v.w * v.w;
    uint2 u; u.x = pack2(v.x, v.y); u.y = pack2(v.z, v.w);
    *(uint2*)(dst + (i * 64 + lane) * 4) = u;
  }
#pragma unroll
  for (int s = 32; s >= 1; s >>= 1) ss += __shfl_xor(ss, s);
  if (lane == 0) *ssq = ss;
}

DI void prep_h2(const Params& p, int L, int t, bf16_t* dst) {
  const int j = threadIdx.x & 63;
  const float* w1 = p.in[16]; const float* b1 = p.in[17]; const float* fr = p.in[18]; const float* w2 = p.in[19]; const float* b2 = p.in[20];
  const float t01 = (float)t / (float)(L - 1);
  const float tl = (float)t / (float)L;
  float a = t01 * w1[j] + b1[j];
#pragma unroll
  for (int k = 0; k < 8; ++k) {
    const float fk = 1e-4f + (float)k * ((7.0f - 1e-4f) / 7.0f);
    const float rev = tl * fk;
    a += cos_rev(rev) * w1[(1 + k) * 64 + j] - sin_rev(rev) * w1[(9 + k) * 64 + j];
  }
  const float h1 = sin_rev(fr[j] * a * 0.15915494309189535f);
  float a2 = b2[j];
  for (int i = 0; i < 64; ++i) a2 += __shfl(h1, i) * w2[i * 64 + j];
  dst[(size_t)j * L + t] = f2bf(sin_rev(fr[64 + j] * a2 * 0.15915494309189535f));
}

constexpr int PREP_NW = 768 + 256 + 576 + 256 + 64 + 64 + 128 + 128 + 64 + 64 + 1024 + 1024 + 1024 + 1024;
constexpr int PREP_T_ROWS = PREP_NW;
constexpr int PREP_T_MEM = PREP_T_ROWS + 8192;
constexpr int PREP_T_H2 = PREP_T_MEM + 576;
constexpr int PREP_T_MISC = PREP_T_H2 + 2304;
constexpr int PREP_TOTAL = PREP_T_MISC + 1;

DI void phase_prep(char* smem, const Params& p) {
  const int tid = threadIdx.x, wave = tid >> 6;
#pragma unroll 1
  for (int task = blockIdx.x; task < PREP_TOTAL; task += gridDim.x) {
    if (task < PREP_NW) {
      int t = task, id = 0;
      for (; id < 14; ++id) { WMat m = get_wmat(p, id); int n = (m.K >> 6) * (m.N >> 6); if (t < n) break; t -= n; }
      WMat m = get_wmat(p, id);
      prep_wtile(smem, m, t);
    } else if (task < PREP_T_MEM) {
      const int row = (task - PREP_T_ROWS) * 8 + wave;
      const float* src = (row < T_P) ? p.in[0] + (size_t)row * DM : p.in[1] + (size_t)(row - T_P) * DM;
      float* RS = (float*)(p.ws + WS_MISC + MS_RS);
      prep_row(src, (bf16_t*)(p.ws + WS_XB) + (size_t)row * DM, RS + row);
      if ((tid & 63) < 5) RS[(size_t)(1 + (tid & 63)) * T_ALL + row] = 0.f;
    } else if (task < PREP_T_H2) {
      const int row = (task - PREP_T_MEM) * 8 + wave;
      const float* src = (row < 512) ? p.in[2] + (size_t)row * DM : p.in[3] + (size_t)(row - 512) * DM;
      prep_row(src, (bf16_t*)(p.ws + WS_R1) + (size_t)row * DM, (float*)(p.ws + WS_MISC + MS_RSM) + row);
    } else if (task < PREP_T_MISC) {
      const int t = (task - PREP_T_H2) * 8 + wave;
      if (t < LP) prep_h2(p, LP, t, (bf16_t*)(p.ws + WS_MISC + MS_H2P));
      else prep_h2(p, LS, t - LP, (bf16_t*)(p.ws + WS_MISC + MS_H2S));
    } else {
      float* lut = (float*)(p.ws + WS_MISC + MS_LUT);
      for (int i = tid; i < 8 * 257; i += NTHR) {
        const int hh = i / 257, rel = (i % 257) - 128;
        const int n = rel < 0 ? -rel : rel;
        int bkt;
        if (n < 8) bkt = n; else { bkt = 2 + (31 - __clz(n * n)); if (bkt > 15) bkt = 15; }
        if (rel > 0) bkt += 16;
        lut[i] = p.in[4][bkt * 8 + hh] * LOG2E;
      }
      if (tid < 64) {
        const float* lf = p.in[12];
        float a = lf[tid] * lf[64 + tid], b = lf[128 + tid] * lf[192 + tid];
#pragma unroll
        for (int s = 32; s >= 1; s >>= 1) { a += __shfl_xor(a, s); b += __shfl_xor(b, s); }
        if (tid == 0) *(float*)(p.ws + WS_MISC + MS_LAM) = expf(a) - expf(b) + 0.2f;
      }
    }
  }
}

DI Seg seg_inproj(const Params& p, int layer, int col0, const float* rs) {
  Seg s{}; s.rs = rs; s.scale = 1.0f;
  if (layer == 0) {
    if (col0 < 512) { s.type = SEG_NORM; s.dst = (bf16_t*)(p.ws + WS_R0); s.ld = 512; s.col = col0; s.gain = p.in[10]; s.scale = QSCALE; }
    else if (col0 < 1024) { s.type = SEG_NORM; s.dst = (bf16_t*)((char*)p.out + 192 * MiB); s.ld = 512; s.col = col0 - 512; s.gain = p.in[11]; }
    else if (col0 < 1536) { s.type = SEG_CHM; s.dst = (bf16_t*)(p.ws + WS_R2); s.CH = 512; s.col = col0 - 1024; }
    else { s.type = SEG_CHM; s.dst = (bf16_t*)p.out; s.CH = 1536; s.col = col0 - 1536; }
  } else {
    if (col0 < 512) { s.type = SEG_NORM; s.dst = (bf16_t*)(p.ws + WS_R0); s.ld = 512; s.col = col0; s.gain = p.in[25]; s.scale = QSCALE; }
    else if (col0 < 1024) { s.type = SEG_NORM; s.dst = (bf16_t*)(p.ws + WS_R1); s.ld = 512; s.col = col0 - 512; s.gain = p.in[26]; }
    else if (col0 < 1536) { s.type = SEG_CHM; s.dst = (bf16_t*)(p.ws + WS_R2); s.CH = 512; s.col = col0 - 1024; }
    else if (col0 < 2048) { s.type = SEG_NORM; s.dst = (bf16_t*)(p.ws + WS_R3); s.ld = 512; s.col = col0 - 1536; s.gain = p.in[28]; s.scale = QSCALE; }
    else if (col0 < 2176) { s.type = SEG_NORM; s.dst = (bf16_t*)(p.ws + WS_KD); s.ld = 128; s.col = col0 - 2048; s.gain = p.in[29]; }
    else { s.type = SEG_CHM; s.dst = (bf16_t*)(p.ws + WS_VDT); s.CH = 128; s.col = col0 - 2176; }
  }
  return s;
}

struct SchedInproj { int xcd, jx, per, rows_per, nt_lo, nt_n;
  DI bool next(int i, SUnit& u) const { const int q = jx + i * per; if (q >= rows_per * nt_n) return false; u.m0 = (xcd * rows_per + q / nt_n) * 256; u.n0 = (nt_lo + q % nt_n) * 256; return true; } };
struct SchedOne { int m0, n0; bool valid;
  DI bool next(int i, SUnit& u) const { if (i > 0 || !valid) return false; u.m0 = m0; u.n0 = n0; return true; } };
struct SchedRow { int m0, n;
  DI bool next(int i, SUnit& u) const { if (i >= n) return false; u.m0 = m0; u.n0 = i * 256; return true; } };

DI void phase_inproj(char* smem, const Params& p, int layer) {
  const bf16_t* W = (const bf16_t*)(p.ws + WS_W);
  const int nxg = (gridDim.x >= 8 && (gridDim.x & 7) == 0) ? 8 : 1;
  {
    GemmArgs ga{(const bf16_t*)(p.ws + WS_XB), nullptr, 1 << 30, DM, W + (layer == 0 ? W_INE : W_INO), DM, DM};
    const int xc = blockIdx.x % nxg, jx = blockIdx.x / nxg, per = gridDim.x / nxg, rp = 256 / nxg;
    const float* rs = (const float*)(p.ws + WS_MISC + MS_RS) + (size_t)(layer * 3) * T_ALL;
    auto sf = [&](const SUnit& u, int wc) -> Seg { return seg_inproj(p, layer, u.n0 + 64 * wc, rs); };
    if (layer == 0) {
      gemm_stream<false>(ga, SchedInproj{xc, jx, per, rp, 0, 4}, sf);
      gemm_stream<true>(ga, SchedInproj{xc, jx, per, rp, 4, 8}, sf);
    } else {
      gemm_stream<false>(ga, SchedInproj{xc, jx, per, rp, 0, 4}, sf);
      gemm_stream<true>(ga, SchedInproj{xc, jx, per, rp, 4, 2}, sf);
      gemm_stream<false>(ga, SchedInproj{xc, jx, per, rp, 6, 3}, sf);
    }
  }
  if (layer == 0) {
    const int t2 = blockIdx.x; const int l = t2 / 36, r = t2 % 36;
    GemmArgs ga{(const bf16_t*)(p.ws + WS_R1), nullptr, 1 << 30, DM, W + W_KV + (size_t)(l & 1) * 512 * 1024, DM, DM};
    auto sfm = [&](const SUnit& u, int wc) -> Seg {
      Seg s{}; s.rs = (const float*)(p.ws + WS_MISC + MS_RSM); s.scale = 1.0f;
      const int col0 = u.n0 + 64 * wc;
      if (col0 < 256) { s.type = SEG_NORM; s.dst = (bf16_t*)(p.ws + WS_MISC + MS_MK) + (size_t)l * 18 * 256 * 256; s.ld = 256; s.col = col0; s.gain = p.in[36] + l * 64; }
      else { s.type = SEG_CHMEM; s.dst = (bf16_t*)(p.ws + WS_MISC + MS_MVT) + (size_t)l * 18 * 256 * 256; s.col = col0 - 256; }
      return s; };
    gemm_stream<false>(ga, SchedOne{(r >> 1) * 256, 0, t2 < 72 && (r & 1) == 0}, sfm);
    gemm_stream<true>(ga, SchedOne{(r >> 1) * 256, 256, t2 < 72 && (r & 1) == 1}, sfm);
  }
  (void)smem;
}

DI void phase_mixer0(char* smem, const Params& p) {
#pragma unroll 1
  for (int item = blockIdx.x; item < 2048; item += gridDim.x) {
    const int kind = item >> 9, idx = item & 511;
#ifndef SUBP
#define SUBP -1
#endif
    if (kind == 0 || kind == 2) {
      if (PROBE & 4) diff_item(smem, p, (kind == 2 ? 512 : 0) + idx, true);
      diff_item(smem, p, (kind == 2 ? 512 : 0) + idx);
    } else if (kind == 1) {
      if (PROBE & 8) hyena_item<14, 1, 1>(smem, p, idx, 0);
      hyena_item<14, 1, 1>(smem, p, idx, 0);
    } else {
      if (PROBE & 8) hyena_item<11, 4, 2>(smem, p, idx, T_P);
      hyena_item<11, 4, 2>(smem, p, idx, T_P);
    }
  }
}
DI void phase_mixer1(char* smem, const Params& p) {
#pragma unroll 1
  for (int item = blockIdx.x; item < 4096; item += gridDim.x) {
    if (PROBE & 16) { if (item < 2048) na_item(smem, p, item, true); else wg_item(smem, p, item - 2048, true); }
    if (item < 2048) na_item(smem, p, item); else wg_item(smem, p, item - 2048);
  }
}

DI void phase_post(char* smem, const Params& p, int layer, int part) {
  const bf16_t* W = (const bf16_t*)(p.ws + WS_W);
  float* RS = (float*)(p.ws + WS_MISC + MS_RS);
  bf16_t* XB = (bf16_t*)(p.ws + WS_XB);
  bf16_t* H0 = (bf16_t*)(p.ws + 195 * MiB);
  bf16_t* H1 = (bf16_t*)(p.ws + 323 * MiB);
  bf16_t* QM = (bf16_t*)(p.ws + WS_QM);
  const int wn = (threadIdx.x >> 6) & 1;
#pragma unroll 1
  for (int mt = blockIdx.x; mt < 256; mt += gridDim.x) {
    const int m0 = mt * 256;
    if (layer == 0 && part == 0) {
      const bf16_t* OBt = (const bf16_t*)(p.ws + WS_R3);
      bf16_t* OB = (bf16_t*)(p.ws + WS_R1);
      const int tid = threadIdx.x;
#pragma unroll 1
      for (int chunk = 0; chunk < 4; ++chunk) {
        __syncthreads();
        {
          const int c = tid >> 2, part = tid & 3;
          const uint4* src = (const uint4*)(OBt + chm_index(512, m0, chunk * 128 + c) + part * 64);
#pragma unroll
          for (int i = 0; i < 8; ++i) *(uint4*)(smem + c * 528 + part * 128 + i * 16) = src[i];
        }
        __syncthreads();
#pragma unroll 2
        for (int it = 0; it < 8; ++it) {
          const int item = it * NTHR + tid; const int t = item & 255, c8 = item >> 8;
          unsigned short v[8];
#pragma unroll
          for (int j = 0; j < 8; ++j) v[j] = *(const unsigned short*)(smem + (c8 * 8 + j) * 528 + t * 2);
          uint4 u; u.x = v[0] | ((unsigned)v[1] << 16); u.y = v[2] | ((unsigned)v[3] << 16); u.z = v[4] | ((unsigned)v[5] << 16); u.w = v[6] | ((unsigned)v[7] << 16);
          *(uint4*)(OB + (size_t)(m0 + t) * 512 + chunk * 128 + c8 * 8) = u;
        }
      }
      __syncthreads();
    }
#ifndef CHAINP
#define CHAINP -1
#endif
    if (part == 0) {
      GemmArgs ga{(const bf16_t*)(p.ws + WS_R0), (const bf16_t*)(p.ws + (layer == 0 ? WS_R1 : WS_R3)), 512, 512, W + (layer == 0 ? W_OUTE : W_OUTO), DM, DM};
      Seg s{}; s.type = SEG_RESID; s.xin0 = layer == 0 ? p.in[0] : nullptr; s.xin1 = layer == 0 ? p.in[1] : nullptr;
      s.xout = p.out; s.xb = XB; s.rs_out = RS + (size_t)(layer * 3 + 1) * T_ALL;
      gemm_stream<false>(ga, SchedRow{m0, 4}, [&](const SUnit& u, int wc) -> Seg { Seg t = s; t.col = u.n0 + 64 * wc; return t; });
    }
    if (part == 0) continue;
    if (CHAINP < 0 || CHAINP == 2) {
      GemmArgs ga{XB, nullptr, 1 << 30, DM, W + W_Q + (size_t)layer * 256 * 1024, DM, DM};
      Seg s{}; s.type = SEG_NORM; s.rs = RS + (size_t)(layer * 3 + 1) * T_ALL; s.dst = QM; s.ld = 256; s.gain = p.in[35] + layer * 64; s.scale = QSCALE;
      gemm_stream<false>(ga, SchedRow{m0, 1}, [&](const SUnit& u, int wc) -> Seg { Seg t = s; t.col = u.n0 + 64 * wc; return t; });
    }
    block_sync_global();
    if (CHAINP < 0 || CHAINP == 3) mem_attn_tile(smem, p, layer, m0);
    block_sync_global();
    if (CHAINP < 0 || CHAINP == 4) {
      GemmArgs ga{QM, nullptr, 1 << 30, 256, W + W_O + (size_t)layer * 1024 * 256, 256, 256};
      Seg s{}; s.type = SEG_RESID; s.xout = p.out; s.xb = XB; s.rs_out = RS + (size_t)(layer * 3 + 2) * T_ALL;
      gemm_stream<false>(ga, SchedRow{m0, 4}, [&](const SUnit& u, int wc) -> Seg { Seg t = s; t.col = u.n0 + 64 * wc; return t; });
    }
    block_sync_global();
    _Pragma("unroll 1") for (int hc = 0; hc < 2; ++hc) {
      {
        GemmArgs ga{XB, nullptr, 1 << 30, DM, W + W_1 + (size_t)layer * 4096 * 1024 + (size_t)hc * 2048 * 1024, DM, DM};
        Seg s{}; s.type = SEG_MLP1; s.rs = RS + (size_t)(layer * 3 + 2) * T_ALL; s.ld = 1024;
        gemm_stream<false>(ga, SchedRow{m0, 8}, [&](const SUnit& u, int wc) -> Seg { Seg t = s; t.dst = (u.n0 < 1024) ? H0 : H1; t.col = (u.n0 & 1023) + 64 * wc; return t; });
      }
      block_sync_global();
      {
        GemmArgs ga{H0, H1, 1024, 1024, W + W_2 + (size_t)layer * 4096 * 1024 + (size_t)hc * 2048, 4096, 2048};
        Seg s{}; s.type = SEG_RESID; s.xout = p.out;
        if (hc == 1 && layer == 0) { s.xb = XB; s.rs_out = RS + (size_t)3 * T_ALL; }
        gemm_stream<false>(ga, SchedRow{m0, 4}, [&](const SUnit& u, int wc) -> Seg { Seg t = s; t.col = u.n0 + 64 * wc; return t; });
      }
      block_sync_global();
    }
  }
  (void)wn;
}

__global__ void __launch_bounds__(NTHR) fwd_kernel(Params p, int ph_lo, int ph_hi) {
  extern __shared__ __attribute__((aligned(16))) char smem[];
#define RUN_PHASE(i_, call_) if (ph_lo <= (i_) && (i_) <= ph_hi) { if ((i_) > ph_lo) { cg::this_grid().sync(); } call_; }
  RUN_PHASE(0, phase_prep(smem, p))
  if (PROBE & 1) { __syncthreads(); phase_prep(smem, p); }
  RUN_PHASE(1, phase_inproj(smem, p, 0))
  if (PROBE & 2) { __syncthreads(); phase_inproj(smem, p, 0); }
  RUN_PHASE(2, phase_mixer0(smem, p))
  RUN_PHASE(3, phase_post(smem, p, 0, 0))
  RUN_PHASE(4, phase_post(smem, p, 0, 1))
  RUN_PHASE(5, phase_inproj(smem, p, 1))
  if (PROBE & 2) { __syncthreads(); phase_inproj(smem, p, 1); }
  RUN_PHASE(6, phase_mixer1(smem, p))
  RUN_PHASE(7, phase_post(smem, p, 1, 0))
  RUN_PHASE(8, phase_post(smem, p, 1, 1))
}

#ifndef ONE_LAUNCH
#define ONE_LAUNCH 1
#endif

extern "C" void kernel_launch(void* const* d_in, const int* in_sizes, int n_in, void* d_out, int out_size, void* d_ws, size_t ws_size,
                              hipStream_t stream) {
  static int grid = 0;
  if (grid == 0) {
    if (n_in != 39 || ws_size < WS_NEED || out_size != T_ALL * DM) { fprintf(stderr, "kernel_launch: unexpected shapes n_in %d ws %zu out %d\n", n_in, ws_size, out_size); grid = -1; return; }
    if (hipFuncSetAttribute((const void*)fwd_kernel, hipFuncAttributeMaxDynamicSharedMemorySize, SMEM_BYTES) != hipSuccess) { fprintf(stderr, "hipFuncSetAttribute failed\n"); grid = -1; return; }
    int dev = 0, cus = 0, per_cu = 0;
    hipGetDevice(&dev);
    hipDeviceGetAttribute(&cus, hipDeviceAttributeMultiprocessorCount, dev);
    hipOccupancyMaxActiveBlocksPerMultiprocessor(&per_cu, (const void*)fwd_kernel, NTHR, SMEM_BYTES);
    if (per_cu < 1 || cus < 1) { fprintf(stderr, "occupancy query: %d blocks/CU, %d CUs\n", per_cu, cus); grid = -1; return; }
    grid = cus;
  }
  if (grid < 0) return;
  Params p{};
  for (int i = 0; i < 39; ++i) p.in[i] = (const float*)d_in[i];
  p.out = (float*)d_out; p.ws = (char*)d_ws;
#if ONE_LAUNCH
  int lo = 0, hi = 8;
  void* args[] = {&p, &lo, &hi};
  hipError_t e = hipLaunchCooperativeKernel((const void*)fwd_kernel, dim3(grid), dim3(NTHR), args, SMEM_BYTES, stream);
  if (e != hipSuccess) fprintf(stderr, "cooperative launch failed: %s\n", hipGetErrorString(e));
#else
  for (int ph = 0; ph <= 8; ++ph) hipLaunchKernelGGL(fwd_kernel, dim3(grid), dim3(NTHR), SMEM_BYTES, stream, p, ph, ph);
#endif
}
```

```cpp
#include <hip/hip_runtime.h>
#include <hip/hip_cooperative_groups.h>
#include <cstdio>
namespace cg = cooperative_groups;

#define DI __device__ __forceinline__
#define PROBE 0
typedef unsigned short bf16_t;
using bf16x8 = __attribute__((ext_vector_type(8))) short;
using s16x4 = __attribute__((ext_vector_type(4))) short;
using f32x4 = __attribute__((ext_vector_type(4))) float;
#define MFMA16(a, b, c) __builtin_amdgcn_mfma_f32_16x16x32_bf16((a), (b), (c), 0, 0, 0)

constexpr int NTHR = 512;
constexpr int T_ALL = 65536;
constexpr int T_P = 32768;
constexpr int LP = 16384, LS = 2048;
constexpr int DM = 1024;
constexpr float EPS = 1e-6f;
constexpr float LOG2E = 1.4426950408889634f;
constexpr float QSCALE = 0.125f * 1.4426950408889634f;
constexpr int SMEM_BYTES = 144 * 1024;
constexpr size_t MiB = (size_t)1 << 20;

constexpr size_t WS_XB = 0;
constexpr size_t WS_W = 128 * MiB;
constexpr size_t W_INE = 0;
constexpr size_t W_OUTE = W_INE + (size_t)3072 * 1024;
constexpr size_t W_INO = W_OUTE + (size_t)1024 * 1024;
constexpr size_t W_OUTO = W_INO + (size_t)2304 * 1024;
constexpr size_t W_Q = W_OUTO + (size_t)1024 * 1024;
constexpr size_t W_KV = W_Q + (size_t)2 * 256 * 1024;
constexpr size_t W_O = W_KV + (size_t)2 * 512 * 1024;
constexpr size_t W_1 = W_O + (size_t)2 * 1024 * 256;
constexpr size_t W_2 = W_1 + (size_t)2 * 4096 * 1024;
constexpr size_t W_END = W_2 + (size_t)2 * 4096 * 1024;
static_assert(W_END * 2 <= 51 * MiB, "weights");
constexpr size_t WS_MISC = 179 * MiB;
constexpr size_t MS_RS = 0;
constexpr size_t MS_RSM = MS_RS + (size_t)6 * T_ALL * 4;
constexpr size_t MS_MK = MS_RSM + 32768;
constexpr size_t MS_MVT = MS_MK + (size_t)2 * 18 * 256 * 256 * 2;
constexpr size_t MS_H2P = MS_MVT + (size_t)2 * 18 * 256 * 256 * 2;
constexpr size_t MS_H2S = MS_H2P + (size_t)LP * 64 * 4;
constexpr size_t MS_LUT = MS_H2S + (size_t)LS * 64 * 4;
constexpr size_t MS_LAM = MS_LUT + 16384;
constexpr size_t MS_END = MS_LAM + 256;
static_assert(MS_END <= 16 * MiB, "misc");
constexpr size_t WS_R0 = 195 * MiB;
constexpr size_t WS_R1 = 259 * MiB;
constexpr size_t WS_R2 = 323 * MiB;
constexpr size_t WS_R3 = 387 * MiB;
constexpr size_t WS_KD = 451 * MiB;
constexpr size_t WS_VDT = 467 * MiB;
constexpr size_t WS_QM = 451 * MiB;
constexpr size_t WS_H_L0 = 323 * MiB;
constexpr size_t WS_H_L1 = 259 * MiB;
constexpr size_t WS_NEED = 512 * MiB;
constexpr size_t HY_SCR_PER_BLOCK = 512 * 1024;

struct Params {
  const float* in[39];
  float* out;
  char* ws;
};

DI unsigned short f2bf(float x) { unsigned u = __float_as_uint(x); u += 0x7fffu + ((u >> 16) & 1u); return (unsigned short)(u >> 16); }
typedef __bf16 bf16v2_t __attribute__((ext_vector_type(2)));
typedef float f32v2_t __attribute__((ext_vector_type(2)));
DI unsigned pack2(float a, float b) { f32v2_t f = {a, b}; bf16v2_t h = __builtin_convertvector(f, bf16v2_t); return __builtin_bit_cast(unsigned, h); }
DI float bf2f(unsigned short h) { return __uint_as_float(((unsigned)h) << 16); }
DI float ex2(float x) { return __builtin_amdgcn_exp2f(x); }
DI float sin_rev(float r) { return __builtin_amdgcn_sinf(r); }
DI float cos_rev(float r) { return __builtin_amdgcn_cosf(r); }
DI int opaque(int x) { asm volatile("" : "+v"(x)); return x; }
DI float dpp_f(float v, int ctrl_sel) {
  int x = __float_as_int(v), r;
  if (ctrl_sel == 0) r = __builtin_amdgcn_update_dpp(x, x, 0xB1, 0xF, 0xF, false);
  else if (ctrl_sel == 1) r = __builtin_amdgcn_update_dpp(x, x, 0x4E, 0xF, 0xF, false);
  else if (ctrl_sel == 2) r = __builtin_amdgcn_update_dpp(x, x, 0x141, 0xF, 0xF, false);
  else r = __builtin_amdgcn_update_dpp(x, x, 0x140, 0xF, 0xF, false);
  return __int_as_float(r);
}
DI float row16_sum(float v) { v += dpp_f(v, 0); v += dpp_f(v, 1); v += dpp_f(v, 2); v += dpp_f(v, 3); return v; }
DI void block_sync_global() { __syncthreads(); }

DI size_t chm_index(int CH, int row, int ch) {
  if (row < T_P) { int b = row >> 14, t = row & (LP - 1); return ((size_t)(b * CH + ch) << 14) + t; }
  int r = row - T_P; int b = r >> 11, t = r & (LS - 1);
  return (size_t)T_P * CH + ((size_t)(b * CH + ch) << 11) + t;
}

struct GemmArgs {
  const bf16_t* A0; const bf16_t* A1; int ksplit; int lda;
  const bf16_t* Wt; int ldw; int K;
};
enum { SEG_NORM = 0, SEG_CHM = 1, SEG_CHMEM = 2, SEG_RESID = 3, SEG_MLP1 = 4 };
struct Seg {
  int type;
  bf16_t* dst; int ld; int col;
  const float* gain; float scale;
  int CH;
  const float* rs;
  const float* xin0; const float* xin1; float* xout; bf16_t* xb; float* rs_out;
};
constexpr int G_TILE_B = 256 * 64 * 2, G_STAGE_B = 2 * G_TILE_B;
DI int g_lds_byte(int r, int c) { int st = (r >> 4) * 2 + (c >> 5), ob = (r & 15) * 64 + (c & 31) * 2; return st * 1024 + (ob ^ (((ob >> 9) & 1) << 5)); }
DI void g_stage_rc(int b, int& R, int& C) { int st = b >> 10, sb = b & 1023, swz = sb ^ (((sb >> 9) & 1) << 5); R = (st >> 1) * 16 + swz / 64; C = (st & 1) * 32 + (swz % 64) / 2; }
#define WAIT_V0() asm volatile("s_waitcnt vmcnt(0)" ::: "memory")

DI void gemm_tile(char* smem_generic, const GemmArgs& ga, int m0, int n0, const Seg& sg) {
  extern __shared__ __attribute__((aligned(16))) char shm[];
  (void)smem_generic;
  const int tid = opaque((int)threadIdx.x), lane = tid & 63, wid = tid >> 6;
  const int l16 = lane & 15, g = lane >> 4;
  const int wr = wid >> 2, wc = wid & 3;
  int sR[4], sC[4];
#pragma unroll
  for (int i = 0; i < 4; ++i) g_stage_rc(wid * 1024 + i * 8192 + lane * 16, sR[i], sC[i]);
  const int KT = ga.K >> 6;
#define G_STAGE(buf_, kt_) do { const int k0_ = (kt_) << 6; \
    const bf16_t* Ab_ = (k0_ < ga.ksplit) ? ga.A0 + k0_ : ga.A1 + (k0_ - ga.ksplit); \
    _Pragma("unroll") for (int i = 0; i < 4; ++i) { \
      __builtin_amdgcn_global_load_lds((const unsigned*)(Ab_ + (size_t)(m0 + sR[i]) * ga.lda + sC[i]), (__attribute__((address_space(3))) unsigned*)(shm + (buf_) * G_STAGE_B + wid * 1024 + i * 8192), 16, 0, 0); \
      __builtin_amdgcn_global_load_lds((const unsigned*)(ga.Wt + (size_t)(n0 + sR[i]) * ga.ldw + k0_ + sC[i]), (__attribute__((address_space(3))) unsigned*)(shm + (buf_) * G_STAGE_B + G_TILE_B + wid * 1024 + i * 8192), 16, 0, 0); } } while (0)
  f32x4 acc[8][4];
#pragma unroll
  for (int i = 0; i < 8; ++i)
#pragma unroll
    for (int j = 0; j < 4; ++j) acc[i][j] = (f32x4){0.f, 0.f, 0.f, 0.f};
  float* rs_lds = (float*)(shm + 143360);
  G_STAGE(0, 0);
  if (sg.rs && tid < 256) rs_lds[tid] = rsqrtf(sg.rs[m0 + tid] * (1.0f / 1024.0f) + EPS);
  WAIT_V0(); __syncthreads();
#pragma unroll 1
  for (int t = 0; t < KT; ++t) {
    const int cur = t & 1;
    if (t + 1 < KT) G_STAGE(cur ^ 1, t + 1);
    const char* SAp = shm + cur * G_STAGE_B; const char* SBp = SAp + G_TILE_B;
#pragma unroll
    for (int ks = 0; ks < 2; ++ks) {
      bf16x8 At[8], Bf[4];
#pragma unroll
      for (int m = 0; m < 8; ++m) At[m] = *(const bf16x8*)(SAp + g_lds_byte(wr * 128 + m * 16 + l16, ks * 32 + g * 8));
#pragma unroll
      for (int n = 0; n < 4; ++n) Bf[n] = *(const bf16x8*)(SBp + g_lds_byte(wc * 64 + n * 16 + l16, ks * 32 + g * 8));
#pragma unroll
      for (int m = 0; m < 8; ++m)
#pragma unroll
        for (int n = 0; n < 4; ++n) acc[m][n] = MFMA16(At[m], Bf[n], acc[m][n]);
      __builtin_amdgcn_sched_barrier(0);
    }
    WAIT_V0(); __syncthreads();
  }
  const int rbase = m0 + 128 * wr + 4 * g;
  if (sg.rs) {
#pragma unroll
    for (int m = 0; m < 8; ++m)
#pragma unroll
      for (int r = 0; r < 4; ++r) {
        const float sc = rs_lds[128 * wr + 4 * g + 16 * m + r];
#pragma unroll
        for (int n = 0; n < 4; ++n) acc[m][n][r] *= sc;
      }
  }
  if (sg.type == SEG_NORM) {
    float gn[4];
#pragma unroll
    for (int n = 0; n < 4; ++n) gn[n] = sg.gain[16 * n + l16] * sg.scale;
#pragma unroll
    for (int m = 0; m < 8; ++m) {
#pragma unroll
      for (int r = 0; r < 4; ++r) {
        float ss = 0.f;
#pragma unroll
        for (int n = 0; n < 4; ++n) ss += acc[m][n][r] * acc[m][n][r];
        ss = row16_sum(ss);
        const float sc = rsqrtf(ss * (1.0f / 64.0f) + EPS);
        bf16_t* d = sg.dst + (size_t)(rbase + 16 * m + r) * sg.ld + sg.col + l16;
#pragma unroll
        for (int n = 0; n < 4; ++n) d[16 * n] = f2bf(acc[m][n][r] * sc * gn[n]);
      }
      __builtin_amdgcn_sched_barrier(0);
    }
  } else if (sg.type == SEG_CHM || sg.type == SEG_CHMEM) {
#pragma unroll
    for (int m = 0; m < 8; ++m) {
#pragma unroll
      for (int n = 0; n < 4; ++n) {
        const int row = rbase + 16 * m; const int ch = sg.col + l16 + 16 * n;
        size_t off;
        if (sg.type == SEG_CHM) off = chm_index(sg.CH, row, ch);
        else off = ((size_t)((row >> 8) * 256 + ch) << 8) + (row & 255);
        uint2 v; v.x = pack2(acc[m][n][0], acc[m][n][1]); v.y = pack2(acc[m][n][2], acc[m][n][3]);
        *(uint2*)(sg.dst + off) = v;
      }
      __builtin_amdgcn_sched_barrier(0);
    }
  } else {
    float* Cs = (float*)shm;
    const int rr = tid >> 5, c4 = (tid & 31) * 4;
#pragma unroll 1
    for (int half = 0; half < 2; ++half) {
      if ((wc >> 1) == half) {
#pragma unroll
        for (int m = 0; m < 8; ++m)
#pragma unroll
          for (int n = 0; n < 4; ++n)
#pragma unroll
            for (int r = 0; r < 4; ++r) Cs[(128 * wr + 16 * m + 4 * g + r) * 132 + 64 * (wc & 1) + 16 * n + l16] = acc[m][n][r];
      }
      __syncthreads();
      const int cg = sg.col + 128 * half + c4;
      if (sg.type == SEG_MLP1) {
#pragma unroll 4
        for (int it = 0; it < 16; ++it) {
          const int lr = it * 16 + rr; const int row = m0 + lr;
          f32x4 v = *(const f32x4*)(Cs + lr * 132 + c4);
          v[0] = fmaxf(v[0], 0.f); v[1] = fmaxf(v[1], 0.f); v[2] = fmaxf(v[2], 0.f); v[3] = fmaxf(v[3], 0.f);
          uint2 u; u.x = pack2(v[0] * v[0], v[1] * v[1]); u.y = pack2(v[2] * v[2], v[3] * v[3]);
          *(uint2*)(sg.dst + (size_t)row * sg.ld + cg) = u;
        }
      } else {
#pragma unroll 1
        for (int it0 = 0; it0 < 16; it0 += 8) {
          f32x4 xv[8];
#pragma unroll
          for (int k = 0; k < 8; ++k) {
            const int row = m0 + (it0 + k) * 16 + rr;
            const float* xo;
            if (sg.xin0) xo = (row < T_P) ? sg.xin0 + (size_t)row * DM : sg.xin1 + (size_t)(row - T_P) * DM;
            else xo = sg.xout + (size_t)row * DM;
            xv[k] = *(const f32x4*)(xo + cg);
          }
#pragma unroll
          for (int k = 0; k < 8; ++k) {
            const int lr = (it0 + k) * 16 + rr; const int row = m0 + lr;
            f32x4 v = *(const f32x4*)(Cs + lr * 132 + c4);
            v += xv[k];
            *(f32x4*)(sg.xout + (size_t)row * DM + cg) = v;
            if (sg.xb) { uint2 u; u.x = pack2(v[0], v[1]); u.y = pack2(v[2], v[3]); *(uint2*)(sg.xb + (size_t)row * DM + cg) = u; }
            if (sg.rs_out) {
              float ss = v[0] * v[0] + v[1] * v[1] + v[2] * v[2] + v[3] * v[3];
              ss = row16_sum(ss); ss += __shfl_xor(ss, 16);
              if ((tid & 31) == 0) atomicAdd(sg.rs_out + row, ss);
            }
          }
        }
      }
      __syncthreads();
    }
  }
}

#define LAS3 __attribute__((address_space(3)))
constexpr int S8_HTB = 128 * 64 * 2;
DI int s8_perm32(int rho) { const int n = rho >> 4, i = rho & 15; return 8 * (i >> 2) + 4 * n + (i & 3); }
struct SUnit { int m0, n0; };

template <bool NAT>
DI void s8_mma(f32x4 (&acc)[4][2], const bf16x8 (&At)[4][2], const bf16x8 (&Bt)[2][2]) {
  __builtin_amdgcn_s_setprio(1);
#pragma unroll
  for (int m = 0; m < 4; ++m)
#pragma unroll
    for (int n = 0; n < 2; ++n)
#pragma unroll
      for (int k = 0; k < 2; ++k) acc[m][n] = NAT ? MFMA16(At[m][k], Bt[n][k], acc[m][n]) : MFMA16(Bt[n][k], At[m][k], acc[m][n]);
  __builtin_amdgcn_s_setprio(0);
}

template <bool NAT>
DI void s8_epilogue(const f32x4 (&acc)[2][2][4][2], const Seg& sg, int m0, int wr, int fr, int fq) {
  if (!NAT && sg.type == SEG_NORM) {
    float gn[2][8];
#pragma unroll
    for (int bj = 0; bj < 2; ++bj)
#pragma unroll
      for (int k = 0; k < 8; ++k) gn[bj][k] = sg.gain[32 * bj + 8 * fq + k] * sg.scale;
#pragma unroll
    for (int ai = 0; ai < 2; ++ai)
#pragma unroll
      for (int m = 0; m < 4; ++m) {
        const int row = m0 + 128 * ai + 64 * wr + 16 * m + fr;
        float ss = 0.f;
#pragma unroll
        for (int bj = 0; bj < 2; ++bj)
#pragma unroll
          for (int n = 0; n < 2; ++n)
#pragma unroll
            for (int j = 0; j < 4; ++j) ss += acc[ai][bj][m][n][j] * acc[ai][bj][m][n][j];
        ss += __shfl_xor(ss, 16); ss += __shfl_xor(ss, 32);
        const float sc = rsqrtf(ss * (1.0f / 64.0f) + EPS);
#pragma unroll
        for (int bj = 0; bj < 2; ++bj) {
          uint4 u;
          u.x = pack2(acc[ai][bj][m][0][0] * sc * gn[bj][0], acc[ai][bj][m][0][1] * sc * gn[bj][1]);
          u.y = pack2(acc[ai][bj][m][0][2] * sc * gn[bj][2], acc[ai][bj][m][0][3] * sc * gn[bj][3]);
          u.z = pack2(acc[ai][bj][m][1][0] * sc * gn[bj][4], acc[ai][bj][m][1][1] * sc * gn[bj][5]);
          u.w = pack2(acc[ai][bj][m][1][2] * sc * gn[bj][6], acc[ai][bj][m][1][3] * sc * gn[bj][7]);
          *(uint4*)(sg.dst + (size_t)row * sg.ld + sg.col + 32 * bj + 8 * fq) = u;
        }
        __builtin_amdgcn_sched_barrier(0);
      }
  } else if (NAT) {
#pragma unroll
    for (int ai = 0; ai < 2; ++ai)
#pragma unroll
      for (int m = 0; m < 4; ++m) {
        const int row = m0 + 128 * ai + 64 * wr + 16 * m + 4 * fq;
        const f32x4 rv = *(const f32x4*)(sg.rs + row);
        f32x4 sc;
#pragma unroll
        for (int j = 0; j < 4; ++j) sc[j] = rsqrtf(rv[j] * (1.0f / 1024.0f) + EPS);
#pragma unroll
        for (int bj = 0; bj < 2; ++bj)
#pragma unroll
          for (int n = 0; n < 2; ++n) {
            const int ch = sg.col + 32 * bj + 8 * (fr >> 2) + 4 * n + (fr & 3);
            size_t off;
            if (sg.type == SEG_CHM) off = chm_index(sg.CH, row, ch);
            else off = ((size_t)((row >> 8) * 256 + ch) << 8) + (row & 255);
            const f32x4 v = acc[ai][bj][m][n] * sc;
            uint2 u; u.x = pack2(v[0], v[1]); u.y = pack2(v[2], v[3]);
            *(uint2*)(sg.dst + off) = u;
          }
        __builtin_amdgcn_sched_barrier(0);
      }
  } else if (sg.type == SEG_CHM) {
#pragma unroll
    for (int ai = 0; ai < 2; ++ai)
#pragma unroll
      for (int m = 0; m < 4; ++m) {
        const int row = m0 + 128 * ai + 64 * wr + 16 * m + fr;
        const float sc = rsqrtf(sg.rs[row] * (1.0f / 1024.0f) + EPS);
#pragma unroll
        for (int bj = 0; bj < 2; ++bj)
#pragma unroll
          for (int n = 0; n < 2; ++n)
#pragma unroll
            for (int j = 0; j < 4; ++j) sg.dst[chm_index(sg.CH, row, sg.col + 32 * bj + 8 * fq + 4 * n + j)] = f2bf(acc[ai][bj][m][n][j] * sc);
        __builtin_amdgcn_sched_barrier(0);
      }
  } else if (sg.type == SEG_MLP1) {
#pragma unroll
    for (int ai = 0; ai < 2; ++ai) {
      float sc[4];
#pragma unroll
      for (int m = 0; m < 4; ++m) sc[m] = rsqrtf(sg.rs[m0 + 128 * ai + 64 * wr + 16 * m + fr] * (1.0f / 1024.0f) + EPS);
#pragma unroll
      for (int m = 0; m < 4; ++m) {
        const int row = m0 + 128 * ai + 64 * wr + 16 * m + fr;
#pragma unroll
        for (int bj = 0; bj < 2; ++bj) {
          f32x4 a = acc[ai][bj][m][0] * sc[m], b = acc[ai][bj][m][1] * sc[m];
#pragma unroll
          for (int j = 0; j < 4; ++j) { a[j] = fmaxf(a[j], 0.f); a[j] *= a[j]; b[j] = fmaxf(b[j], 0.f); b[j] *= b[j]; }
          uint4 u; u.x = pack2(a[0], a[1]); u.y = pack2(a[2], a[3]); u.z = pack2(b[0], b[1]); u.w = pack2(b[2], b[3]);
          *(uint4*)(sg.dst + (size_t)row * sg.ld + sg.col + 32 * bj + 8 * fq) = u;
        }
        __builtin_amdgcn_sched_barrier(0);
      }
    }
  } else {
#pragma unroll
    for (int ai = 0; ai < 2; ++ai)
#pragma unroll
      for (int mp = 0; mp < 2; ++mp) {
        f32x4 xv[2][2][2];
#pragma unroll
        for (int mm = 0; mm < 2; ++mm) {
          const int row = m0 + 128 * ai + 64 * wr + 16 * (2 * mp + mm) + fr;
          const float* xo;
          if (sg.xin0) xo = (row < T_P) ? sg.xin0 + (size_t)row * DM : sg.xin1 + (size_t)(row - T_P) * DM;
          else xo = sg.xout + (size_t)row * DM;
#pragma unroll
          for (int bj = 0; bj < 2; ++bj) { xv[mm][bj][0] = *(const f32x4*)(xo + sg.col + 32 * bj + 8 * fq); xv[mm][bj][1] = *(const f32x4*)(xo + sg.col + 32 * bj + 8 * fq + 4); }
        }
#pragma unroll
        for (int mm = 0; mm < 2; ++mm) {
          const int m = 2 * mp + mm;
          const int row = m0 + 128 * ai + 64 * wr + 16 * m + fr;
          float ss = 0.f;
#pragma unroll
          for (int bj = 0; bj < 2; ++bj) {
            const f32x4 a = acc[ai][bj][m][0] + xv[mm][bj][0], b = acc[ai][bj][m][1] + xv[mm][bj][1];
            float* op = sg.xout + (size_t)row * DM + sg.col + 32 * bj + 8 * fq;
            *(f32x4*)op = a; *(f32x4*)(op + 4) = b;
            if (sg.xb) { uint4 u; u.x = pack2(a[0], a[1]); u.y = pack2(a[2], a[3]); u.z = pack2(b[0], b[1]); u.w = pack2(b[2], b[3]); *(uint4*)(sg.xb + (size_t)row * DM + sg.col + 32 * bj + 8 * fq) = u; }
#pragma unroll
            for (int j = 0; j < 4; ++j) ss += a[j] * a[j] + b[j] * b[j];
          }
          if (sg.rs_out) {
            ss += __shfl_xor(ss, 16); ss += __shfl_xor(ss, 32);
            if (fq == 0) atomicAdd(sg.rs_out + row, ss);
          }
          __builtin_amdgcn_sched_barrier(0);
        }
        __builtin_amdgcn_sched_barrier(0);
      }
  }
}

template <bool NAT, class Sched, class SegFn>
DI void gemm_stream(const GemmArgs& ga, const Sched& S, const SegFn& segfn) {
  extern __shared__ __attribute__((aligned(16))) char shm[];
  LAS3 unsigned char* lds = (LAS3 unsigned char*)shm;
  const int tid = opaque((int)threadIdx.x), wid = __builtin_amdgcn_readfirstlane(tid >> 6), lane = tid & 63, wr = wid >> 2, wc = wid & 3, fr = lane & 15, fq = lane >> 4;
  const int nt = ga.K >> 6, kst = ga.ksplit >> 6;
  unsigned voffA[2], voffB[2];
#pragma unroll
  for (int i = 0; i < 2; ++i) {
    int R, C; g_stage_rc(tid * 16 + i * 8192, R, C);
    const int Rb = ((R & ~31) << 1) + s8_perm32(R & 31);
    voffA[i] = (unsigned)(R * ga.lda + C) * 2u; voffB[i] = (unsigned)(Rb * ga.ldw + C) * 2u;
  }
  const size_t hstepA = (size_t)128 * ga.lda * 2, hstepB = (size_t)32 * ga.ldw * 2;
  const unsigned ldsw = (unsigned)wid * 1024u;
  const int aoff = g_lds_byte(wr * 64 + fr, fq * 8), boff = g_lds_byte(wc * 32 + fr, fq * 8);
#define S8_SA(b, h) (((b) * 2 + (h)) * S8_HTB)
#define S8_SB(b, h) ((4 + (b) * 2 + (h)) * S8_HTB)
#define S8_STAGE(bufoff, gbase, voff) do { _Pragma("unroll") for (int _i = 0; _i < 2; ++_i) \
    __builtin_amdgcn_global_load_lds((const unsigned*)((const char*)(gbase) + (voff)[_i]), (LAS3 unsigned*)(lds + (bufoff) + ldsw + _i * 8192), 16, 0, 0); } while (0)
#define S8_LDA(dst, b, h) do { _Pragma("unroll") for (int m = 0; m < 4; ++m) _Pragma("unroll") for (int k = 0; k < 2; ++k) dst[m][k] = *(const LAS3 bf16x8*)(lds + S8_SA(b, h) + aoff + m * 2048 + k * 1024); } while (0)
#define S8_LDB(dst, b, h) do { _Pragma("unroll") for (int n = 0; n < 2; ++n) _Pragma("unroll") for (int k = 0; k < 2; ++k) dst[n][k] = *(const LAS3 bf16x8*)(lds + S8_SB(b, h) + boff + n * 2048 + k * 1024); } while (0)
#define S8_MMA(ai, bj, At, Bt) s8_mma<NAT>(acc[ai][bj], At, Bt)
#define S8_WAIT_V(n) asm volatile("s_waitcnt vmcnt(" #n ")" ::: "memory")
#define S8_WAIT_L(n) asm volatile("s_waitcnt lgkmcnt(" #n ")" ::: "memory")
#define S8_BAR __builtin_amdgcn_s_barrier()
#define S8_SCHED __builtin_amdgcn_sched_barrier(0)
  auto aptr = [&](const SUnit& u, int t) -> const char* {
    return (const char*)((t < kst ? ga.A0 + (size_t)t * 64 : ga.A1 + (size_t)(t - kst) * 64) + (size_t)u.m0 * ga.lda);
  };
  auto bptr = [&](const SUnit& u, int t) -> const char* { return (const char*)(ga.Wt + (size_t)u.n0 * ga.ldw + (size_t)t * 64); };
  SUnit cur, nxt; int ui = 0;
  if (!S.next(0, cur)) return;
  f32x4 acc[2][2][4][2];
#pragma unroll
  for (int a = 0; a < 2; ++a)
#pragma unroll
    for (int b = 0; b < 2; ++b)
#pragma unroll
      for (int m = 0; m < 4; ++m)
#pragma unroll
        for (int n = 0; n < 2; ++n) acc[a][b][m][n] = (f32x4){0.f, 0.f, 0.f, 0.f};
  bf16x8 At[4][2], B0[2][2], B1[2][2];
  Seg seg = segfn(cur, wc);
  { const char* cA = aptr(cur, 0); const char* cB = bptr(cur, 0); const char* cA1 = aptr(cur, 1); const char* cB1 = bptr(cur, 1);
    S8_STAGE(S8_SB(0, 0), cB, voffB); S8_STAGE(S8_SA(0, 0), cA, voffA); S8_STAGE(S8_SB(0, 1), cB + hstepB, voffB); S8_STAGE(S8_SA(0, 1), cA + hstepA, voffA);
    if (wr == 1) S8_BAR;
    S8_WAIT_V(4); S8_BAR;
    S8_STAGE(S8_SB(1, 0), cB1, voffB); S8_STAGE(S8_SA(1, 0), cA1, voffA); S8_STAGE(S8_SB(1, 1), cB1 + hstepB, voffB);
    S8_WAIT_V(6); S8_BAR; }
  for (;;) {
    const bool has_next = S.next(ui + 1, nxt);
    const SUnit nu = has_next ? nxt : cur;
#pragma unroll 1
    for (int t = 0; t < nt; t += 2) {
      const bool last = (t == nt - 2);
      const char* a1 = aptr(cur, t + 1);
      const char* a2 = last ? aptr(nu, 0) : aptr(cur, t + 2); const char* b2 = last ? bptr(nu, 0) : bptr(cur, t + 2);
      const char* a3 = last ? aptr(nu, 1) : aptr(cur, t + 3); const char* b3 = last ? bptr(nu, 1) : bptr(cur, t + 3);
      S8_LDB(B0, 0, 0); S8_SCHED; S8_LDA(At, 0, 0); S8_STAGE(S8_SA(1, 1), a1 + hstepA, voffA);
      S8_WAIT_L(8); S8_BAR; S8_WAIT_L(0); S8_MMA(0, 0, At, B0); S8_BAR; S8_SCHED;
      S8_LDB(B1, 0, 1); S8_STAGE(S8_SB(0, 0), b2, voffB);
      S8_BAR; S8_WAIT_L(0); S8_MMA(0, 1, At, B1); S8_BAR;
      S8_LDA(At, 0, 1); S8_STAGE(S8_SA(0, 0), a2, voffA);
      S8_BAR; S8_WAIT_L(0); S8_MMA(1, 0, At, B0); S8_BAR; S8_SCHED;
      S8_STAGE(S8_SB(0, 1), b2 + hstepB, voffB);
      S8_WAIT_V(6); S8_BAR; S8_MMA(1, 1, At, B1); S8_BAR;
      S8_LDB(B0, 1, 0); S8_SCHED; S8_LDA(At, 1, 0); S8_STAGE(S8_SA(0, 1), a2 + hstepA, voffA);
      S8_WAIT_L(8); S8_BAR; S8_WAIT_L(0); S8_MMA(0, 0, At, B0); S8_BAR; S8_SCHED;
      S8_LDB(B1, 1, 1); S8_STAGE(S8_SB(1, 0), b3, voffB);
      S8_BAR; S8_WAIT_L(0); S8_MMA(0, 1, At, B1); S8_BAR;
      S8_LDA(At, 1, 1); S8_STAGE(S8_SA(1, 0), a3, voffA);
      S8_BAR; S8_WAIT_L(0); S8_MMA(1, 0, At, B0); S8_BAR; S8_SCHED;
      S8_STAGE(S8_SB(1, 1), b3 + hstepB, voffB);
      S8_WAIT_V(6); S8_BAR; S8_MMA(1, 1, At, B1); S8_BAR;
    }
#ifndef S8_NOEPI
    { const int lane2 = opaque((int)__builtin_amdgcn_mbcnt_hi(~0u, __builtin_amdgcn_mbcnt_lo(~0u, 0u))); s8_epilogue<NAT>(acc, seg, cur.m0, wr, lane2 & 15, lane2 >> 4); }
#else
    if (seg.type == 77) *(f32x4*)(seg.xout + fr) = acc[0][0][0][0] + acc[1][1][3][1] + acc[0][1][2][0] + acc[1][0][1][1];
#endif
    if (!has_next) break;
#pragma unroll
    for (int a = 0; a < 2; ++a)
#pragma unroll
      for (int b = 0; b < 2; ++b)
#pragma unroll
        for (int m = 0; m < 4; ++m)
#pragma unroll
          for (int n = 0; n < 2; ++n) acc[a][b][m][n] = (f32x4){0.f, 0.f, 0.f, 0.f};
    cur = nxt; ++ui;
    seg = segfn(cur, wc);
  }
  S8_WAIT_V(0);
  if (wr == 0) S8_BAR;
  S8_BAR;
}

enum { AM_MEM = 0, AM_DIFF = 1, AM_WG = 2, AM_NA = 3 };
constexpr int ATT_LUT_OFS = 73728;
constexpr int ATT_O0_OFS = 77824;

template <int VD, int MODE>
DI void attn_core(char* smem, const bf16_t* Q, int ldq, const bf16_t* K, int ldk, const bf16_t* Vt, int ldv,
                  int qpos0, int kbeg, int kend, int nrows, float sink_l2, float (&O)[2][VD / 16][4]) {
  constexpr int NDB = VD / 16;
  constexpr int STAGE = 8192 + VD * 128;
  constexpr int NL = 1 + VD / 64;
  extern __shared__ __attribute__((aligned(16))) char shm[];
  const int tid = opaque((int)threadIdx.x), lane = tid & 63, wave = tid >> 6;
  const int l16 = lane & 15, g = lane >> 4;
  const float* lut = (const float*)(smem + ATT_LUT_OFS);
  bf16x8 qf[2][2];
#pragma unroll
  for (int qb = 0; qb < 2; ++qb)
#pragma unroll
    for (int kk = 0; kk < 2; ++kk) qf[qb][kk] = *(const bf16x8*)(Q + (size_t)(32 * wave + 16 * qb + l16) * ldq + 32 * kk + 8 * g);
  float m[2] = {-1e30f, -1e30f};
  f32x4 Oa[2][NDB], Ol[2];
#pragma unroll
  for (int qb = 0; qb < 2; ++qb) {
    Ol[qb] = (f32x4){0.f, 0.f, 0.f, 0.f};
#pragma unroll
    for (int db = 0; db < NDB; ++db) Oa[qb][db] = (f32x4){0.f, 0.f, 0.f, 0.f};
  }
  bf16x8 ones;
#pragma unroll
  for (int j = 0; j < 8; ++j) ones[j] = (short)0x3F80;
  const int wq0 = qpos0 + 32 * wave;
  const int srow = 8 * wave + (lane >> 3);
  const int schunk = (lane & 7) ^ (lane >> 3);
  const int schunkK = (lane & 7) ^ ((wave & 3) | ((((lane >> 3) >> 1) & 1) << 2));
#define ATT_ISSUE(k0_, st_) do { \
    __builtin_amdgcn_global_load_lds((const unsigned*)(K + (size_t)((k0_) + srow) * ldk + 8 * schunkK), (__attribute__((address_space(3))) unsigned*)(shm + (st_) * STAGE + wave * 1024), 16, 0, 0); \
    __builtin_amdgcn_global_load_lds((const unsigned*)(Vt + (size_t)(srow) * ldv + (k0_) + 8 * schunk), (__attribute__((address_space(3))) unsigned*)(shm + (st_) * STAGE + 8192 + wave * 1024), 16, 0, 0); \
    if (VD == 128) __builtin_amdgcn_global_load_lds((const unsigned*)(Vt + (size_t)(srow + 64) * ldv + (k0_) + 8 * schunk), (__attribute__((address_space(3))) unsigned*)(shm + (st_) * STAGE + 8192 + 8192 + wave * 1024), 16, 0, 0); } while (0)
  const int ntile = (kend - kbeg) >> 6;
  ATT_ISSUE(kbeg, 0);
  if (ntile > 1) { ATT_ISSUE(kbeg + 64, 1); asm volatile("s_waitcnt vmcnt(%0)" :: "n"(NL) : "memory"); }
  else asm volatile("s_waitcnt vmcnt(0)" ::: "memory");
  __builtin_amdgcn_s_barrier();
  int it = 0, st = 0;
  for (int k0 = kbeg; k0 < kend; k0 += 64, ++it) {
    { const int st2 = (st >= 1) ? st - 1 : 2; if (it + 2 < ntile) ATT_ISSUE(k0 + 128, st2); }
    const char* Ks = shm + st * STAGE; const char* Vs = Ks + 8192;
    bool active = true;
    if (MODE == AM_WG) active = !(k0 + 63 < wq0 - 128 || k0 > wq0 + 31 + 128);
    int na_rs = 0; const int qr = wq0 >> 6, kr = k0 >> 6;
    if (MODE == AM_NA) { na_rs = min(max(qr - 4, 0), nrows - 8); active = (kr >= na_rs && kr < na_rs + 8); }
    if (active) {
      float coff = 0.f;
      bool lut_tile = false;
      if (MODE == AM_DIFF) {
        if (k0 + 63 - wq0 <= -128) coff = lut[0];
        else if (k0 - (wq0 + 31) >= 128) coff = lut[256];
        else lut_tile = true;
      }
      float nsh[2];
#pragma unroll
      for (int qb = 0; qb < 2; ++qb) nsh[qb] = (m[qb] > -1e29f) ? (coff - m[qb]) : 0.f;
      f32x4 S[2][4];
#pragma unroll
      for (int kb = 0; kb < 4; ++kb) {
        const int krow = 32 * (kb >> 1) + 8 * (l16 >> 2) + 4 * (kb & 1) + (l16 & 3);
        const int kfz = ((krow >> 3) & 3) | (((krow >> 1) & 1) << 2);
        bf16x8 kf0 = *(const bf16x8*)(Ks + krow * 128 + ((g ^ kfz) << 4));
        bf16x8 kf1 = *(const bf16x8*)(Ks + krow * 128 + (((4 + g) ^ kfz) << 4));
#pragma unroll
        for (int qb = 0; qb < 2; ++qb) {
          f32x4 z = (f32x4){nsh[qb], nsh[qb], nsh[qb], nsh[qb]};
          z = MFMA16(kf0, qf[qb][0], z);
          S[qb][kb] = MFMA16(kf1, qf[qb][1], z);
        }
      }
#pragma unroll
      for (int qb = 0; qb < 2; ++qb) {
        const int q = wq0 + 16 * qb + l16;
        if ((MODE == AM_DIFF && lut_tile) || MODE == AM_WG) {
#pragma unroll
          for (int kb = 0; kb < 4; ++kb)
#pragma unroll
            for (int r = 0; r < 4; ++r) {
              const int rel = k0 + 32 * (kb >> 1) + 8 * g + 4 * (kb & 1) + r - q;
              const int rc = min(max(rel, -128), 128);
              float sv = S[qb][kb][r] + lut[rc + 128];
              if (MODE == AM_WG && (rel > 128 || rel < -128)) sv = -1e30f;
              S[qb][kb][r] = sv;
            }
        } else if (MODE == AM_NA) {
          const int qc = q & 63;
          const int cs = min(max(qc - 8, 0), 48);
          const int dr = kr - qr + 7;
#pragma unroll
          for (int kb = 0; kb < 4; ++kb)
#pragma unroll
            for (int r = 0; r < 4; ++r) {
              const int kc = 32 * (kb >> 1) + 8 * g + 4 * (kb & 1) + r;
              const bool ok = (kc >= cs) && (kc < cs + 16);
              const int dc = min(max(kc - qc + 15, 0), 30);
              float sv = S[qb][kb][r] + lut[dr * 31 + dc];
              S[qb][kb][r] = ok ? sv : -1e30f;
            }
        }
      }
      bool need = (m[0] <= -1e29f) || (m[1] <= -1e29f);
#pragma unroll
      for (int qb = 0; qb < 2; ++qb)
#pragma unroll
        for (int kb = 0; kb < 4; ++kb)
#pragma unroll
          for (int r = 0; r < 4; ++r) need = need || (S[qb][kb][r] > 8.0f);
      if (__any(need)) {
#pragma unroll
        for (int qb = 0; qb < 2; ++qb) {
          float v = -1e30f;
#pragma unroll
          for (int kb = 0; kb < 4; ++kb) v = fmaxf(v, fmaxf(fmaxf(S[qb][kb][0], S[qb][kb][1]), fmaxf(S[qb][kb][2], S[qb][kb][3])));
          v = fmaxf(v, __shfl_xor(v, 16)); v = fmaxf(v, __shfl_xor(v, 32));
          const bool lf = (m[qb] <= -1e29f);
          const float delta = lf ? v : fmaxf(v, 0.f);
          const float alpha = lf ? 0.f : ex2(-delta);
          m[qb] = lf ? (v + coff) : (m[qb] + delta);
          Ol[qb] *= alpha;
#pragma unroll
          for (int db = 0; db < NDB; ++db) Oa[qb][db] *= alpha;
#pragma unroll
          for (int kb = 0; kb < 4; ++kb)
#pragma unroll
            for (int r = 0; r < 4; ++r) S[qb][kb][r] -= delta;
        }
      }
#pragma unroll
      for (int qb = 0; qb < 2; ++qb)
#pragma unroll
        for (int kb = 0; kb < 4; ++kb)
#pragma unroll
          for (int r = 0; r < 4; ++r) S[qb][kb][r] = ex2(S[qb][kb][r]);
#pragma unroll
      for (int ks = 0; ks < 2; ++ks) {
        bf16x8 pf[2];
#pragma unroll
        for (int qb = 0; qb < 2; ++qb) {
          uint4 u;
          u.x = pack2(S[qb][2 * ks][0], S[qb][2 * ks][1]); u.y = pack2(S[qb][2 * ks][2], S[qb][2 * ks][3]);
          u.z = pack2(S[qb][2 * ks + 1][0], S[qb][2 * ks + 1][1]); u.w = pack2(S[qb][2 * ks + 1][2], S[qb][2 * ks + 1][3]);
          pf[qb] = __builtin_bit_cast(bf16x8, u);
          Ol[qb] = MFMA16(ones, pf[qb], Ol[qb]);
        }
#pragma unroll
        for (int db = 0; db < NDB; ++db) {
          const bf16x8 vf = *(const bf16x8*)(Vs + (16 * db + l16) * 128 + (((4 * ks + g) ^ (l16 & 7)) << 4));
#pragma unroll
          for (int qb = 0; qb < 2; ++qb) Oa[qb][db] = MFMA16(vf, pf[qb], Oa[qb][db]);
        }
      }
    }
    if (it + 2 < ntile) asm volatile("s_waitcnt vmcnt(%0)" :: "n"(NL) : "memory");
    else asm volatile("s_waitcnt vmcnt(0)" ::: "memory");
    asm volatile("s_waitcnt lgkmcnt(0)" ::: "memory");
    __builtin_amdgcn_s_barrier();
    st = (st == 2) ? 0 : st + 1;
  }
#pragma unroll
  for (int qb = 0; qb < 2; ++qb) {
    float lt = Ol[qb][0];
    if (MODE == AM_WG) lt += ex2(sink_l2 - m[qb]);
    const float inv = 1.0f / lt;
#pragma unroll
    for (int db = 0; db < NDB; ++db)
#pragma unroll
      for (int r = 0; r < 4; ++r) O[qb][db][r] = Oa[qb][db][r] * inv;
  }
}

template <int NDB>
DI void attn_store(bf16_t* dst, int ld, const float (&O)[2][NDB][4]) {
  const int lane = threadIdx.x & 63, wave = threadIdx.x >> 6, l16 = lane & 15, g = lane >> 4;
#pragma unroll
  for (int qb = 0; qb < 2; ++qb)
#pragma unroll
    for (int db = 0; db < NDB; ++db) {
      uint2 v; v.x = pack2(O[qb][db][0], O[qb][db][1]); v.y = pack2(O[qb][db][2], O[qb][db][3]);
      *(uint2*)(dst + (size_t)(32 * wave + 16 * qb + l16) * ld + 16 * db + 4 * g) = v;
    }
}

DI void seq_of_row(int row0, int& L, int& seq_row0, int& b_glob) {
  if (row0 < T_P) { L = LP; int b = row0 >> 14; seq_row0 = b << 14; b_glob = b; }
  else { L = LS; int b = (row0 - T_P) >> 11; seq_row0 = T_P + (b << 11); b_glob = 2 + b; }
}

DI void diff_item(char* smem, const Params& p, int item, bool dry = false) {
  bf16_t* QA = (bf16_t*)(p.ws + WS_R0);
  const bf16_t* KA = (const bf16_t*)((const char*)p.out + 192 * MiB);
  const bf16_t* VAt = (const bf16_t*)(p.ws + WS_R2);
  const float* misc_lut = (const float*)(p.ws + WS_MISC + MS_LUT);
  const float lam = *(const float*)(p.ws + WS_MISC + MS_LAM);
  int h, row0;
  if (item < 512) { h = item & 3; row0 = (item >> 2) * 256; }
  else { int i2 = item - 512; h = i2 & 3; row0 = T_P + (i2 >> 2) * 256; }
  int L, srow0, bg; seq_of_row(row0, L, srow0, bg);
  const int qpos0 = row0 - srow0;
  const bf16_t* Vt = VAt + chm_index(512, srow0, h * 128);
  float O[2][8][4];
  unsigned* o0s = (unsigned*)(smem + ATT_O0_OFS) + threadIdx.x;
  const int tid = threadIdx.x;
#pragma unroll 1
  for (int mp = 0; mp < 2; ++mp) {
    __syncthreads();
    for (int i = tid; i < 257; i += NTHR) ((float*)(smem + ATT_LUT_OFS))[i] = misc_lut[(h * 2 + mp) * 257 + i];
    __syncthreads();
    attn_core<128, AM_DIFF>(smem, QA + (size_t)row0 * 512 + h * 128 + mp * 64, 512, KA + (size_t)srow0 * 512 + h * 128 + mp * 64, 512,
                            Vt, L, qpos0, 0, L, 0, 0.f, O);
    if (mp == 0) {
#pragma unroll
      for (int qb = 0; qb < 2; ++qb)
#pragma unroll
        for (int db = 0; db < 8; ++db) { o0s[((qb * 8 + db) * 2) * NTHR] = pack2(O[qb][db][0], O[qb][db][1]); o0s[((qb * 8 + db) * 2 + 1) * NTHR] = pack2(O[qb][db][2], O[qb][db][3]); }
    }
  }
  const int tid2 = opaque((int)threadIdx.x);
  const int lane = tid2 & 63, l16 = lane & 15, g = lane >> 4;
  const float* sg = p.in[13];
#pragma unroll
  for (int qb = 0; qb < 2; ++qb) {
    float ss = 0.f;
#pragma unroll
    for (int db = 0; db < 8; ++db) {
      const unsigned w0 = o0s[((qb * 8 + db) * 2) * NTHR], w1 = o0s[((qb * 8 + db) * 2 + 1) * NTHR];
      float a0 = bf2f((unsigned short)(w0 & 0xffff)), a1 = bf2f((unsigned short)(w0 >> 16));
      float a2 = bf2f((unsigned short)(w1 & 0xffff)), a3 = bf2f((unsigned short)(w1 >> 16));
      O[qb][db][0] = a0 - lam * O[qb][db][0]; O[qb][db][1] = a1 - lam * O[qb][db][1];
      O[qb][db][2] = a2 - lam * O[qb][db][2]; O[qb][db][3] = a3 - lam * O[qb][db][3];
#pragma unroll
      for (int r = 0; r < 4; ++r) ss += O[qb][db][r] * O[qb][db][r];
    }
    ss += __shfl_xor(ss, 16); ss += __shfl_xor(ss, 32);
    const float sc = rsqrtf(ss * (1.0f / 128.0f) + EPS) * 0.8f;
#pragma unroll
    for (int db = 0; db < 8; ++db)
#pragma unroll
      for (int r = 0; r < 4; ++r) O[qb][db][r] *= sc * sg[16 * db + 4 * g + r];
  }
  if (dry) attn_store<8>((bf16_t*)(p.ws + 484 * MiB), 512, O); else attn_store<8>(QA + (size_t)row0 * 512 + h * 128, 512, O);
}

DI void wg_item(char* smem, const Params& p, int item, bool dry = false) {
  bf16_t* QD = (bf16_t*)(p.ws + WS_R3);
  const bf16_t* KD = (const bf16_t*)(p.ws + WS_KD);
  const bf16_t* VDt = (const bf16_t*)(p.ws + WS_VDT);
  const float* misc_lut = (const float*)(p.ws + WS_MISC + MS_LUT);
  const int hq = item & 7; const int row0 = (item >> 3) * 256;
  int L, srow0, bg; seq_of_row(row0, L, srow0, bg);
  const int qpos0 = row0 - srow0;
  const int kvh = hq >> 2;
  __syncthreads();
  for (int i = threadIdx.x; i < 257; i += NTHR) ((float*)(smem + ATT_LUT_OFS))[i] = misc_lut[hq * 257 + i];
  __syncthreads();
  float O[2][4][4];
  const int kbeg = max(0, qpos0 - 128), kend = min(L, qpos0 + 256 + 128);
  attn_core<64, AM_WG>(smem, QD + (size_t)row0 * 512 + hq * 64, 512, KD + (size_t)srow0 * 128 + kvh * 64, 128,
                       VDt + chm_index(128, srow0, kvh * 64), L, qpos0, kbeg, kend, 0, p.in[30][hq] * LOG2E, O);
  if (dry) attn_store<4>((bf16_t*)(p.ws + 484 * MiB), 512, O); else attn_store<4>(QD + (size_t)row0 * 512 + hq * 64, 512, O);
}

DI void na_item(char* smem, const Params& p, int item, bool dry = false) {
  bf16_t* QC = (bf16_t*)(p.ws + WS_R0);
  const bf16_t* KC = (const bf16_t*)(p.ws + WS_R1);
  const bf16_t* VCt = (const bf16_t*)(p.ws + WS_R2);
  const int h = item & 7; const int row0 = (item >> 3) * 256;
  int L, srow0, bg; seq_of_row(row0, L, srow0, bg);
  const int qpos0 = row0 - srow0;
  const int nrows = L >> 6;
  __syncthreads();
  for (int i = threadIdx.x; i < 465; i += NTHR) ((float*)(smem + ATT_LUT_OFS))[i] = p.in[27][h * 465 + i] * LOG2E;
  __syncthreads();
  const int qr0 = qpos0 >> 6;
  const int rs0 = min(max(qr0 - 4, 0), nrows - 8), rs3 = min(max(qr0 + 3 - 4, 0), nrows - 8);
  float O[2][4][4];
  attn_core<64, AM_NA>(smem, QC + (size_t)row0 * 512 + h * 64, 512, KC + (size_t)srow0 * 512 + h * 64, 512,
                       VCt + chm_index(512, srow0, h * 64), L, qpos0, rs0 * 64, (rs3 + 8) * 64, nrows, 0.f, O);
  if (dry) attn_store<4>((bf16_t*)(p.ws + 484 * MiB), 512, O); else attn_store<4>(QC + (size_t)row0 * 512 + h * 64, 512, O);
}

DI void mem_attn_tile(char* smem, const Params& p, int layer, int row0) {
  bf16_t* QM = (bf16_t*)(p.ws + WS_QM);
  const bf16_t* MK = (const bf16_t*)(p.ws + WS_MISC + MS_MK) + (size_t)layer * 18 * 256 * 256;
  const bf16_t* MVt = (const bf16_t*)(p.ws + WS_MISC + MS_MVT) + (size_t)layer * 18 * 256 * 256;
  int L, srow0, bg; seq_of_row(row0, L, srow0, bg);
#pragma unroll 1
  for (int h = 0; h < 4; ++h) {
    float O[2][4][4];
    attn_core<64, AM_MEM>(smem, QM + (size_t)row0 * 256 + h * 64, 256, MK + (size_t)bg * 256 * 256 + h * 64, 256,
                          MVt + ((size_t)(bg * 256 + h * 64) << 8), 256, 0, 0, 256, 0, 0.f, O);
    attn_store<4>(QM + (size_t)row0 * 256 + h * 64, 256, O);
  }
}

DI int PADI(int i) { return i + (i >> 5); }
DI float2 cmul(float2 a, float2 b) { return make_float2(a.x * b.x - a.y * b.y, a.x * b.y + a.y * b.x); }
DI float2 cmulc(float2 a, float2 b) { return make_float2(a.x * b.x + a.y * b.y, a.y * b.x - a.x * b.y); }
DI constexpr float C16(int m) { return m == 0 ? 1.f : m == 1 ? 0.92387953251128674f : m == 2 ? 0.70710678118654752f : m == 3 ? 0.38268343236508977f : m == 4 ? 0.f : m == 5 ? -0.38268343236508977f : m == 6 ? -0.70710678118654752f : -0.92387953251128674f; }
DI constexpr float S16(int m) { return m == 0 ? 0.f : m == 1 ? 0.38268343236508977f : m == 2 ? 0.70710678118654752f : m == 3 ? 0.92387953251128674f : m == 4 ? 1.f : m == 5 ? 0.92387953251128674f : m == 6 ? 0.70710678118654752f : 0.38268343236508977f; }

template <int LOGR, int LOGS, bool INV>
DI void fft_pass(float2* buf, int total) {
  constexpr int R = 1 << LOGR;
  constexpr int S = 1 << LOGS;
  const int tid0 = opaque((int)threadIdx.x);
#pragma unroll 1
  for (int u = tid0; u < (total >> LOGR); u += NTHR) {
    const int j = u & (S - 1);
    const int base = ((u >> LOGS) << (LOGS + LOGR)) + j;
    float2* bp = buf + PADI(base);
    float2 x[R];
#pragma unroll
    for (int k = 0; k < R; ++k) x[k] = bp[k * S + ((k * S) >> 5)];
    float2 pw[LOGR];
    {
      const float rev = -(float)j * (1.0f / (float)(R * S));
      pw[0] = make_float2(cos_rev(rev), sin_rev(rev));
#pragma unroll
      for (int i = 1; i < LOGR; ++i) pw[i] = cmul(pw[i - 1], pw[i - 1]);
    }
    if (!INV) {
#pragma unroll
      for (int i = 0; i < LOGR; ++i) {
        const int h = R >> (i + 1);
#pragma unroll
        for (int k = 0; k < R; ++k) {
          if ((k & h) == 0) {
            const int mm = (k & (h - 1)) * 8 / h;
            float2 a = x[k], b = x[k + h];
            x[k] = make_float2(a.x + b.x, a.y + b.y);
            float2 d = make_float2(a.x - b.x, a.y - b.y);
            if (mm != 0) d = cmul(d, make_float2(C16(mm), -S16(mm)));
            x[k + h] = cmul(d, pw[i]);
          }
        }
      }
    } else {
#pragma unroll
      for (int i = LOGR - 1; i >= 0; --i) {
        const int h = R >> (i + 1);
#pragma unroll
        for (int k = 0; k < R; ++k) {
          if ((k & h) == 0) {
            const int mm = (k & (h - 1)) * 8 / h;
            float2 a = x[k];
            float2 d = cmulc(x[k + h], pw[i]);
            if (mm != 0) d = cmulc(d, make_float2(C16(mm), -S16(mm)));
            x[k] = make_float2(a.x + d.x, a.y + d.y);
            x[k + h] = make_float2(a.x - d.x, a.y - d.y);
          }
        }
      }
    }
#pragma unroll
    for (int k = 0; k < R; ++k) bp[k * S + ((k * S) >> 5)] = x[k];
  }
  __syncthreads();
}

template <int LOGN>
DI void fft_fwd(float2* buf, int total) {
  if (LOGN == 14) { fft_pass<4, 10, false>(buf, total); fft_pass<4, 6, false>(buf, total); fft_pass<4, 2, false>(buf, total); fft_pass<2, 0, false>(buf, total); }
  else { fft_pass<4, 7, false>(buf, total); fft_pass<4, 3, false>(buf, total); fft_pass<3, 0, false>(buf, total); }
}
template <int LOGN>
DI void fft_inv(float2* buf, int total) {
  if (LOGN == 14) { fft_pass<2, 0, true>(buf, total); fft_pass<4, 2, true>(buf, total); fft_pass<4, 6, true>(buf, total); fft_pass<4, 10, true>(buf, total); }
  else { fft_pass<3, 0, true>(buf, total); fft_pass<4, 3, true>(buf, total); fft_pass<4, 7, true>(buf, total); }
}

template <int LOGN, int NB, int NSUB>
DI void hyena_item(char* smem, const Params& p, int c, int row_base  ) {
  constexpr int L = 1 << LOGN;
  constexpr int SPT = L / NTHR;
  constexpr int EPT = NB * L / NTHR;
  const int tid = opaque((int)threadIdx.x);
  float2* buf = (float2*)smem;
  float* sm_w3 = (float*)(smem + 135168);
  float* sm_red = sm_w3 + 256;
  char* scr = p.ws + WS_XB + (size_t)blockIdx.x * HY_SCR_PER_BLOCK;
  float* scrF0 = (float*)scr;
  float* scrB0 = scrF0 + L;
  float* scrF1 = (float*)(p.ws + 451 * MiB + (size_t)blockIdx.x * 128 * 1024);
  float* scrB1 = scrF1 + L;
  float2* scrY = (float2*)(scr + 128 * 1024);
  float2* scrZ = (float2*)(scr + 256 * 1024);
  float2* scrS = (float2*)(scr + 384 * 1024);
  const bf16_t* UH = (const bf16_t*)p.out;
  bf16_t* OBt = (bf16_t*)(p.ws + WS_R3);
  const bf16_t* h2b = (const bf16_t*)(p.ws + WS_MISC + (LOGN == 14 ? MS_H2P : MS_H2S));
  const float* w3 = p.in[21];
  const float* cw = p.in[14]; const float* cb = p.in[15]; const float* skp = p.in[22];
  const float delta = fabsf(-3.0701134573253945f + (float)c * ((-15.350567286626973f + 3.0701134573253945f) / 511.0f));
  const float invLm1 = 1.0f / (float)(L - 1);

  float wv[3][4];
#pragma unroll
  for (int q = 0; q < 3; ++q) { const int ch = q * 512 + c; wv[q][0] = cw[ch]; wv[q][1] = cw[1536 + ch]; wv[q][2] = cw[2 * 1536 + ch]; wv[q][3] = cb[ch]; }
  auto loadu3 = [&](int b, int ch, int n, float (&r)[3]) {
    const bf16_t* u = UH + chm_index(1536, row_base + b * L, ch) + n;
    r[1] = bf2f(u[0]);
    r[0] = (n > 0) ? bf2f(u[-1]) : 0.f;
    r[2] = (n < L - 1) ? bf2f(u[1]) : 0.f;
  };
  auto convw = [&](int q, const float (&r)[3]) -> float { return r[0] * wv[q][0] + r[1] * wv[q][1] + r[2] * wv[q][2] + wv[q][3]; };

  {
    __syncthreads();
    if (tid < 256) sm_w3[tid] = w3[(size_t)(tid & 63) * 2048 + (tid >> 6) * 512 + c];
    __syncthreads();
    float asum0 = 0.f, asum1 = 0.f;
    constexpr int NP = L / (2 * NTHR);
    constexpr int CHK = NP < 8 ? NP : 8;
#pragma unroll 1
    for (int rep = 0; rep < ((PROBE & 64) ? 2 : 1); ++rep) {
      asum0 = 0.f; asum1 = 0.f;
#pragma unroll 1
      for (int i0 = 0; i0 < NP; i0 += CHK) {
        float acc[CHK][4][2];
#pragma unroll
        for (int i = 0; i < CHK; ++i)
#pragma unroll
          for (int q = 0; q < 4; ++q) { acc[i][q][0] = 0.f; acc[i][q][1] = 0.f; }
#pragma unroll 4
        for (int j = 0; j < 64; ++j) {
          const float w0 = sm_w3[j], w1 = sm_w3[64 + j], w2 = sm_w3[128 + j], w3v = sm_w3[192 + j];
          const unsigned* hp = (const unsigned*)(h2b + (size_t)j * L) + tid + NTHR * i0;
#pragma unroll
          for (int i = 0; i < CHK; ++i) {
            const unsigned hv = hp[NTHR * i];
            const float h0 = __uint_as_float(hv << 16), h1 = __uint_as_float(hv & 0xffff0000u);
            acc[i][0][0] += h0 * w0; acc[i][0][1] += h1 * w0; acc[i][1][0] += h0 * w1; acc[i][1][1] += h1 * w1;
            acc[i][2][0] += h0 * w2; acc[i][2][1] += h1 * w2; acc[i][3][0] += h0 * w3v; acc[i][3][1] += h1 * w3v;
          }
        }
#pragma unroll
        for (int i = 0; i < CHK; ++i) {
          const int t0 = 2 * (tid + NTHR * (i0 + i));
          const float d0 = ex2(-(float)t0 * invLm1 * delta * LOG2E), d1 = ex2(-(float)(t0 + 1) * invLm1 * delta * LOG2E);
          const float f00 = acc[i][0][0] * d0, f01 = acc[i][0][1] * d1, b00 = acc[i][1][0] * d0, b01 = acc[i][1][1] * d1;
          const float f10 = acc[i][2][0] * d0, f11 = acc[i][2][1] * d1, b10 = acc[i][3][0] * d0, b11 = acc[i][3][1] * d1;
          *(float2*)(scrF0 + t0) = make_float2(f00, f01); *(float2*)(scrB0 + t0) = make_float2(b00, b01);
          *(float2*)(scrF1 + t0) = make_float2(f10, f11); *(float2*)(scrB1 + t0) = make_float2(b10, b11);
          asum0 += fabsf(f00) + fabsf(f01) + (t0 >= 1 ? fabsf(b00) : 0.f) + fabsf(b01);
          asum1 += fabsf(f10) + fabsf(f11) + (t0 >= 1 ? fabsf(b10) : 0.f) + fabsf(b11);
        }
      }
    }
#pragma unroll
    for (int s = 32; s >= 1; s >>= 1) { asum0 += __shfl_xor(asum0, s); asum1 += __shfl_xor(asum1, s); }
    if ((tid & 63) == 0) { sm_red[tid >> 6] = asum0; sm_red[8 + (tid >> 6)] = asum1; }
    block_sync_global();
  }
#pragma unroll 1
  for (int o = 0; o < 2; ++o) {
    float nrm = 0.f;
#pragma unroll
    for (int w = 0; w < 8; ++w) nrm += sm_red[8 * o + w];
    const float inv_nrm = 1.0f / nrm;
    const float* scrF = o ? scrF1 : scrF0;
    const float* scrB = o ? scrB1 : scrB0;
    const float sk = skp[o * 512 + c];

#pragma unroll 1
    for (int par = 0; par < 2; ++par) {
#pragma unroll 2
      for (int i = 0; i < SPT; ++i) {
        const int n = tid + NTHR * i;
        const float f = scrF[n];
        const float br = (n == 0) ? 0.f : scrB[L - n];
        float2 v;
        if (par == 0) v = make_float2((f + br) * inv_nrm, 0.f);
        else { const float gm = (f - br) * inv_nrm; const float rev = -(float)n / (float)(2 * L); v = make_float2(gm * cos_rev(rev), gm * sin_rev(rev)); }
        buf[PADI(n)] = v;
      }
      __syncthreads();
      fft_fwd<LOGN>(buf, L);
#pragma unroll 8
      for (int i = 0; i < SPT; ++i) scrS[tid + NTHR * i] = buf[PADI(tid + NTHR * i)];
      __syncthreads();
#pragma unroll 1
      for (int sub = 0; sub < NSUB; ++sub) {
        constexpr int BT = 4;
#pragma unroll 1
        for (int i0 = 0; i0 < EPT; i0 += BT) {
          float2 zz[BT];
          if (o == 0 && par == 0) {
            float ra[BT][3], rb[BT][3];
#pragma unroll
            for (int k = 0; k < BT; ++k) {
              const int e = tid + NTHR * (i0 + k); const int f = e >> LOGN, n = e & (L - 1); const int pp = sub * NB + f;
              loadu3(2 * pp, c, n, ra[k]); loadu3(2 * pp + 1, c, n, rb[k]);
            }
#pragma unroll
            for (int k = 0; k < BT; ++k) {
              const int e = tid + NTHR * (i0 + k); const int f = e >> LOGN, n = e & (L - 1); const int pp = sub * NB + f;
              zz[k] = make_float2(convw(0, ra[k]), convw(0, rb[k]));
              scrZ[(size_t)pp * L + n] = zz[k];
            }
          } else {
#pragma unroll
            for (int k = 0; k < BT; ++k) {
              const int e = tid + NTHR * (i0 + k); const int f = e >> LOGN, n = e & (L - 1); const int pp = sub * NB + f;
              zz[k] = scrZ[(size_t)pp * L + n];
            }
          }
#pragma unroll
          for (int k = 0; k < BT; ++k) {
            const int e = tid + NTHR * (i0 + k); const int n = e & (L - 1);
            float2 z = zz[k];
            if (par == 1) { const float rev = -(float)n / (float)(2 * L); z = cmul(z, make_float2(cos_rev(rev), sin_rev(rev))); }
            buf[PADI(e)] = z;
          }
        }
        __syncthreads();
        if (PROBE & 32) {
          fft_fwd<LOGN>(buf, NB * L); fft_inv<LOGN>(buf, NB * L);
          _Pragma("unroll 1") for (int i = 0; i < EPT; ++i) { const int e = tid + NTHR * i; float2 v = buf[PADI(e)]; buf[PADI(e)] = make_float2(v.x * (1.0f / L), v.y * (1.0f / L)); }
          __syncthreads();
        }
        fft_fwd<LOGN>(buf, NB * L);
#pragma unroll 1
        for (int i0 = 0; i0 < EPT; i0 += BT) {
          float2 ss[BT];
#pragma unroll
          for (int k = 0; k < BT; ++k) ss[k] = scrS[(tid + NTHR * (i0 + k)) & (L - 1)];
#pragma unroll
          for (int k = 0; k < BT; ++k) { const int e = tid + NTHR * (i0 + k); buf[PADI(e)] = cmul(buf[PADI(e)], ss[k]); }
        }
        __syncthreads();
        fft_inv<LOGN>(buf, NB * L);
        if (par == 0) {
#pragma unroll 8
          for (int i = 0; i < EPT; ++i) {
            const int e = tid + NTHR * i; const int f = e >> LOGN, n = e & (L - 1);
            scrY[(size_t)(sub * NB + f) * L + n] = buf[PADI(e)];
          }
        } else {
          const int gsel = (o == 0 ? 1 : 2);
#pragma unroll 1
          for (int i0 = 0; i0 < EPT; i0 += BT) {
            float2 ye[BT], zz[BT]; float ga[BT][3], gb[BT][3];
#pragma unroll
            for (int k = 0; k < BT; ++k) {
              const int e = tid + NTHR * (i0 + k); const int f = e >> LOGN, n = e & (L - 1); const int pp = sub * NB + f;
              ye[k] = scrY[(size_t)pp * L + n]; zz[k] = scrZ[(size_t)pp * L + n];
              loadu3(2 * pp, gsel * 512 + c, n, ga[k]); loadu3(2 * pp + 1, gsel * 512 + c, n, gb[k]);
            }
#pragma unroll
            for (int k = 0; k < BT; ++k) {
              const int e = tid + NTHR * (i0 + k); const int f = e >> LOGN, n = e & (L - 1); const int pp = sub * NB + f;
              float2 y = buf[PADI(e)];
              const float rev = -(float)n / (float)(2 * L);
              y = cmulc(y, make_float2(cos_rev(rev), sin_rev(rev)));
              const float sc = 0.5f / (float)L;
              const float c0 = (ye[k].x + y.x) * sc + sk * zz[k].x;
              const float c1 = (ye[k].y + y.y) * sc + sk * zz[k].y;
              const float z0 = convw(gsel, ga[k]) * c0;
              const float z1 = convw(gsel, gb[k]) * c1;
              if (o == 0) scrZ[(size_t)pp * L + n] = make_float2(z0, z1);
              else {
                OBt[chm_index(512, row_base + (2 * pp) * L, c) + n] = f2bf(z0);
                OBt[chm_index(512, row_base + (2 * pp + 1) * L, c) + n] = f2bf(z1);
              }
            }
          }
        }
        __syncthreads();
      }
    }
  }
}

struct WMat { const float* src; int K; int N; const float* gain; bf16_t* dst; };
DI WMat get_wmat(const Params& p, int id) {
  bf16_t* W = (bf16_t*)(p.ws + WS_W);
  WMat m;
  switch (id) {
    case 0: m = {p.in[9], 1024, 3072, p.in[5], W + W_INE}; break;
    case 1: m = {p.in[23], 1024, 1024, nullptr, W + W_OUTE}; break;
    case 2: m = {p.in[24], 1024, 2304, p.in[5] + 1024, W + W_INO}; break;
    case 3: m = {p.in[31], 1024, 1024, nullptr, W + W_OUTO}; break;
    case 4: m = {p.in[32], 1024, 256, p.in[6], W + W_Q}; break;
    case 5: m = {p.in[32] + 1024 * 256, 1024, 256, p.in[6] + 1024, W + W_Q + 256 * 1024}; break;
    case 6: m = {p.in[33], 1024, 512, p.in[7], W + W_KV}; break;
    case 7: m = {p.in[33] + 1024 * 512, 1024, 512, p.in[7] + 1024, W + W_KV + 512 * 1024}; break;
    case 8: m = {p.in[34], 256, 1024, nullptr, W + W_O}; break;
    case 9: m = {p.in[34] + 256 * 1024, 256, 1024, nullptr, W + W_O + 1024 * 256}; break;
    case 10: m = {p.in[37], 1024, 4096, p.in[8], W + W_1}; break;
    case 11: m = {p.in[37] + (size_t)1024 * 4096, 1024, 4096, p.in[8] + 1024, W + W_1 + (size_t)4096 * 1024}; break;
    case 12: m = {p.in[38], 4096, 1024, nullptr, W + W_2}; break;
    default: m = {p.in[38] + (size_t)4096 * 1024, 4096, 1024, nullptr, W + W_2 + (size_t)4096 * 1024}; break;
  }
  return m;
}

DI void prep_wtile(char* smem, const WMat& m, int tile) {
  float* t = (float*)smem;
  const int ntn = m.N >> 6;
  const int k0 = (tile / ntn) << 6, n0 = (tile % ntn) << 6;
  const int tid = threadIdx.x;
  __syncthreads();
  {
    const int kk = tid >> 4, n4 = (tid & 15) * 4;
#pragma unroll
    for (int i = 0; i < 2; ++i) {
      const int k = kk + 32 * i;
      float4 v = *(const float4*)(m.src + (size_t)(k0 + k) * m.N + n0 + n4);
      const float gk = m.gain ? m.gain[k0 + k] : 1.0f;
      t[k * 65 + n4] = v.x * gk; t[k * 65 + n4 + 1] = v.y * gk; t[k * 65 + n4 + 2] = v.z * gk; t[k * 65 + n4 + 3] = v.w * gk;
    }
  }
  __syncthreads();
  {
    const int n = tid >> 3, kc = tid & 7;
    uint4 u;
    u.x = pack2(t[(8 * kc) * 65 + n], t[(8 * kc + 1) * 65 + n]); u.y = pack2(t[(8 * kc + 2) * 65 + n], t[(8 * kc + 3) * 65 + n]);
    u.z = pack2(t[(8 * kc + 4) * 65 + n], t[(8 * kc + 5) * 65 + n]); u.w = pack2(t[(8 * kc + 6) * 65 + n], t[(8 * kc + 7) * 65 + n]);
    *(uint4*)(m.dst + (size_t)(n0 + n) * m.K + k0 + 8 * kc) = u;
  }
}

DI void prep_row(const float* src, bf16_t* dst, float* ssq) {
  const int lane = threadIdx.x & 63;
  float ss = 0.f;
#pragma unroll
  for (int i = 0; i < 4; ++i) {
    float4 v = *(const float4*)(src + (i * 64 + lane) * 4);
    ss += v.x * v.x + v.y * v.y + v.z * v.z + v.w * v.w;
    uint2 u; u.x = pack2(v.x, v.y); u.y = pack2(v.z, v.w);
    *(uint2*)(dst + (i * 64 + lane) * 4) = u;
  }
#pragma unroll
  for (int s = 32; s >= 1; s >>= 1) ss += __shfl_xor(ss, s);
  if (lane == 0) *ssq = ss;
}

DI void prep_h2(const Params& p, int L, int t, bf16_t* dst) {
  const int j = threadIdx.x & 63;
  const float* w1 = p.in[16]; const float* b1 = p.in[17]; const float* fr = p.in[18]; const float* w2 = p.in[19]; const float* b2 = p.in[20];
  const float t01 = (float)t / (float)(L - 1);
  const float tl = (float)t / (float)L;
  float a = t01 * w1[j] + b1[j];
#pragma unroll
  for (int k = 0; k < 8; ++k) {
    const float fk = 1e-4f + (float)k * ((7.0f - 1e-4f) / 7.0f);
    const float rev = tl * fk;
    a += cos_rev(rev) * w1[(1 + k) * 64 + j] - sin_rev(rev) * w1[(9 + k) * 64 + j];
  }
  const float h1 = sin_rev(fr[j] * a * 0.15915494309189535f);
  float a2 = b2[j];
  for (int i = 0; i < 64; ++i) a2 += __shfl(h1, i) * w2[i * 64 + j];
  dst[(size_t)j * L + t] = f2bf(sin_rev(fr[64 + j] * a2 * 0.15915494309189535f));
}

constexpr int PREP_NW = 768 + 256 + 576 + 256 + 64 + 64 + 128 + 128 + 64 + 64 + 1024 + 1024 + 1024 + 1024;
constexpr int PREP_T_ROWS = PREP_NW;
constexpr int PREP_T_MEM = PREP_T_ROWS + 8192;
constexpr int PREP_T_H2 = PREP_T_MEM + 576;
constexpr int PREP_T_MISC = PREP_T_H2 + 2304;
constexpr int PREP_TOTAL = PREP_T_MISC + 1;

DI void phase_prep(char* smem, const Params& p) {
  const int tid = threadIdx.x, wave = tid >> 6;
#pragma unroll 1
  for (int task = blockIdx.x; task < PREP_TOTAL; task += gridDim.x) {
    if (task < PREP_NW) {
      int t = task, id = 0;
      for (; id < 14; ++id) { WMat m = get_wmat(p, id); int n = (m.K >> 6) * (m.N >> 6); if (t < n) break; t -= n; }
      WMat m = get_wmat(p, id);
      prep_wtile(smem, m, t);
    } else if (task < PREP_T_MEM) {
      const int row = (task - PREP_T_ROWS) * 8 + wave;
      const float* src = (row < T_P) ? p.in[0] + (size_t)row * DM : p.in[1] + (size_t)(row - T_P) * DM;
      float* RS = (float*)(p.ws + WS_MISC + MS_RS);
      prep_row(src, (bf16_t*)(p.ws + WS_XB) + (size_t)row * DM, RS + row);
      if ((tid & 63) < 5) RS[(size_t)(1 + (tid & 63)) * T_ALL + row] = 0.f;
    } else if (task < PREP_T_H2) {
      const int row = (task - PREP_T_MEM) * 8 + wave;
      const float* src = (row < 512) ? p.in[2] + (size_t)row * DM : p.in[3] + (size_t)(row - 512) * DM;
      prep_row(src, (bf16_t*)(p.ws + WS_R1) + (size_t)row * DM, (float*)(p.ws + WS_MISC + MS_RSM) + row);
    } else if (task < PREP_T_MISC) {
      const int t = (task - PREP_T_H2) * 8 + wave;
      if (t < LP) prep_h2(p, LP, t, (bf16_t*)(p.ws + WS_MISC + MS_H2P));
      else prep_h2(p, LS, t - LP, (bf16_t*)(p.ws + WS_MISC + MS_H2S));
    } else {
      float* lut = (float*)(p.ws + WS_MISC + MS_LUT);
      for (int i = tid; i < 8 * 257; i += NTHR) {
        const int hh = i / 257, rel = (i % 257) - 128;
        const int n = rel < 0 ? -rel : rel;
        int bkt;
        if (n < 8) bkt = n; else { bkt = 2 + (31 - __clz(n * n)); if (bkt > 15) bkt = 15; }
        if (rel > 0) bkt += 16;
        lut[i] = p.in[4][bkt * 8 + hh] * LOG2E;
      }
      if (tid < 64) {
        const float* lf = p.in[12];
        float a = lf[tid] * lf[64 + tid], b = lf[128 + tid] * lf[192 + tid];
#pragma unroll
        for (int s = 32; s >= 1; s >>= 1) { a += __shfl_xor(a, s); b += __shfl_xor(b, s); }
        if (tid == 0) *(float*)(p.ws + WS_MISC + MS_LAM) = expf(a) - expf(b) + 0.2f;
      }
    }
  }
}

DI Seg seg_inproj(const Params& p, int layer, int col0, const float* rs) {
  Seg s{}; s.rs = rs; s.scale = 1.0f;
  if (layer == 0) {
    if (col0 < 512) { s.type = SEG_NORM; s.dst = (bf16_t*)(p.ws + WS_R0); s.ld = 512; s.col = col0; s.gain = p.in[10]; s.scale = QSCALE; }
    else if (col0 < 1024) { s.type = SEG_NORM; s.dst = (bf16_t*)((char*)p.out + 192 * MiB); s.ld = 512; s.col = col0 - 512; s.gain = p.in[11]; }
    else if (col0 < 1536) { s.type = SEG_CHM; s.dst = (bf16_t*)(p.ws + WS_R2); s.CH = 512; s.col = col0 - 1024; }
    else { s.type = SEG_CHM; s.dst = (bf16_t*)p.out; s.CH = 1536; s.col = col0 - 1536; }
  } else {
    if (col0 < 512) { s.type = SEG_NORM; s.dst = (bf16_t*)(p.ws + WS_R0); s.ld = 512; s.col = col0; s.gain = p.in[25]; s.scale = QSCALE; }
    else if (col0 < 1024) { s.type = SEG_NORM; s.dst = (bf16_t*)(p.ws + WS_R1); s.ld = 512; s.col = col0 - 512; s.gain = p.in[26]; }
    else if (col0 < 1536) { s.type = SEG_CHM; s.dst = (bf16_t*)(p.ws + WS_R2); s.CH = 512; s.col = col0 - 1024; }
    else if (col0 < 2048) { s.type = SEG_NORM; s.dst = (bf16_t*)(p.ws + WS_R3); s.ld = 512; s.col = col0 - 1536; s.gain = p.in[28]; s.scale = QSCALE; }
    else if (col0 < 2176) { s.type = SEG_NORM; s.dst = (bf16_t*)(p.ws + WS_KD); s.ld = 128; s.col = col0 - 2048; s.gain = p.in[29]; }
    else { s.type = SEG_CHM; s.dst = (bf16_t*)(p.ws + WS_VDT); s.CH = 128; s.col = col0 - 2176; }
  }
  return s;
}

struct SchedInproj { int xcd, jx, per, rows_per, nt_lo, nt_n;
  DI bool next(int i, SUnit& u) const { const int q = jx + i * per; if (q >= rows_per * nt_n) return false; u.m0 = (xcd * rows_per + q / nt_n) * 256; u.n0 = (nt_lo + q % nt_n) * 256; return true; } };
struct SchedOne { int m0, n0; bool valid;
  DI bool next(int i, SUnit& u) const { if (i > 0 || !valid) return false; u.m0 = m0; u.n0 = n0; return true; } };
struct SchedRow { int m0, n;
  DI bool next(int i, SUnit& u) const { if (i >= n) return false; u.m0 = m0; u.n0 = i * 256; return true; } };

DI void phase_inproj(char* smem, const Params& p, int layer) {
  const bf16_t* W = (const bf16_t*)(p.ws + WS_W);
  const int nxg = (gridDim.x >= 8 && (gridDim.x & 7) == 0) ? 8 : 1;
  {
    GemmArgs ga{(const bf16_t*)(p.ws + WS_XB), nullptr, 1 << 30, DM, W + (layer == 0 ? W_INE : W_INO), DM, DM};
    const int xc = blockIdx.x % nxg, jx = blockIdx.x / nxg, per = gridDim.x / nxg, rp = 256 / nxg;
    const float* rs = (const float*)(p.ws + WS_MISC + MS_RS) + (size_t)(layer * 3) * T_ALL;
    auto sf = [&](const SUnit& u, int wc) -> Seg { return seg_inproj(p, layer, u.n0 + 64 * wc, rs); };
    if (layer == 0) {
      gemm_stream<false>(ga, SchedInproj{xc, jx, per, rp, 0, 4}, sf);
      gemm_stream<true>(ga, SchedInproj{xc, jx, per, rp, 4, 8}, sf);
    } else {
      gemm_stream<false>(ga, SchedInproj{xc, jx, per, rp, 0, 4}, sf);
      gemm_stream<true>(ga, SchedInproj{xc, jx, per, rp, 4, 2}, sf);
      gemm_stream<false>(ga, SchedInproj{xc, jx, per, rp, 6, 3}, sf);
    }
  }
  if (layer == 0) {
    const int t2 = blockIdx.x; const int l = t2 / 36, r = t2 % 36;
    GemmArgs ga{(const bf16_t*)(p.ws + WS_R1), nullptr, 1 << 30, DM, W + W_KV + (size_t)(l & 1) * 512 * 1024, DM, DM};
    auto sfm = [&](const SUnit& u, int wc) -> Seg {
      Seg s{}; s.rs = (const float*)(p.ws + WS_MISC + MS_RSM); s.scale = 1.0f;
      const int col0 = u.n0 + 64 * wc;
      if (col0 < 256) { s.type = SEG_NORM; s.dst = (bf16_t*)(p.ws + WS_MISC + MS_MK) + (size_t)l * 18 * 256 * 256; s.ld = 256; s.col = col0; s.gain = p.in[36] + l * 64; }
      else { s.type = SEG_CHMEM; s.dst = (bf16_t*)(p.ws + WS_MISC + MS_MVT) + (size_t)l * 18 * 256 * 256; s.col = col0 - 256; }
      return s; };
    gemm_stream<false>(ga, SchedOne{(r >> 1) * 256, 0, t2 < 72 && (r & 1) == 0}, sfm);
    gemm_stream<true>(ga, SchedOne{(r >> 1) * 256, 256, t2 < 72 && (r & 1) == 1}, sfm);
  }
  (void)smem;
}

DI void phase_mixer0(char* smem, const Params& p) {
#pragma unroll 1
  for (int item = blockIdx.x; item < 2048; item += gridDim.x) {
    const int kind = item >> 9, idx = item & 511;
#ifndef SUBP
#define SUBP -1
#endif
    if (kind == 0 || kind == 2) {
      if (PROBE & 4) diff_item(smem, p, (kind == 2 ? 512 : 0) + idx, true);
      diff_item(smem, p, (kind == 2 ? 512 : 0) + idx);
    } else if (kind == 1) {
      if (PROBE & 8) hyena_item<14, 1, 1>(smem, p, idx, 0);
      hyena_item<14, 1, 1>(smem, p, idx, 0);
    } else {
      if (PROBE & 8) hyena_item<11, 4, 2>(smem, p, idx, T_P);
      hyena_item<11, 4, 2>(smem, p, idx, T_P);
    }
  }
}
DI void phase_mixer1(char* smem, const Params& p) {
#pragma unroll 1
  for (int item = blockIdx.x; item < 4096; item += gridDim.x) {
    if (PROBE & 16) { if (item < 2048) na_item(smem, p, item, true); else wg_item(smem, p, item - 2048, true); }
    if (item < 2048) na_item(smem, p, item); else wg_item(smem, p, item - 2048);
  }
}

DI void phase_post(char* smem, const Params& p, int layer, int part) {
  const bf16_t* W = (const bf16_t*)(p.ws + WS_W);
  float* RS = (float*)(p.ws + WS_MISC + MS_RS);
  bf16_t* XB = (bf16_t*)(p.ws + WS_XB);
  bf16_t* H0 = (bf16_t*)(p.ws + 195 * MiB);
  bf16_t* H1 = (bf16_t*)(p.ws + 323 * MiB);
  bf16_t* QM = (bf16_t*)(p.ws + WS_QM);
  const int wn = (threadIdx.x >> 6) & 1;
#pragma unroll 1
  for (int mt = blockIdx.x; mt < 256; mt += gridDim.x) {
    const int m0 = mt * 256;
    if (layer == 0 && part == 0) {
      const bf16_t* OBt = (const bf16_t*)(p.ws + WS_R3);
      bf16_t* OB = (bf16_t*)(p.ws + WS_R1);
      const int tid = threadIdx.x;
#pragma unroll 1
      for (int chunk = 0; chunk < 4; ++chunk) {
        __syncthreads();
        {
          const int c = tid >> 2, part = tid & 3;
          const uint4* src = (const uint4*)(OBt + chm_index(512, m0, chunk * 128 + c) + part * 64);
#pragma unroll
          for (int i = 0; i < 8; ++i) *(uint4*)(smem + c * 528 + part * 128 + i * 16) = src[i];
        }
        __syncthreads();
#pragma unroll 2
        for (int it = 0; it < 8; ++it) {
          const int item = it * NTHR + tid; const int t = item & 255, c8 = item >> 8;
          unsigned short v[8];
#pragma unroll
          for (int j = 0; j < 8; ++j) v[j] = *(const unsigned short*)(smem + (c8 * 8 + j) * 528 + t * 2);
          uint4 u; u.x = v[0] | ((unsigned)v[1] << 16); u.y = v[2] | ((unsigned)v[3] << 16); u.z = v[4] | ((unsigned)v[5] << 16); u.w = v[6] | ((unsigned)v[7] << 16);
          *(uint4*)(OB + (size_t)(m0 + t) * 512 + chunk * 128 + c8 * 8) = u;
        }
      }
      __syncthreads();
    }
#ifndef CHAINP
#define CHAINP -1
#endif
    if (part == 0) {
      GemmArgs ga{(const bf16_t*)(p.ws + WS_R0), (const bf16_t*)(p.ws + (layer == 0 ? WS_R1 : WS_R3)), 512, 512, W + (layer == 0 ? W_OUTE : W_OUTO), DM, DM};
      Seg s{}; s.type = SEG_RESID; s.xin0 = layer == 0 ? p.in[0] : nullptr; s.xin1 = layer == 0 ? p.in[1] : nullptr;
      s.xout = p.out; s.xb = XB; s.rs_out = RS + (size_t)(layer * 3 + 1) * T_ALL;
      gemm_stream<false>(ga, SchedRow{m0, 4}, [&](const SUnit& u, int wc) -> Seg { Seg t = s; t.col = u.n0 + 64 * wc; return t; });
    }
    if (part == 0) continue;
    if (CHAINP < 0 || CHAINP == 2) {
      GemmArgs ga{XB, nullptr, 1 << 30, DM, W + W_Q + (size_t)layer * 256 * 1024, DM, DM};
      Seg s{}; s.type = SEG_NORM; s.rs = RS + (size_t)(layer * 3 + 1) * T_ALL; s.dst = QM; s.ld = 256; s.gain = p.in[35] + layer * 64; s.scale = QSCALE;
      gemm_stream<false>(ga, SchedRow{m0, 1}, [&](const SUnit& u, int wc) -> Seg { Seg t = s; t.col = u.n0 + 64 * wc; return t; });
    }
    block_sync_global();
    if (CHAINP < 0 || CHAINP == 3) mem_attn_tile(smem, p, layer, m0);
    block_sync_global();
    if (CHAINP < 0 || CHAINP == 4) {
      GemmArgs ga{QM, nullptr, 1 << 30, 256, W + W_O + (size_t)layer * 1024 * 256, 256, 256};
      Seg s{}; s.type = SEG_RESID; s.xout = p.out; s.xb = XB; s.rs_out = RS + (size_t)(layer * 3 + 2) * T_ALL;
      gemm_stream<false>(ga, SchedRow{m0, 4}, [&](const SUnit& u, int wc) -> Seg { Seg t = s; t.col = u.n0 + 64 * wc; return t; });
    }
    block_sync_global();
    _Pragma("unroll 1") for (int hc = 0; hc < 2; ++hc) {
      {
        GemmArgs ga{XB, nullptr, 1 << 30, DM, W + W_1 + (size_t)layer * 4096 * 1024 + (size_t)hc * 2048 * 1024, DM, DM};
        Seg s{}; s.type = SEG_MLP1; s.rs = RS + (size_t)(layer * 3 + 2) * T_ALL; s.ld = 1024;
        gemm_stream<false>(ga, SchedRow{m0, 8}, [&](const SUnit& u, int wc) -> Seg { Seg t = s; t.dst = (u.n0 < 1024) ? H0 : H1; t.col = (u.n0 & 1023) + 64 * wc; return t; });
      }
      block_sync_global();
      {
        GemmArgs ga{H0, H1, 1024, 1024, W + W_2 + (size_t)layer * 4096 * 1024 + (size_t)hc * 2048, 4096, 2048};
        Seg s{}; s.type = SEG_RESID; s.xout = p.out;
        if (hc == 1 && layer == 0) { s.xb = XB; s.rs_out = RS + (size_t)3 * T_ALL; }
        gemm_stream<false>(ga, SchedRow{m0, 4}, [&](const SUnit& u, int wc) -> Seg { Seg t = s; t.col = u.n0 + 64 * wc; return t; });
      }
      block_sync_global();
    }
  }
  (void)wn;
}

__global__ void __launch_bounds__(NTHR) fwd_kernel(Params p, int ph_lo, int ph_hi) {
  extern __shared__ __attribute__((aligned(16))) char smem[];
#define RUN_PHASE(i_, call_) if (ph_lo <= (i_) && (i_) <= ph_hi) { if ((i_) > ph_lo) { cg::this_grid().sync(); } call_; }
  RUN_PHASE(0, phase_prep(smem, p))
  if (PROBE & 1) { __syncthreads(); phase_prep(smem, p); }
  RUN_PHASE(1, phase_inproj(smem, p, 0))
  if (PROBE & 2) { __syncthreads(); phase_inproj(smem, p, 0); }
  RUN_PHASE(2, phase_mixer0(smem, p))
  RUN_PHASE(3, phase_post(smem, p, 0, 0))
  RUN_PHASE(4, phase_post(smem, p, 0, 1))
  RUN_PHASE(5, phase_inproj(smem, p, 1))
  if (PROBE & 2) { __syncthreads(); phase_inproj(smem, p, 1); }
  RUN_PHASE(6, phase_mixer1(smem, p))
  RUN_PHASE(7, phase_post(smem, p, 1, 0))
  RUN_PHASE(8, phase_post(smem, p, 1, 1))
}

#ifndef ONE_LAUNCH
#define ONE_LAUNCH 1
#endif

extern "C" void kernel_launch(void* const* d_in, const int* in_sizes, int n_in, void* d_out, int out_size, void* d_ws, size_t ws_size,
                              hipStream_t stream) {
  static int grid = 0;
  if (grid == 0) {
    if (n_in != 39 || ws_size < WS_NEED || out_size != T_ALL * DM) { fprintf(stderr, "kernel_launch: unexpected shapes n_in %d ws %zu out %d\n", n_in, ws_size, out_size); grid = -1; return; }
    if (hipFuncSetAttribute((const void*)fwd_kernel, hipFuncAttributeMaxDynamicSharedMemorySize, SMEM_BYTES) != hipSuccess) { fprintf(stderr, "hipFuncSetAttribute failed\n"); grid = -1; return; }
    int dev = 0, cus = 0, per_cu = 0;
    hipGetDevice(&dev);
    hipDeviceGetAttribute(&cus, hipDeviceAttributeMultiprocessorCount, dev);
    hipOccupancyMaxActiveBlocksPerMultiprocessor(&per_cu, (const void*)fwd_kernel, NTHR, SMEM_BYTES);
    if (per_cu < 1 || cus < 1) { fprintf(stderr, "occupancy query: %d blocks/CU, %d CUs\n", per_cu, cus); grid = -1; return; }
    grid = cus;
  }
  if (grid < 0) return;
  Params p{};
  for (int i = 0; i < 39; ++i) p.in[i] = (const float*)d_in[i];
  p.out = (float*)d_out; p.ws = (char*)d_ws;
#if ONE_LAUNCH
  int lo = 0, hi = 8;
  void* args[] = {&p, &lo, &hi};
  hipError_t e = hipLaunchCooperativeKernel((const void*)fwd_kernel, dim3(grid), dim3(NTHR), args, SMEM_BYTES, stream);
  if (e != hipSuccess) fprintf(stderr, "cooperative launch failed: %s\n", hipGetErrorString(e));
#else
  for (int ph = 0; ph <= 8; ++ph) hipLaunchKernelGGL(fwd_kernel, dim3(grid), dim3(NTHR), SMEM_BYTES, stream, p, ph, ph);
#endif
}
```
